# Optimizing an MI355X kernel written in HIP

```python
import numpy as np
import jax, jax.numpy as jnp
from jax import lax

D_MODEL = 1024
BATCH = 16
SEQ = 2048
DEPTH = 1

RET_HEADS = 4
RET_DK = 128
RET_DV = 256
RET_CHUNK = 128
NSA_HEADS = 8
NSA_KV_GROUPS = 2
NSA_GROUP_HEADS = NSA_HEADS // NSA_KV_GROUPS
NSA_DK = 64
CMP_BLOCK = 32
CMP_STRIDE = 16
CMP_HIDDEN = 256
SEL_BLOCK = 64
SEL_TOPK = 8
WINDOW = 512
D_FF = 2816
CONV_W = 3

EPS = 1e-6
NEG = -1e30
FORCE = 1e9

IN_SIZES = (RET_HEADS * RET_DK, RET_HEADS * RET_DK, RET_HEADS * RET_DV, RET_HEADS * RET_DV,
            NSA_HEADS * NSA_DK,
            NSA_KV_GROUPS * NSA_DK, NSA_KV_GROUPS * NSA_DK, NSA_KV_GROUPS * NSA_DK,
            NSA_KV_GROUPS * NSA_DK, NSA_KV_GROUPS * NSA_DK, NSA_KV_GROUPS * NSA_DK,
            3 * NSA_HEADS, D_MODEL, D_MODEL)
N_IN = sum(IN_SIZES)

kernel_name = "hybrid_retention_nsa_convffn"


def rmsnorm(x, g):
    xf = x.astype(jnp.float32)
    y = xf * lax.rsqrt(jnp.mean(xf * xf, axis=-1, keepdims=True) + EPS) * g.astype(jnp.float32)
    return y.astype(x.dtype)


def retention(q, k, v, g, gn_g):
    B, S = q.shape[0], q.shape[1]
    H, C = RET_HEADS, RET_CHUNK
    NCH = S // C
    lg = jnp.log1p(-jnp.exp2(-5.0 - jnp.arange(H, dtype=jnp.float32)))
    pos = jnp.arange(C, dtype=jnp.float32)
    diff = pos[:, None] - pos[None, :]
    dmask = jnp.where(diff >= 0, jnp.exp(lg[:, None, None] * jnp.maximum(diff, 0.0)), 0.0)
    zeta = jnp.exp(lg[:, None] * (C - 1 - pos))
    xi = jnp.exp(lg[:, None] * (pos + 1.0))

    def to_chunks(t):
        return t.reshape(B, NCH, C, H, t.shape[-1]).transpose(0, 3, 1, 2, 4)

    qc = to_chunks(q)
    kc = to_chunks(k) * (RET_DK ** -0.5)
    vc = to_chunks(v)
    inner = jnp.einsum('bhncd,bhnmd->bhncm', qc, kc) * dmask[:, None]
    o_inner = jnp.einsum('bhncm,bhnme->bhnce', inner, vc)
    kv = jnp.einsum('bhnmd,bhnme->nbhde', kc * zeta[:, None, :, None], vc)
    chunk_decay = jnp.exp(lg * C).astype(kv.dtype)[:, None, None]

    def step(R, kv_n):
        return chunk_decay * R + kv_n, R

    R0 = jnp.zeros(kv.shape[1:], kv.dtype)
    _, R_prev = lax.scan(step, R0, kv)
    o_cross = jnp.einsum('bhncd,nbhde->bhnce', qc * xi[:, None, :, None], R_prev)
    o = (o_inner + o_cross).transpose(0, 2, 3, 1, 4).reshape(B, S, H, RET_DV)
    of = o.astype(jnp.float32)
    mu = jnp.mean(of, axis=-1, keepdims=True)
    var = jnp.mean(jnp.square(of - mu), axis=-1, keepdims=True)
    on = ((of - mu) * lax.rsqrt(var + EPS)).reshape(B, S, H * RET_DV) * gn_g.astype(jnp.float32)
    return (jax.nn.silu(g.astype(jnp.float32)) * on).astype(q.dtype)


def compress(t, pos_emb, w1, b1, w2):
    B, G, S, dk = t.shape
    npc = CMP_BLOCK // CMP_STRIDE
    NP = S // CMP_STRIDE
    pieces = t.reshape(B, G, NP, CMP_STRIDE, dk)
    blocks = jnp.concatenate([pieces[:, :, i:NP - (npc - 1) + i] for i in range(npc)], axis=3)
    blocks = (blocks + pos_emb).reshape(B, G, NP - npc + 1, CMP_BLOCK * dk)
    return jax.nn.gelu(blocks @ w1 + b1) @ w2


def nsa(q, kcr, vcr, ks, vs, kw, vw, gates,
        cmp_pos_k, cmp_w1_k, cmp_b1_k, cmp_w2_k, cmp_pos_v, cmp_w1_v, cmp_b1_v, cmp_w2_v):
    B, S = q.shape[0], q.shape[1]
    G, R, dk, T = NSA_KV_GROUPS, NSA_GROUP_HEADS, NSA_DK, SEL_BLOCK
    NS = S // SEL_BLOCK
    NQ = S // T
    k_eff = min(SEL_TOPK, NS)
    scale = dk ** -0.5
    qh = q.reshape(B, S, G, R, dk).transpose(0, 2, 3, 1, 4)

    def kvh(t):
        return t.reshape(B, S, G, dk).transpose(0, 2, 1, 3)

    kcr, vcr, ks, vs, kw, vw = [kvh(t) for t in (kcr, vcr, ks, vs, kw, vw)]
    slopes = jnp.exp2(-(jnp.arange(NSA_HEADS, dtype=jnp.float32) + 1.0)).reshape(G, R)
    tpos = jnp.arange(S, dtype=jnp.float32)

    kcmp = compress(kcr, cmp_pos_k, cmp_w1_k, cmp_b1_k, cmp_w2_k)
    vcmp = compress(vcr, cmp_pos_v, cmp_w1_v, cmp_b1_v, cmp_w2_v)
    NC = kcmp.shape[2]
    c_start = jnp.arange(NC) * CMP_STRIDE
    c_end = (c_start + CMP_BLOCK - 1).astype(jnp.float32)
    dcmp = tpos[:, None] - c_end[None, :]
    cmask = dcmp >= 0
    s = jnp.einsum('bgrtd,bgcd->bgrtc', qh, kcmp).astype(jnp.float32) * scale
    s = jnp.where(cmask, s - slopes[None, :, :, None, None] * dcmp, NEG)
    p_cmp = jax.nn.softmax(s, axis=-1) * cmask
    o_cmp = jnp.einsum('bgrtc,bgcd->bgrtd', p_cmp.astype(vcmp.dtype), vcmp)

    j_start = jnp.arange(NS) * SEL_BLOCK
    overlap = ((c_start[:, None] < j_start[None, :] + SEL_BLOCK) &
               (c_start[:, None] + CMP_BLOCK > j_start[None, :])).astype(jnp.float32)
    imp = jnp.einsum('bgrtc,cj->bgtj', p_cmp, overlap)
    cur = (jnp.arange(S) // SEL_BLOCK)[:, None]
    jj = jnp.arange(NS)[None, :]
    imp = jnp.where((jj == 0) | (jj == cur) | (jj == cur - 1), FORCE, imp)
    imp = jnp.where(jj > cur, -FORCE, imp)
    _, sel_idx = lax.top_k(imp, k_eff)

    ks_blk = ks.reshape(B, G, NS, SEL_BLOCK, dk)
    vs_blk = vs.reshape(B, G, NS, SEL_BLOCK, dk)
    kw_pad = jnp.pad(kw, ((0, 0), (0, 0), (WINDOW, 0), (0, 0)))
    vw_pad = jnp.pad(vw, ((0, 0), (0, 0), (WINDOW, 0), (0, 0)))
    bi = jnp.arange(B)[:, None, None, None]
    gi = jnp.arange(G)[None, :, None, None]
    sl = slopes[None, :, :, None]

    def block_fn(n):
        t0 = n * T
        qb = lax.dynamic_slice_in_dim(qh, t0, T, axis=3)
        tb = t0 + jnp.arange(T)
        idb = lax.dynamic_slice_in_dim(sel_idx, t0, T, axis=2)
        kb = ks_blk[bi, gi, idb]
        vb = vs_blk[bi, gi, idb]
        kpos = idb[..., None] * SEL_BLOCK + jnp.arange(SEL_BLOCK)
        dsel = (tb[None, None, :, None, None] - kpos).astype(jnp.float32)[:, :, None]
        ss = jnp.einsum('bgrtd,bgtnsd->bgrtns', qb, kb).astype(jnp.float32) * scale
        ss = jnp.where(dsel >= 0, ss - sl[..., None, None] * dsel, NEG)
        ps = jax.nn.softmax(ss.reshape(B, G, R, T, -1), axis=-1).reshape(ss.shape)
        o_sel = jnp.einsum('bgrtns,bgtnsd->bgrtd', ps.astype(vb.dtype), vb)
        kwb = lax.dynamic_slice_in_dim(kw_pad, t0, WINDOW + T, axis=2)
        vwb = lax.dynamic_slice_in_dim(vw_pad, t0, WINDOW + T, axis=2)
        wpos = t0 - WINDOW + jnp.arange(WINDOW + T)
        dw = tb[:, None] - wpos[None, :]
        wmask = (dw >= 0) & (dw < WINDOW) & (wpos[None, :] >= 0)
        sw = jnp.einsum('bgrtd,bgsd->bgrts', qb, kwb).astype(jnp.float32) * scale
        sw = jnp.where(wmask, sw - sl[..., None] * dw.astype(jnp.float32), NEG)
        pw = jax.nn.softmax(sw, axis=-1)
        o_win = jnp.einsum('bgrts,bgsd->bgrtd', pw.astype(vwb.dtype), vwb)
        return o_sel, o_win

    o_sel, o_win = lax.map(block_fn, jnp.arange(NQ))
    o_sel = o_sel.transpose(1, 2, 3, 0, 4, 5).reshape(B, G, R, S, dk)
    o_win = o_win.transpose(1, 2, 3, 0, 4, 5).reshape(B, G, R, S, dk)

    gt = jax.nn.sigmoid(gates.reshape(B, S, 3, G, R).transpose(2, 0, 3, 4, 1))[..., None]
    o = gt[0] * o_cmp + gt[1] * o_sel + gt[2] * o_win
    return o.transpose(0, 3, 1, 2, 4).reshape(B, S, NSA_HEADS * dk).astype(q.dtype)


def conv_ffn(h, w_up, conv_w, conv_b, w_down):
    S = h.shape[1]
    a, b = jnp.split(h @ w_up, 2, axis=-1)
    a_pad = jnp.pad(a, ((0, 0), (CONV_W - 1, 0), (0, 0)))
    ac = conv_b + sum(conv_w[i] * a_pad[:, i:i + S] for i in range(CONV_W))
    return (jax.nn.gelu(ac) * b) @ w_down


def setup_inputs(seed: int = 0) -> dict:
    key = jax.random.key(seed)
    ks = jax.random.split(key, 24)
    f32 = jnp.float32

    def nrm(k, shape, fan_in):
        return jax.random.normal(k, shape, f32) * (fan_in ** -0.5)

    def gain(k, shape):
        return 1.0 + 0.01 * jax.random.normal(k, shape, f32)

    L = DEPTH
    return {
        "x": jax.random.normal(ks[0], (BATCH, SEQ, D_MODEL), f32),
        "norm_mix": gain(ks[1], (L, D_MODEL)),
        "w_in": nrm(ks[2], (L, D_MODEL, N_IN), D_MODEL),
        "ret_gn_g": gain(ks[3], (L, RET_HEADS * RET_DV)),
        "cmp_pos_k": 0.02 * jax.random.normal(ks[4], (L, CMP_BLOCK, NSA_DK), f32),
        "cmp_w1_k": nrm(ks[5], (L, CMP_BLOCK * NSA_DK, CMP_HIDDEN), CMP_BLOCK * NSA_DK),
        "cmp_b1_k": 0.01 * jax.random.normal(ks[6], (L, CMP_HIDDEN), f32),
        "cmp_w2_k": nrm(ks[7], (L, CMP_HIDDEN, NSA_DK), CMP_HIDDEN),
        "cmp_pos_v": 0.02 * jax.random.normal(ks[8], (L, CMP_BLOCK, NSA_DK), f32),
        "cmp_w1_v": nrm(ks[9], (L, CMP_BLOCK * NSA_DK, CMP_HIDDEN), CMP_BLOCK * NSA_DK),
        "cmp_b1_v": 0.01 * jax.random.normal(ks[10], (L, CMP_HIDDEN), f32),
        "cmp_w2_v": nrm(ks[11], (L, CMP_HIDDEN, NSA_DK), CMP_HIDDEN),
        "w_ret_o": nrm(ks[12], (L, RET_HEADS * RET_DV, D_MODEL), RET_HEADS * RET_DV),
        "w_nsa_o": nrm(ks[13], (L, NSA_HEADS * NSA_DK, D_MODEL), NSA_HEADS * NSA_DK),
        "w_out": nrm(ks[14], (L, D_MODEL, D_MODEL), D_MODEL),
        "norm_ffn": gain(ks[15], (L, D_MODEL)),
        "w_up": nrm(ks[16], (L, D_MODEL, 2 * D_FF), D_MODEL),
        "conv_w": nrm(ks[17], (L, CONV_W, D_FF), CONV_W),
        "conv_b": 0.01 * jax.random.normal(ks[18], (L, D_FF), f32),
        "w_down": nrm(ks[19], (L, D_FF, D_MODEL), D_FF),
        "norm_final": gain(ks[20], (D_MODEL,)),
    }


def reference(x, norm_mix, w_in, ret_gn_g, cmp_pos_k, cmp_w1_k, cmp_b1_k, cmp_w2_k,
              cmp_pos_v, cmp_w1_v, cmp_b1_v, cmp_w2_v, w_ret_o, w_nsa_o, w_out,
              norm_ffn, w_up, conv_w, conv_b, w_down, norm_final):
    B, S, _ = x.shape
    split_at = list(np.cumsum(IN_SIZES)[:-1])
    for l in range(DEPTH):
        h = rmsnorm(x, norm_mix[l])
        proj = h @ w_in[l]
        (rq, rk, rv, rg, nq, kcr, vcr, ksl, vsl, kwn, vwn, ngate,
         ga, gb) = jnp.split(proj, split_at, axis=-1)
        y_a = retention(rq.reshape(B, S, RET_HEADS, RET_DK), rk.reshape(B, S, RET_HEADS, RET_DK),
                        rv.reshape(B, S, RET_HEADS, RET_DV), rg, ret_gn_g[l]) @ w_ret_o[l]
        y_b = nsa(nq, kcr, vcr, ksl, vsl, kwn, vwn, ngate,
                  cmp_pos_k[l], cmp_w1_k[l], cmp_b1_k[l], cmp_w2_k[l],
                  cmp_pos_v[l], cmp_w1_v[l], cmp_b1_v[l], cmp_w2_v[l]) @ w_nsa_o[l]
        merged = jax.nn.sigmoid(ga) * y_a + jax.nn.sigmoid(gb) * y_b
        x = x + merged @ w_out[l]
        x = x + conv_ffn(rmsnorm(x, norm_ffn[l]), w_up[l], conv_w[l], conv_b[l], w_down[l])
    return rmsnorm(x, norm_final)
```

```cpp
#include <hip/hip_runtime.h>
#include <cstdio>
#include <cstdint>

constexpr int DM = 1024, NB = 16, S = 2048;
constexpr int RH = 4, RDK = 128, RDV = 256;
constexpr int NG = 2, NR = 4, NDK = 64, CBLK = 32, CSTR = 16, CHID = 256, SBLK = 64, TOPK = 8, WIN = 512;
constexpr int DFF = 2816, NIN = 6424;
constexpr int NC = S / CSTR - 1;
constexpr int NS = S / SBLK;
constexpr float EPS = 1e-6f;
constexpr int C_RQ = 0, C_RK = 512, C_RV = 1024, C_RG = 2048, C_NQ = 3072, C_KCR = 3584, C_VCR = 3712, C_KS = 3840, C_VS = 3968,
              C_KW = 4096, C_VW = 4224, C_GATE = 4352, C_GA = 4376, C_GB = 5400;

__device__ __forceinline__ float wave_sum(float v) {
#pragma unroll
    for (int o = 1; o < 64; o <<= 1) v += __shfl_xor(v, o);
    return v;
}
__device__ __forceinline__ float wave_max(float v) {
#pragma unroll
    for (int o = 1; o < 64; o <<= 1) v = fmaxf(v, __shfl_xor(v, o));
    return v;
}
__device__ __forceinline__ float gelu_tanh(float x) {
    const float c = 0.7978845608028654f;
    return 0.5f * x * (1.f + tanhf(c * (x + 0.044715f * x * x * x)));
}
__device__ __forceinline__ float sigmoidf(float x) { return 1.f / (1.f + expf(-x)); }

__global__ void __launch_bounds__(256) k_rms(const float* x, float* rs, int rows, int ld) {
    const int w = (blockIdx.x * 256 + threadIdx.x) >> 6, lane = threadIdx.x & 63;
    if (w >= rows) return;
    const float* r = x + (size_t)w * ld;
    float s = 0.f;
    for (int i = lane; i < DM; i += 64) { const float v = r[i]; s += v * v; }
    s = wave_sum(s);
    if (lane == 0) rs[w] = rsqrtf(s / DM + EPS);
}

template <class AF, class EF> struct GemmArgs { const float* B; int M, N, K, ldb; AF af; EF ef; };
template <class AF, class EF>
__global__ void __launch_bounds__(256) k_gemm(GemmArgs<AF, EF> ga) {
    const int M = ga.M, N = ga.N, K = ga.K, ldb = ga.ldb; const float* B = ga.B; const AF& af = ga.af; const EF& ef = ga.ef;
    __shared__ float As[16][68], Bs[16][68];
    const int tx = threadIdx.x & 15, ty = threadIdx.x >> 4;
    const int m0 = blockIdx.y * 64, n0 = blockIdx.x * 64;
    float acc[4][4];
#pragma unroll
    for (int i = 0; i < 4; ++i)
#pragma unroll
        for (int j = 0; j < 4; ++j) acc[i][j] = 0.f;
    for (int k0 = 0; k0 < K; k0 += 16) {
        for (int i = threadIdx.x; i < 1024; i += 256) { const int r = i >> 4, c = i & 15; As[c][r] = (m0 + r < M) ? af(m0 + r, k0 + c) : 0.f; }
        for (int i = threadIdx.x; i < 1024; i += 256) { const int r = i >> 6, c = i & 63; Bs[r][c] = (n0 + c < N) ? B[(size_t)(k0 + r) * ldb + n0 + c] : 0.f; }
        __syncthreads();
#pragma unroll
        for (int kk = 0; kk < 16; ++kk) {
            float a[4], b[4];
#pragma unroll
            for (int i = 0; i < 4; ++i) { a[i] = As[kk][ty * 4 + i]; b[i] = Bs[kk][tx * 4 + i]; }
#pragma unroll
            for (int i = 0; i < 4; ++i)
#pragma unroll
                for (int j = 0; j < 4; ++j) acc[i][j] += a[i] * b[j];
        }
        __syncthreads();
    }
#pragma unroll
    for (int i = 0; i < 4; ++i)
#pragma unroll
        for (int j = 0; j < 4; ++j) { const int r = m0 + ty * 4 + i, c = n0 + tx * 4 + j; if (r < M && c < N) ef(r, c, acc[i][j]); }
}

struct AfNorm { const float* x; const float* rs; const float* g; int ld; int pad; __device__ float operator()(int r, int k) const { return x[(size_t)r * ld + k] * rs[r] * g[k]; } };
struct AfPlain { const float* x; int ld; int pad; __device__ float operator()(int r, int k) const { return x[(size_t)r * ld + k]; } };
struct EfStore { float* o; int ld; int pad; __device__ void operator()(int r, int c, float v) const { o[(size_t)r * ld + c] = v; } };
struct EfMergeA { float* o; const float* proj; __device__ void operator()(int r, int c, float v) const { o[(size_t)r * DM + c] = sigmoidf(proj[(size_t)r * NIN + C_GA + c]) * v; } };
struct EfMergeB { float* o; const float* proj; __device__ void operator()(int r, int c, float v) const { o[(size_t)r * DM + c] += sigmoidf(proj[(size_t)r * NIN + C_GB + c]) * v; } };
struct EfResid { float* o; const float* base; __device__ void operator()(int r, int c, float v) const { o[(size_t)r * DM + c] = base[(size_t)r * DM + c] + v; } };

__global__ void __launch_bounds__(256) k_retention(const float* proj, const float* gn_g, float* aret) {
    __shared__ float Qs[32][129], Ks[16][129], Vs[16][256], Ps[32][17];
    const int qt = blockIdx.x, h = blockIdx.y, tid = threadIdx.x;
    const float lg = log1pf(-exp2f(-5.0f - (float)h));
    const float scale = 0.08838834764831845f;
    for (int i = tid; i < 32 * 128; i += 256) { const int r = i >> 7, c = i & 127; Qs[r][c] = proj[(size_t)(qt * 32 + r) * NIN + C_RQ + h * RDK + c]; }
    float acc[32];
#pragma unroll
    for (int e = 0; e < 32; ++e) acc[e] = 0.f;
    const int pi = tid >> 3, pj0 = (tid & 7) * 2;
    for (int kt = 0; kt <= 2 * qt + 1; ++kt) {
        __syncthreads();
        for (int i = tid; i < 16 * 128; i += 256) { const int r = i >> 7, c = i & 127; Ks[r][c] = proj[(size_t)(kt * 16 + r) * NIN + C_RK + h * RDK + c]; }
        for (int i = tid; i < 16 * 256; i += 256) { const int r = i >> 8, c = i & 255; Vs[r][c] = proj[(size_t)(kt * 16 + r) * NIN + C_RV + h * RDV + c]; }
        __syncthreads();
#pragma unroll
        for (int jj = 0; jj < 2; ++jj) {
            const int j = pj0 + jj; float d = 0.f;
            for (int c = 0; c < 128; ++c) d += Qs[pi][c] * Ks[j][c];
            const int diff = (qt * 32 + pi) - (kt * 16 + j);
            Ps[pi][j] = diff >= 0 ? d * scale * expf(lg * (float)diff) : 0.f;
        }
        __syncthreads();
        for (int j = 0; j < 16; ++j) {
            const float p = Ps[pi][j];
#pragma unroll
            for (int e = 0; e < 32; ++e) acc[e] += p * Vs[j][(tid & 7) + 8 * e];
        }
    }
    float s = 0.f;
#pragma unroll
    for (int e = 0; e < 32; ++e) s += acc[e];
    s += __shfl_xor(s, 1); s += __shfl_xor(s, 2); s += __shfl_xor(s, 4);
    const float mu = s / 256.f;
    float q = 0.f;
#pragma unroll
    for (int e = 0; e < 32; ++e) { const float d = acc[e] - mu; q += d * d; }
    q += __shfl_xor(q, 1); q += __shfl_xor(q, 2); q += __shfl_xor(q, 4);
    const float rstd = rsqrtf(q / 256.f + EPS);
    const int t = qt * 32 + pi;
#pragma unroll
    for (int e = 0; e < 32; ++e) {
        const int col = h * RDV + (tid & 7) + 8 * e;
        const float on = (acc[e] - mu) * rstd * gn_g[col];
        const float g = proj[(size_t)t * NIN + C_RG + col];
        aret[(size_t)t * 1024 + col] = g * sigmoidf(g) * on;
    }
}

__global__ void __launch_bounds__(256) k_compress(const float* proj, const float* pos, const float* w1, const float* b1, const float* w2, float* out, int colbase, int pad) {
    __shared__ float bv[CBLK * NDK], hid[CHID];
    const int c = blockIdx.x, g = blockIdx.y, tid = threadIdx.x;
    for (int i = tid; i < CBLK * NDK; i += 256) { const int ii = i >> 6, d = i & 63; bv[i] = proj[(size_t)(c * CSTR + ii) * NIN + colbase + g * NDK + d] + pos[i]; }
    __syncthreads();
    float a = b1[tid];
    for (int k = 0; k < CBLK * NDK; ++k) a += bv[k] * w1[(size_t)k * CHID + tid];
    hid[tid] = gelu_tanh(a);
    __syncthreads();
    if (tid < NDK) { float o = 0.f; for (int j = 0; j < CHID; ++j) o += hid[j] * w2[j * NDK + tid]; out[((size_t)g * NC + c) * NDK + tid] = o; }
}

__global__ void __launch_bounds__(256) k_cmp_attn(const float* proj, const float* kcmp, const float* vcmp, float* ocmp, unsigned* selmask) {
    __shared__ float qs[4][NR][NDK], ps[4][NR][128];
    const int w = threadIdx.x >> 6, lane = threadIdx.x & 63;
    const int gt = blockIdx.x * 4 + w, g = gt & 1, t = gt >> 1;
    for (int r = 0; r < NR; ++r) qs[w][r][lane] = proj[(size_t)t * NIN + C_NQ + (g * NR + r) * NDK + lane];
    __syncthreads();
    for (int r = 0; r < NR; ++r) {
        const int h = g * NR + r; const float slope = exp2f(-(float)(h + 1));
        float sc[2]; bool val[2];
#pragma unroll
        for (int u = 0; u < 2; ++u) {
            const int c = lane + 64 * u; sc[u] = -1e30f; val[u] = false;
            if (c < NC) {
                float d = 0.f; const float* kr = kcmp + ((size_t)g * NC + c) * NDK;
                for (int x = 0; x < NDK; ++x) d += qs[w][r][x] * kr[x];
                const int dc = t - (c * CSTR + CBLK - 1);
                if (dc >= 0) { val[u] = true; sc[u] = d * 0.125f - slope * (float)dc; }
            }
        }
        const float m = wave_max(fmaxf(sc[0], sc[1]));
        float p0 = val[0] ? expf(sc[0] - m) : 0.f, p1 = val[1] ? expf(sc[1] - m) : 0.f;
        const float sum = wave_sum(p0 + p1);
        const float inv = sum > 0.f ? 1.f / sum : 0.f;
        p0 *= inv; p1 *= inv;
        ps[w][r][lane] = p0; ps[w][r][lane + 64] = p1;
    }
    __syncthreads();
    for (int r = 0; r < NR; ++r) {
        float o = 0.f;
        for (int c = 0; c < NC; ++c) o += ps[w][r][c] * vcmp[((size_t)g * NC + c) * NDK + lane];
        ocmp[(size_t)t * 512 + (g * NR + r) * NDK + lane] = o;
    }
    float imp = 0.f; const int j = lane & 31;
    for (int r = 0; r < NR; ++r)
        for (int c = 4 * j - 1; c <= 4 * j + 3; ++c) if (c >= 0 && c < NC) imp += ps[w][r][c];
    const int cur = t >> 6;
    if (j == 0 || j == cur || j == cur - 1) imp = 1e9f;
    if (j > cur) imp = -1e9f;
    int rank = 0;
    for (int i = 0; i < NS; ++i) { const float o = __shfl(imp, i); rank += (o > imp || (o == imp && i < j)) ? 1 : 0; }
    const unsigned long long bal = __ballot(rank < TOPK && lane < 32 && j <= cur);
    if (lane == 0) selmask[t * NG + g] = (unsigned)bal;
}

template <bool IS_WIN>
__global__ void __launch_bounds__(256) k_attn(const float* proj, int kcol, int vcol, const unsigned* selmask, float* out) {
    __shared__ float qs[NR][NDK], scs[NR][9 * 64]; __shared__ int blks[NR][9];
    const int r = threadIdx.x >> 6, lane = threadIdx.x & 63;
    const int g = blockIdx.x & 1, t = blockIdx.x >> 1, h = g * NR + r, cur = t >> 6;
    const float slope = exp2f(-(float)(h + 1));
    qs[r][lane] = proj[(size_t)t * NIN + C_NQ + h * NDK + lane];
    unsigned mask;
    if (IS_WIN) { const int lo = (t - (WIN - 1)) > 0 ? ((t - (WIN - 1)) >> 6) : 0; mask = 0u; for (int j = lo; j <= cur; ++j) mask |= 1u << j; }
    else mask = selmask[t * NG + g];
    int nb = 0;
    for (int j = 0; j < NS; ++j) if ((mask >> j) & 1u) { if (lane == 0) blks[r][nb] = j; ++nb; }
    __syncthreads();
    float m = -1e30f;
    for (int b = 0; b < nb; ++b) {
        const int s = blks[r][b] * 64 + lane; const int d = t - s;
        const bool valid = d >= 0 && (!IS_WIN || d < WIN);
        float sc = -1e30f;
        if (valid) { float dot = 0.f; const float* kr = proj + (size_t)s * NIN + kcol + g * NDK; for (int x = 0; x < NDK; ++x) dot += qs[r][x] * kr[x]; sc = dot * 0.125f - slope * (float)d; }
        scs[r][b * 64 + lane] = sc; m = fmaxf(m, sc);
    }
    m = wave_max(m);
    float sum = 0.f;
    for (int b = 0; b < nb; ++b) { const float sc = scs[r][b * 64 + lane]; const float p = sc > -1e29f ? expf(sc - m) : 0.f; scs[r][b * 64 + lane] = p; sum += p; }
    sum = wave_sum(sum);
    __syncthreads();
    float o = 0.f;
    for (int b = 0; b < nb; ++b) {
        const int s0 = blks[r][b] * 64;
        for (int i = 0; i < 64; ++i) { const float p = scs[r][b * 64 + i]; if (p != 0.f) o += p * proj[(size_t)(s0 + i) * NIN + vcol + g * NDK + lane]; }
    }
    out[(size_t)t * 512 + h * NDK + lane] = o / sum;
}

__global__ void __launch_bounds__(256) k_nsa_combine(const float* proj, const float* ocmp, const float* osel, const float* owin, float* nsao) {
    const int i = blockIdx.x * 256 + threadIdx.x; if (i >= S * 512) return;
    const int t = i >> 9, h = (i & 511) >> 6;
    const float* gp = proj + (size_t)t * NIN + C_GATE;
    nsao[i] = sigmoidf(gp[h]) * ocmp[i] + sigmoidf(gp[8 + h]) * osel[i] + sigmoidf(gp[16 + h]) * owin[i];
}

__global__ void __launch_bounds__(256) k_convgate(const float* up, const float* cw, const float* cb, float* hmid) {
    const int i = blockIdx.x * 256 + threadIdx.x; if (i >= S * DFF) return;
    const int t = i / DFF, f = i % DFF;
    float ac = cb[f] + cw[2 * DFF + f] * up[(size_t)t * (2 * DFF) + f];
    if (t >= 1) ac += cw[1 * DFF + f] * up[(size_t)(t - 1) * (2 * DFF) + f];
    if (t >= 2) ac += cw[0 * DFF + f] * up[(size_t)(t - 2) * (2 * DFF) + f];
    hmid[i] = gelu_tanh(ac) * up[(size_t)t * (2 * DFF) + DFF + f];
}

__global__ void __launch_bounds__(256) k_final(float* x, const float* g, int rows, int pad) {
    const int w = (blockIdx.x * 256 + threadIdx.x) >> 6, lane = threadIdx.x & 63;
    if (w >= rows) return;
    float* r = x + (size_t)w * DM;
    float s = 0.f;
    for (int i = lane; i < DM; i += 64) { const float v = r[i]; s += v * v; }
    s = wave_sum(s);
    const float rs = rsqrtf(s / DM + EPS);
    for (int i = lane; i < DM; i += 64) r[i] = r[i] * rs * g[i];
}

template <class AF, class EF>
static void gemm(hipStream_t st, int M, int N, int K, const float* B, int ldb, AF af, EF ef) {
    dim3 grid((N + 63) / 64, (M + 63) / 64);
    GemmArgs<AF, EF> ga{}; ga.B = B; ga.M = M; ga.N = N; ga.K = K; ga.ldb = ldb; ga.af = af; ga.ef = ef;
    hipLaunchKernelGGL((k_gemm<AF, EF>), grid, dim3(256), 0, st, ga);
}

extern "C" void kernel_launch(void* const* d_in, const int* in_sizes, int n_in, void* d_out, int out_size, void* d_ws, size_t ws_size, hipStream_t stream) {
    const float* x = (const float*)d_in[0];
    const float* norm_mix = (const float*)d_in[1];
    const float* w_in = (const float*)d_in[2];
    const float* ret_gn_g = (const float*)d_in[3];
    const float* cmp_pos_k = (const float*)d_in[4];
    const float* cmp_w1_k = (const float*)d_in[5];
    const float* cmp_b1_k = (const float*)d_in[6];
    const float* cmp_w2_k = (const float*)d_in[7];
    const float* cmp_pos_v = (const float*)d_in[8];
    const float* cmp_w1_v = (const float*)d_in[9];
    const float* cmp_b1_v = (const float*)d_in[10];
    const float* cmp_w2_v = (const float*)d_in[11];
    const float* w_ret_o = (const float*)d_in[12];
    const float* w_nsa_o = (const float*)d_in[13];
    const float* w_out = (const float*)d_in[14];
    const float* norm_ffn = (const float*)d_in[15];
    const float* w_up = (const float*)d_in[16];
    const float* conv_w = (const float*)d_in[17];
    const float* conv_b = (const float*)d_in[18];
    const float* w_down = (const float*)d_in[19];
    const float* norm_final = (const float*)d_in[20];
    float* out = (float*)d_out;

    float* ws = (float*)d_ws;
    size_t off = 0;
    auto take = [&](size_t n) { float* p = ws + off; off += (n + 63) & ~(size_t)63; return p; };
    float* rs1 = take(S);
    float* proj = take((size_t)S * NIN);
    float* aret = take((size_t)S * 1024);
    float* kcmp = take((size_t)NG * NC * NDK);
    float* vcmp = take((size_t)NG * NC * NDK);
    float* ocmp = take((size_t)S * 512);
    float* osel = take((size_t)S * 512);
    float* owin = take((size_t)S * 512);
    unsigned* selmask = (unsigned*)take((size_t)S * NG);
    float* nsao = take((size_t)S * 512);
    float* merged = take((size_t)S * 1024);
    float* rs2 = take(S);
    float* up = take((size_t)S * 2 * DFF);
    float* hmid = take((size_t)S * DFF);

    for (int b = 0; b < NB; ++b) {
        const float* xb = x + (size_t)b * S * DM;
        float* ob = out + (size_t)b * S * DM;
        hipLaunchKernelGGL(k_rms, dim3(S / 4), dim3(256), 0, stream, xb, rs1, S, DM);
        gemm(stream, S, NIN, DM, w_in, NIN, AfNorm{xb, rs1, norm_mix, DM, 0}, EfStore{proj, NIN, 0});
        hipLaunchKernelGGL(k_retention, dim3(S / 32, RH), dim3(256), 0, stream, (const float*)proj, ret_gn_g, aret);
        hipLaunchKernelGGL(k_compress, dim3(NC, NG), dim3(256), 0, stream, (const float*)proj, cmp_pos_k, cmp_w1_k, cmp_b1_k, cmp_w2_k, kcmp, C_KCR, 0);
        hipLaunchKernelGGL(k_compress, dim3(NC, NG), dim3(256), 0, stream, (const float*)proj, cmp_pos_v, cmp_w1_v, cmp_b1_v, cmp_w2_v, vcmp, C_VCR, 0);
        hipLaunchKernelGGL(k_cmp_attn, dim3(S * NG / 4), dim3(256), 0, stream, (const float*)proj, (const float*)kcmp, (const float*)vcmp, ocmp, selmask);
        hipLaunchKernelGGL((k_attn<false>), dim3(S * NG), dim3(256), 0, stream, (const float*)proj, C_KS, C_VS, (const unsigned*)selmask, osel);
        hipLaunchKernelGGL((k_attn<true>), dim3(S * NG), dim3(256), 0, stream, (const float*)proj, C_KW, C_VW, (const unsigned*)selmask, owin);
        hipLaunchKernelGGL(k_nsa_combine, dim3(S * 512 / 256), dim3(256), 0, stream, (const float*)proj, (const float*)ocmp, (const float*)osel, (const float*)owin, nsao);
        gemm(stream, S, DM, 1024, w_ret_o, DM, AfPlain{aret, 1024, 0}, EfMergeA{merged, proj});
        gemm(stream, S, DM, 512, w_nsa_o, DM, AfPlain{nsao, 512, 0}, EfMergeB{merged, proj});
        gemm(stream, S, DM, DM, w_out, DM, AfPlain{merged, DM, 0}, EfResid{ob, xb});
        hipLaunchKernelGGL(k_rms, dim3(S / 4), dim3(256), 0, stream, (const float*)ob, rs2, S, DM);
        gemm(stream, S, 2 * DFF, DM, w_up, 2 * DFF, AfNorm{ob, rs2, norm_ffn, DM, 0}, EfStore{up, 2 * DFF, 0});
        hipLaunchKernelGGL(k_convgate, dim3((S * DFF + 255) / 256), dim3(256), 0, stream, (const float*)up, conv_w, conv_b, hmid);
        gemm(stream, S, DM, DFF, w_down, DM, AfPlain{hmid, DFF, 0}, EfResid{ob, ob});
        hipLaunchKernelGGL(k_final, dim3(S / 4), dim3(256), 0, stream, ob, norm_final, S, 0);
    }
}
```

```cpp
#include <hip/hip_runtime.h>
#include <cstdio>
#include <cstdint>
namespace pg8 {
#define PG8_LAS __attribute__((address_space(3)))
typedef unsigned short bf16_t;
typedef short bf16x8 __attribute__((ext_vector_type(8)));
typedef float f32x4 __attribute__((ext_vector_type(4)));
typedef unsigned u32x4 __attribute__((ext_vector_type(4)));
constexpr int BM = 256, BK = 64, HALF = 128, HTB = HALF * BK * 2  , STAGE_BYTES = 8 * HTB, NXCD = 8, WGM = 8;

__host__ __device__ __forceinline__ int lds_byte(int r, int c) { const int st = (r >> 4) * 2 + (c >> 5), rr = r & 15, cc = c & 31, ob = rr * 64 + cc * 2; return st * 1024 + (ob ^ (((ob >> 9) & 1) << 5)); }
__host__ __device__ __forceinline__ void stage_rc(int b, int& R, int& C) { const int st = b / 1024, sb = b % 1024, swz = sb ^ (((sb >> 9) & 1) << 5); R = (st >> 1) * 16 + swz / 64; C = (st & 1) * 32 + (swz % 64) / 2; }
__host__ __device__ __forceinline__ int perm32(int rho) { const int n = rho >> 4, i = rho & 15; return 8 * (i >> 2) + 4 * n + (i & 3); }

struct Unit { int pm, pn; };
struct Gemm { const bf16_t* A; const bf16_t* Bt; int lda, K, ks1, ks2; };

struct StaticOrder {
    int nM, nN, nwg, G, c;
    __host__ __device__ void init(int M, int N, int G_, int c_) { nM = M / BM; nN = N / BM; nwg = nM * nN; G = G_; c = c_; }
    __host__ __device__ bool next(int i, Unit& u) const {
        const long L = (long)i * G + c; if (L >= nwg) return false;
        int wgid = (int)L; { const int q = nwg / NXCD, r = nwg % NXCD, xcd = wgid % NXCD, off = wgid / NXCD; wgid = (xcd < r ? xcd * (q + 1) : r * (q + 1) + (xcd - r) * q) + off; }
        const int nig = WGM * nN, gid = wgid / nig, fm = gid * WGM, gsz = (nM - fm) < WGM ? (nM - fm) : WGM;
        u.pm = fm + ((wgid % nig) % gsz); u.pn = (wgid % nig) / gsz; return true;
    }
    __device__ __forceinline__ void a_ready(const Unit&) const {}
    __device__ __forceinline__ void done(const Unit&) const {}
};

__device__ __forceinline__ unsigned cvt_pk_bf16(float lo, float hi) { unsigned r; asm volatile("v_cvt_pk_bf16_f32 %0, %1, %2" : "=v"(r) : "v"(lo), "v"(hi)); return r; }
__device__ __forceinline__ float bf_lo(unsigned u) { return __builtin_bit_cast(float, u << 16); }
__device__ __forceinline__ float bf_hi(unsigned u) { return __builtin_bit_cast(float, u & 0xffff0000u); }
__device__ __forceinline__ float fsig(float x) { return __builtin_amdgcn_rcpf(1.f + __builtin_amdgcn_exp2f(-1.4426950408889634f * x)); }

template <int MODE> struct EpiRowScale {
    static constexpr bool PERM = true, AFTER_DRAIN = false;
    bf16_t* O; int ldc; const float* rs;
    __device__ __forceinline__ void operator()(const f32x4 (&acc)[2][2][4][2], const Unit& u, int wr, int wc, int fr, int fq) const {
        const int row0 = u.pm * BM + wr * 64 + fr, col0 = u.pn * BM + wc * 32 + 8 * fq;
#pragma unroll
        for (int ai = 0; ai < 2; ++ai)
#pragma unroll
            for (int m = 0; m < 4; ++m) { const int row = row0 + ai * HALF + m * 16; float s = 1.f;
                if (MODE == 1) s = __builtin_amdgcn_rsqf(rs[row] * (1.0f / 1024.0f) + 1e-6f);
                bf16_t* rowp = O + (size_t)row * ldc + col0;
#pragma unroll
                for (int bj = 0; bj < 2; ++bj) { const f32x4 v0 = acc[ai][bj][m][0] * s, v1 = acc[ai][bj][m][1] * s;
                    u32x4 w; w.x = cvt_pk_bf16(v0[0], v0[1]); w.y = cvt_pk_bf16(v0[2], v0[3]); w.z = cvt_pk_bf16(v1[0], v1[1]); w.w = cvt_pk_bf16(v1[2], v1[3]);
                    *(u32x4*)(rowp + bj * HALF) = w; } }
    }
};
template <bool FIRST> struct EpiMerge {
    static constexpr bool PERM = true, AFTER_DRAIN = false;
    bf16_t* O; const bf16_t* G; int ldc;
    __device__ __forceinline__ void operator()(const f32x4 (&acc)[2][2][4][2], const Unit& u, int wr, int wc, int fr, int fq) const {
        const int row0 = u.pm * BM + wr * 64 + fr, col0 = u.pn * BM + wc * 32 + 8 * fq;
#pragma unroll
        for (int ai = 0; ai < 2; ++ai)
#pragma unroll
            for (int m = 0; m < 4; ++m) { const size_t off = (size_t)(row0 + ai * HALF + m * 16) * ldc + col0;
#pragma unroll
                for (int bj = 0; bj < 2; ++bj) { const u32x4 gv = *(const u32x4*)(G + off + bj * HALF);
                    const f32x4 v0 = acc[ai][bj][m][0], v1 = acc[ai][bj][m][1];
                    float r[8];
                    r[0] = fsig(bf_lo(gv.x)) * v0[0]; r[1] = fsig(bf_hi(gv.x)) * v0[1]; r[2] = fsig(bf_lo(gv.y)) * v0[2]; r[3] = fsig(bf_hi(gv.y)) * v0[3];
                    r[4] = fsig(bf_lo(gv.z)) * v1[0]; r[5] = fsig(bf_hi(gv.z)) * v1[1]; r[6] = fsig(bf_lo(gv.w)) * v1[2]; r[7] = fsig(bf_hi(gv.w)) * v1[3];
                    if (!FIRST) { const u32x4 pv = *(const u32x4*)(O + off + bj * HALF);
                        r[0] += bf_lo(pv.x); r[1] += bf_hi(pv.x); r[2] += bf_lo(pv.y); r[3] += bf_hi(pv.y); r[4] += bf_lo(pv.z); r[5] += bf_hi(pv.z); r[6] += bf_lo(pv.w); r[7] += bf_hi(pv.w); }
                    u32x4 w; w.x = cvt_pk_bf16(r[0], r[1]); w.y = cvt_pk_bf16(r[2], r[3]); w.z = cvt_pk_bf16(r[4], r[5]); w.w = cvt_pk_bf16(r[6], r[7]);
                    *(u32x4*)(O + off + bj * HALF) = w; } }
    }
};
template <bool WB16> struct EpiResid {
    static constexpr bool PERM = false, AFTER_DRAIN = false;
    const float* X; float* X1; bf16_t* Xb; int ldb; float* sumsq;
    __device__ __forceinline__ void operator()(const f32x4 (&acc)[2][2][4][2], const Unit& u, int wr, int wc, int fr, int fq) const {
        const int row0 = u.pm * BM + wr * 64 + fr, col0 = u.pn * BM + wc * 32 + 4 * fq;
#pragma unroll
        for (int ai = 0; ai < 2; ++ai)
#pragma unroll
            for (int m = 0; m < 4; ++m) { const int row = row0 + ai * HALF + m * 16; float ss = 0.f;
#pragma unroll
                for (int bj = 0; bj < 2; ++bj)
#pragma unroll
                    for (int n = 0; n < 2; ++n) { const int c = col0 + bj * HALF + n * 16;
                        const f32x4 x = *(const f32x4*)(X + (size_t)row * 1024 + c) + acc[ai][bj][m][n];
                        *(f32x4*)(X1 + (size_t)row * 1024 + c) = x;
                        ss += (x[0] * x[0] + x[1] * x[1]) + (x[2] * x[2] + x[3] * x[3]);
                        if (WB16) { unsigned long long w = (unsigned long long)cvt_pk_bf16(x[0], x[1]) | ((unsigned long long)cvt_pk_bf16(x[2], x[3]) << 32);
                            *(unsigned long long*)(Xb + (size_t)row * ldb + c) = w; } }
                ss += __shfl_xor(ss, 16); ss += __shfl_xor(ss, 32);
                if (fq == 0) atomicAdd(sumsq + row, ss); }
    }
};

template <class Epi, class Sched, bool ALIGN_EPI = false, bool SP2 = false>
__device__ __forceinline__ void gemm_phase(PG8_LAS unsigned char* lds, const Gemm g, const Sched& S, const Epi& E) {
    const int tid = threadIdx.x, wid = __builtin_amdgcn_readfirstlane(tid >> 6), lane = tid & 63, wr = wid >> 2, wc = wid & 3, fr = lane & 15, fq = lane >> 4;
    const int K = g.K, nt = K / BK;
    unsigned voffA[2], voffB[2];
#pragma unroll
    for (int i = 0; i < 2; ++i) { int R, C; stage_rc(tid * 16 + i * 8192, R, C); const int Rb = Epi::PERM ? ((R & ~31) + perm32(R & 31)) : R;
        voffA[i] = (unsigned)(R * g.lda + C) * 2u; voffB[i] = (unsigned)(Rb * K + C) * 2u; }
    const size_t kstep = (size_t)(BK * 2);
    const size_t hstepB = (size_t)HALF * K * 2, hstepA = (size_t)HALF * g.lda * 2, ks1 = (size_t)g.ks1, ks2 = (size_t)g.ks2;
    const size_t tstepA = 2 * hstepA, tstepB = 2 * hstepB;
    const unsigned ldsw = (unsigned)wid * 1024u;
    const int aoff = lds_byte(wr * 64 + fr, fq * 8), boff = lds_byte(wc * 32 + fr, fq * 8);
#define PG8_SA(b, h) (((b) * 2 + (h)) * HTB)
#define PG8_SB(b, h) ((4 + (b) * 2 + (h)) * HTB)
#define PG8_STAGE(bufoff, gbase, voff) do { _Pragma("unroll") for (int _i = 0; _i < 2; ++_i) \
        __builtin_amdgcn_global_load_lds((const unsigned*)((const char*)(gbase) + (voff)[_i]), (PG8_LAS unsigned*)(lds + (bufoff) + ldsw + _i * 8192), 16, 0, 0); } while (0)
#define PG8_LDA(dst, b, h) do { _Pragma("unroll") for (int m = 0; m < 4; ++m) _Pragma("unroll") for (int k = 0; k < 2; ++k) dst[m][k] = *(const PG8_LAS bf16x8*)(lds + PG8_SA(b, h) + aoff + m * 2048 + k * 1024); } while (0)
#define PG8_LDB(dst, b, h) do { _Pragma("unroll") for (int n = 0; n < 2; ++n) _Pragma("unroll") for (int k = 0; k < 2; ++k) dst[n][k] = *(const PG8_LAS bf16x8*)(lds + PG8_SB(b, h) + boff + n * 2048 + k * 1024); } while (0)
#define PG8_MMA(ai, bj, At, Bt) do { __builtin_amdgcn_s_setprio(1); _Pragma("unroll") for (int m = 0; m < 4; ++m) _Pragma("unroll") for (int n = 0; n < 2; ++n) _Pragma("unroll") for (int k = 0; k < 2; ++k) \
        acc[ai][bj][m][n] = __builtin_amdgcn_mfma_f32_16x16x32_bf16(Bt[n][k], At[m][k], acc[ai][bj][m][n], 0, 0, 0); __builtin_amdgcn_s_setprio(0); } while (0)
#define PG8_WAIT_V(n) asm volatile("s_waitcnt vmcnt(" #n ")" ::: "memory")
#define PG8_WAIT_L(n) asm volatile("s_waitcnt lgkmcnt(" #n ")" ::: "memory")
#define PG8_BAR __builtin_amdgcn_s_barrier()
#define PG8_SCHED __builtin_amdgcn_sched_barrier(0)
    Unit cur, nxt; int ui = 0;
    if (!S.next(0, cur)) return;
    f32x4 acc[2][2][4][2];
#pragma unroll
    for (int a = 0; a < 2; ++a)
#pragma unroll
        for (int b = 0; b < 2; ++b)
#pragma unroll
            for (int m = 0; m < 4; ++m)
#pragma unroll
                for (int n = 0; n < 2; ++n) acc[a][b][m][n] = (f32x4){0.f, 0.f, 0.f, 0.f};
    bf16x8 At[4][2], B0[2][2], B1[2][2];
    const char* cA = (const char*)g.A + (size_t)cur.pm * tstepA; const char* cB = (const char*)g.Bt + (size_t)cur.pn * tstepB;
    S.a_ready(cur);
    if constexpr (SP2) {
        PG8_STAGE(PG8_SB(0, 0), cB, voffB); PG8_STAGE(PG8_SB(0, 1), cB + hstepB, voffB); PG8_STAGE(PG8_SA(0, 0), cA, voffA); PG8_STAGE(PG8_SA(0, 1), cA + hstepA, voffA);
        if (wr == 1) PG8_BAR;
        PG8_WAIT_V(2); PG8_BAR;
        PG8_STAGE(PG8_SB(1, 0), cB + kstep, voffB); PG8_STAGE(PG8_SA(1, 0), cA + ks1, voffA); PG8_STAGE(PG8_SB(1, 1), cB + hstepB + kstep, voffB);
        PG8_WAIT_V(6); PG8_BAR;
    } else {
        PG8_STAGE(PG8_SB(0, 0), cB, voffB); PG8_STAGE(PG8_SA(0, 0), cA, voffA); PG8_STAGE(PG8_SB(0, 1), cB + hstepB, voffB); PG8_STAGE(PG8_SA(0, 1), cA + hstepA, voffA);
        if (wr == 1) PG8_BAR;
        PG8_WAIT_V(4); PG8_BAR;
        PG8_STAGE(PG8_SB(1, 0), cB + kstep, voffB); PG8_STAGE(PG8_SA(1, 0), cA + ks1, voffA); PG8_STAGE(PG8_SB(1, 1), cB + hstepB + kstep, voffB);
        PG8_WAIT_V(6); PG8_BAR;
    }
    for (;;) {
        const bool has_next = S.next(ui + 1, nxt);
        const char* nA = has_next ? (const char*)g.A + (size_t)nxt.pm * tstepA : cA; const char* nB = has_next ? (const char*)g.Bt + (size_t)nxt.pn * tstepB : cB;
        for (int t = 0; t < nt; t += 2) {
            const bool last = (t == nt - 2);
            const char* a1 = cA + (size_t)(t >> 1) * ks2 + ks1;
            const char* a2 = last ? nA : cA + (size_t)((t + 2) >> 1) * ks2; const char* b2 = last ? nB : cB + (size_t)(t + 2) * kstep;
            const char* a3 = a2 + ks1; const char* b3 = b2 + kstep;
            if (last && has_next) S.a_ready(nxt);
            if constexpr (SP2) {
            PG8_LDB(B0, 0, 0); PG8_LDB(B1, 0, 1); PG8_SCHED; PG8_LDA(At, 0, 0); PG8_STAGE(PG8_SA(1, 1), a1 + hstepA, voffA);
            PG8_WAIT_V(8); PG8_WAIT_L(0); PG8_BAR; PG8_MMA(0, 0, At, B0); PG8_MMA(0, 1, At, B1); PG8_BAR; PG8_SCHED;
            PG8_LDA(At, 0, 1); PG8_STAGE(PG8_SB(0, 0), b2, voffB); PG8_STAGE(PG8_SB(0, 1), b2 + hstepB, voffB); PG8_STAGE(PG8_SA(0, 0), a2, voffA);
            PG8_WAIT_V(8); PG8_WAIT_L(0); PG8_BAR; PG8_MMA(1, 0, At, B0); PG8_MMA(1, 1, At, B1); PG8_BAR; PG8_SCHED;
            PG8_LDB(B0, 1, 0); PG8_LDB(B1, 1, 1); PG8_SCHED; PG8_LDA(At, 1, 0); PG8_STAGE(PG8_SA(0, 1), a2 + hstepA, voffA);
            PG8_WAIT_V(8); PG8_WAIT_L(0); PG8_BAR; PG8_MMA(0, 0, At, B0); PG8_MMA(0, 1, At, B1); PG8_BAR; PG8_SCHED;
            PG8_LDA(At, 1, 1); PG8_STAGE(PG8_SB(1, 0), b3, voffB); PG8_STAGE(PG8_SB(1, 1), b3 + hstepB, voffB); PG8_STAGE(PG8_SA(1, 0), a3, voffA);
            PG8_WAIT_V(8); PG8_WAIT_L(0); PG8_BAR; PG8_MMA(1, 0, At, B0); PG8_MMA(1, 1, At, B1); PG8_BAR; PG8_SCHED;
            } else {
            PG8_LDB(B0, 0, 0); PG8_SCHED; PG8_LDA(At, 0, 0); PG8_STAGE(PG8_SA(1, 1), a1 + hstepA, voffA);
            PG8_WAIT_L(8); PG8_BAR; PG8_WAIT_L(0); PG8_MMA(0, 0, At, B0); PG8_BAR; PG8_SCHED;
            PG8_LDB(B1, 0, 1); PG8_STAGE(PG8_SB(0, 0), b2, voffB);
            PG8_BAR; PG8_WAIT_L(0); PG8_MMA(0, 1, At, B1); PG8_BAR;
            PG8_LDA(At, 0, 1); PG8_STAGE(PG8_SA(0, 0), a2, voffA);
            PG8_BAR; PG8_WAIT_L(0); PG8_MMA(1, 0, At, B0); PG8_BAR; PG8_SCHED;
            PG8_STAGE(PG8_SB(0, 1), b2 + hstepB, voffB);
            PG8_WAIT_V(6); PG8_BAR; PG8_MMA(1, 1, At, B1); PG8_BAR;
            PG8_LDB(B0, 1, 0); PG8_SCHED; PG8_LDA(At, 1, 0); PG8_STAGE(PG8_SA(0, 1), a2 + hstepA, voffA);
            PG8_WAIT_L(8); PG8_BAR; PG8_WAIT_L(0); PG8_MMA(0, 0, At, B0); PG8_BAR; PG8_SCHED;
            PG8_LDB(B1, 1, 1); PG8_STAGE(PG8_SB(1, 0), b3, voffB);
            PG8_BAR; PG8_WAIT_L(0); PG8_MMA(0, 1, At, B1); PG8_BAR;
            PG8_LDA(At, 1, 1); PG8_STAGE(PG8_SA(1, 0), a3, voffA);
            PG8_BAR; PG8_WAIT_L(0); PG8_MMA(1, 0, At, B0); PG8_BAR; PG8_SCHED;
            PG8_STAGE(PG8_SB(1, 1), b3 + hstepB, voffB);
            PG8_WAIT_V(6); PG8_BAR; PG8_MMA(1, 1, At, B1); PG8_BAR;
            }
        }
        if constexpr (ALIGN_EPI) { if (wr == 0) PG8_BAR; }
        if constexpr (!Epi::AFTER_DRAIN) { E(acc, cur, wr, wc, fr, fq); S.done(cur); }
        if (!has_next) break;
#pragma unroll
        for (int a = 0; a < 2; ++a)
#pragma unroll
            for (int b = 0; b < 2; ++b)
#pragma unroll
                for (int m = 0; m < 4; ++m)
#pragma unroll
                    for (int n = 0; n < 2; ++n) acc[a][b][m][n] = (f32x4){0.f, 0.f, 0.f, 0.f};
        cur = nxt; cA = nA; cB = nB; ++ui;
        if constexpr (ALIGN_EPI) { if (wr == 1) PG8_BAR; }
    }
    PG8_WAIT_V(0);
    if constexpr (!ALIGN_EPI) { if (wr == 0) PG8_BAR; }
    PG8_BAR;
    if constexpr (Epi::AFTER_DRAIN) { E.fused(acc, cur, wr, wc, fr, fq, lds, wid, lane); S.done(cur); }
#undef PG8_SA
#undef PG8_SB
#undef PG8_STAGE
#undef PG8_LDA
#undef PG8_LDB
#undef PG8_MMA
#undef PG8_WAIT_V
#undef PG8_WAIT_L
#undef PG8_BAR
#undef PG8_SCHED
}
}
constexpr int M = 32768, DM = 1024, SEQ = 2048, NBATCH = 16;
constexpr int RH = 4, RDK = 128, RDV = 256;
constexpr int NG = 2, NR = 4, NDK = 64, CBLK = 32, CSTR = 16, CHID = 256, TOPK = 8, WIN = 512;
constexpr int DFF = 2816, NIN = 6424;
constexpr int NC = SEQ / CSTR - 1;
constexpr int NS = SEQ / 64;
constexpr float EPS = 1e-6f;
constexpr int C_GATE = 4352, C_GA = 4376, C_GB = 5400;
constexpr int PP = 6656;
constexpr int PC_RQ = 0, PC_RK = 512, PC_RV = 1024, PC_RG = 2048, PC_NQ = 3072, PC_KCR = 3584, PC_VCR = 3712, PC_KS = 3840, PC_VS = 3968,
              PC_KW = 4096, PC_VW = 4224, PC_GA = 4352, PC_GB = 5376, PC_GATE = 6400;
constexpr int PC_MERGED = 1024, PC_X1B = 0, PC_UP = 1024;
constexpr int NPAD_IN = 6656, NUP = 2 * DFF;
constexpr size_t MiB = 1u << 20;
constexpr size_t WS_CTL = 0, CTL_ZERO_BYTES = 1 * MiB;
constexpr size_t WS_RS2 = 256 * 1024, WS_RS3 = 512 * 1024;
constexpr size_t WS_WIN = 1 * MiB, WS_WUP = 14 * MiB, WS_WDN = 25 * MiB, WS_WRO = 31 * MiB, WS_WNO = 33 * MiB, WS_WOUT = 34 * MiB;
constexpr size_t WS_KCMP = 39 * MiB, WS_VCMP = 41 * MiB, WS_SEL = 43 * MiB;
constexpr size_t WS_PROJ = 48 * MiB;
constexpr size_t WS_END = WS_PROJ + (size_t)(M + 32) * PP * 2;
static_assert(WS_END <= 512 * MiB, "d_ws map");
constexpr int CW_BAR = 4096;
constexpr size_t DO_XB = 0, DO_NSA = 64 * MiB;

constexpr int LDS_BYTES = 147456;
constexpr int MISC_OFF = 131072 + 320;

typedef unsigned short bf16;
typedef unsigned v4u __attribute__((ext_vector_type(4)));
typedef float f32x4 __attribute__((ext_vector_type(4)));
#define GAS __attribute__((address_space(1)))
#define LDS_WAIT() asm volatile("s_waitcnt lgkmcnt(0)" ::: "memory")
__device__ __forceinline__ unsigned f2bf(float f) { unsigned u = __builtin_bit_cast(unsigned, f); return (u + 0x7fffu + ((u >> 16) & 1u)) >> 16; }
__device__ __forceinline__ unsigned pk2(float lo, float hi) { return f2bf(lo) | (f2bf(hi) << 16); }
__device__ __forceinline__ float bf2f(bf16 v) { return __builtin_bit_cast(float, (unsigned)v << 16); }
__device__ __forceinline__ float wave_sum(float v) {
#pragma unroll
    for (int o = 1; o < 64; o <<= 1) v += __shfl_xor(v, o);
    return v;
}
__device__ __forceinline__ float wave_max(float v) {
#pragma unroll
    for (int o = 1; o < 64; o <<= 1) v = fmaxf(v, __shfl_xor(v, o));
    return v;
}
__device__ __forceinline__ float gelu_tanh(float x) { const float c = 0.7978845608028654f; return 0.5f * x * (1.f + tanhf(c * (x + 0.044715f * x * x * x))); }
__device__ __forceinline__ float sigmoidf_(float x) { return 1.f / (1.f + expf(-x)); }

#define XB_TMO      128
#define XB_XCNT(j)  (256  + 64 * (j))
#define XB_XSUB(j)  (1280 + 64 * (j))
#define XB_XGEN(j)  (2304 + 64 * (j))
#define XB_TOP      3328
#define XB_TOPGEN   3392
#define XCD_BAR_WORDS 3456
#define XB_SPIN_CAP (1u << 21)
#define LAS __attribute__((address_space(3)))

__device__ __forceinline__ unsigned xb_ld(unsigned* p)              { return __hip_atomic_load(p, __ATOMIC_RELAXED, __HIP_MEMORY_SCOPE_AGENT); }
__device__ __forceinline__ unsigned xb_add(unsigned* p, unsigned v) { return __hip_atomic_fetch_add(p, v, __ATOMIC_RELAXED, __HIP_MEMORY_SCOPE_AGENT); }
__device__ __forceinline__ unsigned xb_xcc_id() { return (unsigned)__builtin_amdgcn_s_getreg((3 << 11) | 20) & 0xFu; }
#define XB_SPIN(cond, bar) do { unsigned _sp = 0; while (cond) { __builtin_amdgcn_s_sleep(1); \
    if ((++_sp & 255u) == 0u) { if (xb_ld(&(bar)[XB_TMO])) break; if (_sp > XB_SPIN_CAP) { atomicAdd(&(bar)[XB_TMO], 1u); break; } } } } while (0)

struct XcdBarrier {
    unsigned* bar; unsigned x;
    volatile LAS unsigned* st;
};

__device__ __forceinline__ XcdBarrier xcd_barrier_post(unsigned* bar, volatile LAS unsigned* st) {
    XcdBarrier b; b.bar = bar; b.x = xb_xcc_id(); b.st = st;
    if (threadIdx.x == 0) (void)xb_add(&bar[XB_XCNT(b.x)], 1u);
    return b;
}
__device__ __forceinline__ void xcd_barrier_complete(unsigned* bar, unsigned x, unsigned& nloc, unsigned& nx) {
    const unsigned G = gridDim.x * gridDim.y * gridDim.z;
    unsigned sum, cnt, mine, sp = 0u;
    for (;;) {
        sum = 0u; cnt = 0u; mine = 0u;
#pragma unroll
        for (unsigned j = 0; j < 16; ++j) { const unsigned c = xb_ld(&bar[XB_XCNT(j)]); sum += c; cnt += (c > 0u) ? 1u : 0u; mine = (j == x) ? c : mine; }
        if (sum == G) break;
        __builtin_amdgcn_s_sleep(1);
        if ((++sp & 255u) == 0u) { if (xb_ld(&bar[XB_TMO])) break; if (sp > XB_SPIN_CAP) { atomicAdd(&bar[XB_TMO], 1u); break; } }
    }
    nloc = mine > 0u ? mine : 1u; nx = cnt > 0u ? cnt : 1u;
}

__device__ __forceinline__ void xcd_barrier(const XcdBarrier& b) {
    asm volatile("s_waitcnt vmcnt(0)" ::: "memory");
    __syncthreads();
    if (threadIdx.x == 0) {
        unsigned* bar = b.bar;
        __builtin_amdgcn_s_waitcnt(0);
        unsigned nloc = b.st[0], nx = b.st[1];
        if (nloc == 0u) { xcd_barrier_complete(bar, b.x, nloc, nx); b.st[0] = nloc; b.st[1] = nx; }
        const unsigned old = xb_add(&bar[XB_XSUB(b.x)], 1u);
        const unsigned gen = old / nloc;
        if (old + 1u == (gen + 1u) * nloc) {
            __builtin_amdgcn_fence(__ATOMIC_RELEASE, "agent");
            asm volatile("s_waitcnt vmcnt(0)" ::: "memory");
            const unsigned og = xb_add(&bar[XB_TOP], 1u);
            const unsigned tg = og / nx;
            if (og + 1u == (tg + 1u) * nx) xb_add(&bar[XB_TOPGEN], 1u);
            else XB_SPIN(xb_ld(&bar[XB_TOPGEN]) == tg, bar);
            __builtin_amdgcn_fence(__ATOMIC_ACQUIRE, "agent");
            xb_add(&bar[XB_XGEN(b.x)], 1u);
            asm volatile("s_waitcnt vmcnt(0)" ::: "memory");
        } else {
            XB_SPIN(xb_ld(&bar[XB_XGEN(b.x)]) == gen, bar);
            __builtin_amdgcn_fence(__ATOMIC_ACQUIRE, "agent");
            asm volatile("s_waitcnt vmcnt(0)" ::: "memory");
        }
    }
    __syncthreads();
}

struct Args { const float* in[21]; float* out; unsigned char* ws; };

struct MapIn { __device__ __forceinline__ int operator()(int n) const { return n < 4352 ? n : (n < 6400 ? n + 24 : (n < 6424 ? n - 2048 : -1)); } };
struct MapUp { __device__ __forceinline__ int operator()(int n) const { const int pn = n >> 8, j = n & 255; return j < 128 ? 128 * pn + j : DFF + 128 * pn + (j - 128); } };
struct MapId { __device__ __forceinline__ int operator()(int n) const { return n; } };
template <class MAP>
__device__ __forceinline__ void p0_transpose_item(const float* W, int K, int Nsrc, int nblk, bf16* WT, const float* ksc, LAS float* scr, int item, int lane, MAP map) {
    const int kb = item / nblk, nb = item % nblk, k0 = 64 * kb, n0 = 32 * nb;
    const int sc = map(n0 + (lane & 31));
#pragma unroll 8
    for (int i = 0; i < 32; ++i) { const int kk = 2 * i + (lane >> 5); float v = 0.f; if (sc >= 0) { v = W[(size_t)(k0 + kk) * Nsrc + sc]; if (ksc) v *= ksc[k0 + kk]; } scr[kk * 33 + (lane & 31)] = v; }
    LDS_WAIT(); asm volatile("" ::: "memory");
    const int c = lane & 7;
#pragma unroll
    for (int j = 0; j < 4; ++j) { const int n = (lane >> 3) + 8 * j; const LAS float* s = scr + (8 * c) * 33 + n;
        v4u o; o.x = pk2(s[0 * 33], s[1 * 33]); o.y = pk2(s[2 * 33], s[3 * 33]); o.z = pk2(s[4 * 33], s[5 * 33]); o.w = pk2(s[6 * 33], s[7 * 33]);
        *(GAS v4u*)(WT + (size_t)(n0 + n) * K + k0 + 8 * c) = o; }
    LDS_WAIT(); asm volatile("" ::: "memory");
}
__device__ __forceinline__ void p0_prologue(const Args& a, LAS unsigned char* lds, int G) {
    const int tid = threadIdx.x, lane = tid & 63, wave = tid >> 6;
    LAS float* scr = (LAS float*)(lds + wave * 16384);
    const int gw = blockIdx.x * 8 + wave, NGW = G * 8;
    unsigned char* ws = a.ws;
    constexpr int I_IN = 16 * (NPAD_IN / 32), I_UP = 16 * (NUP / 32), I_DN = (DFF / 64) * 32, I_RO = 16 * 32, I_NO = 8 * 32, I_OUT = 16 * 32;
    constexpr int NITEMS = I_IN + I_UP + I_DN + I_RO + I_NO + I_OUT;
    for (int it = gw; it < NITEMS; it += NGW) {
        int r = it;
        if (r < I_IN) { p0_transpose_item(a.in[2], DM, NIN, NPAD_IN / 32, (bf16*)(ws + WS_WIN), a.in[1], scr, r, lane, MapIn()); continue; } r -= I_IN;
        if (r < I_UP) { p0_transpose_item(a.in[16], DM, NUP, NUP / 32, (bf16*)(ws + WS_WUP), a.in[15], scr, r, lane, MapUp()); continue; } r -= I_UP;
        if (r < I_DN) { p0_transpose_item(a.in[19], DFF, DM, 32, (bf16*)(ws + WS_WDN), nullptr, scr, r, lane, MapId()); continue; } r -= I_DN;
        if (r < I_RO) { p0_transpose_item(a.in[12], 1024, DM, 32, (bf16*)(ws + WS_WRO), nullptr, scr, r, lane, MapId()); continue; } r -= I_RO;
        if (r < I_NO) { p0_transpose_item(a.in[13], 512, DM, 32, (bf16*)(ws + WS_WNO), nullptr, scr, r, lane, MapId()); continue; } r -= I_NO;
        p0_transpose_item(a.in[14], DM, DM, 32, (bf16*)(ws + WS_WOUT), nullptr, scr, r, lane, MapId());
    }
    bf16* XB = (bf16*)((unsigned char*)a.out + DO_XB);
    for (int m = gw; m < M; m += NGW) {
        const GAS f32x4* xr = (const GAS f32x4*)(a.in[0] + (size_t)m * DM) + lane;
        f32x4 v[4]; float s = 0.f;
#pragma unroll
        for (int j = 0; j < 4; ++j) { v[j] = xr[64 * j]; s += (v[j].x * v[j].x + v[j].y * v[j].y) + (v[j].z * v[j].z + v[j].w * v[j].w); }
        const float rstd = rsqrtf(wave_sum(s) * (1.f / DM) + EPS);
        GAS unsigned long long* o8 = (GAS unsigned long long*)(XB + (size_t)m * DM) + lane;
#pragma unroll
        for (int j = 0; j < 4; ++j) o8[64 * j] = (unsigned long long)pk2(v[j].x * rstd, v[j].y * rstd) | ((unsigned long long)pk2(v[j].z * rstd, v[j].w * rstd) << 32);
    }
}

__device__ __forceinline__ float ldp(const bf16* P, size_t row, int col) { return bf2f(P[row * PP + col]); }

__device__ __forceinline__ void n_compress(const Args& a, const bf16* P, LAS unsigned char* lds, int G) {
    const int tid = threadIdx.x, sub = tid >> 8, lt = tid & 255;
    LAS float* bv = (LAS float*)(lds + sub * 16384); LAS float* hid = bv + CBLK * NDK;
    for (int it = blockIdx.x; it < NBATCH * NC * 2; it += G) {
        const int u = it * 2 + sub, kv = u & 1, g = (u >> 1) & 1, c = (u >> 2) % NC, b = (u >> 2) / NC;
        const float* pos = a.in[kv ? 8 : 4]; const float* w1 = a.in[kv ? 9 : 5]; const float* b1 = a.in[kv ? 10 : 6]; const float* w2 = a.in[kv ? 11 : 7];
        float* out = (float*)(a.ws + (kv ? WS_VCMP : WS_KCMP));
        const int colbase = (kv ? PC_VCR : PC_KCR) + g * NDK;
        __syncthreads();
        for (int i = lt; i < CBLK * NDK; i += 256) { const int ii = i >> 6, d = i & 63; bv[i] = ldp(P, (size_t)b * SEQ + c * CSTR + ii, colbase + d) + pos[i]; }
        __syncthreads();
        float acc = b1[lt];
        for (int k = 0; k < CBLK * NDK; ++k) acc += bv[k] * w1[(size_t)k * CHID + lt];
        hid[lt] = gelu_tanh(acc);
        __syncthreads();
        if (lt < NDK) { float o = 0.f; for (int j = 0; j < CHID; ++j) o += hid[j] * w2[j * NDK + lt]; out[(((size_t)b * NG + g) * NC + c) * NDK + lt] = o; }
    }
}

template <int MODE>
__device__ __forceinline__ void n_attn(const Args& a, const bf16* P, bf16* NSA, LAS unsigned char* lds, int G) {
    const int tid = threadIdx.x, sub = tid >> 8, r = (tid >> 6) & 3, lane = tid & 63;
    LAS float* qs = (LAS float*)(lds + sub * 16384) + r * 64;
    LAS float* scs = (LAS float*)(lds + sub * 16384 + 1024) + r * 576;
    LAS int* blks = (LAS int*)(lds + sub * 16384 + 1024 + 9216) + r * 12;
    const unsigned* selmask = (const unsigned*)(a.ws + WS_SEL);
    const int kcol = MODE ? PC_KW : PC_KS, vcol = MODE ? PC_VW : PC_VS;
    for (int it = blockIdx.x; it < M; it += G) {
        const int u = it * 2 + sub, g = u & 1, t = u >> 1, tl = t & (SEQ - 1), h = g * NR + r, cur = tl >> 6;
        const size_t rb = (size_t)(t - tl);
        const float slope = exp2f(-(float)(h + 1));
        __syncthreads();
        qs[lane] = ldp(P, t, PC_NQ + h * NDK + lane);
        unsigned mask;
        if (MODE) { const int lo = (tl - (WIN - 1)) > 0 ? ((tl - (WIN - 1)) >> 6) : 0; mask = 0u; for (int j = lo; j <= cur; ++j) mask |= 1u << j; }
        else mask = selmask[t * NG + g];
        int nb = 0;
        for (int j = 0; j < NS; ++j) if ((mask >> j) & 1u) { if (lane == 0) blks[nb] = j; ++nb; }
        __syncthreads();
        float m = -1e30f;
        for (int b = 0; b < nb; ++b) {
            const int s = blks[b] * 64 + lane; const int d = tl - s;
            const bool valid = d >= 0 && (!MODE || d < WIN);
            float sc = -1e30f;
            if (valid) { float dot = 0.f; const bf16* kr = P + (rb + s) * PP + kcol + g * NDK; for (int x = 0; x < NDK; ++x) dot += qs[x] * bf2f(kr[x]); sc = dot * 0.125f - slope * (float)d; }
            scs[b * 64 + lane] = sc; m = fmaxf(m, sc);
        }
        m = wave_max(m);
        float sum = 0.f;
        for (int b = 0; b < nb; ++b) { const float sc = scs[b * 64 + lane]; const float p = sc > -1e29f ? expf(sc - m) : 0.f; scs[b * 64 + lane] = p; sum += p; }
        sum = wave_sum(sum);
        __syncthreads();
        float o = 0.f;
        for (int b = 0; b < nb; ++b) {
            const int s0 = blks[b] * 64;
            for (int i = 0; i < 64; ++i) { const float p = scs[b * 64 + i]; if (p != 0.f) o += p * ldp(P, rb + s0 + i, vcol + g * NDK + lane); }
        }
        const float gate = sigmoidf_(ldp(P, t, PC_GATE + (MODE ? 16 : 8) + h));
        const size_t oi = (size_t)t * 512 + h * NDK + lane;
        float res = gate * o / sum;
        if (!MODE) res += bf2f(NSA[oi]);
        NSA[oi] = (bf16)f2bf(res);
    }
}

__device__ __forceinline__ void n_cmp(const Args& a, const bf16* P, bf16* NSA, LAS unsigned char* lds, int G) {
    const int tid = threadIdx.x, w = tid >> 6, lane = tid & 63;
    LAS float* qs = (LAS float*)(lds + w * 4096);
    LAS float* ps = qs + 256;
    const float* kcmp = (const float*)(a.ws + WS_KCMP); const float* vcmp = (const float*)(a.ws + WS_VCMP);
    unsigned* selmask = (unsigned*)(a.ws + WS_SEL);
    for (int it = blockIdx.x; it < M * NG / 8; it += G) {
        const int u = it * 8 + w, g = u & 1, t = u >> 1, tl = t & (SEQ - 1), b = t >> 11;
        const float* kc = kcmp + ((size_t)b * NG + g) * NC * NDK; const float* vc = vcmp + ((size_t)b * NG + g) * NC * NDK;
        __syncthreads();
        for (int r = 0; r < NR; ++r) qs[r * 64 + lane] = ldp(P, t, PC_NQ + (g * NR + r) * NDK + lane);
        __syncthreads();
        for (int r = 0; r < NR; ++r) {
            const int h = g * NR + r; const float slope = exp2f(-(float)(h + 1));
            float sc[2]; bool val[2];
#pragma unroll
            for (int q = 0; q < 2; ++q) {
                const int c = lane + 64 * q; sc[q] = -1e30f; val[q] = false;
                if (c < NC) {
                    float d = 0.f; const float* kr = kc + (size_t)c * NDK;
                    for (int x = 0; x < NDK; ++x) d += qs[r * 64 + x] * kr[x];
                    const int dc = tl - (c * CSTR + CBLK - 1);
                    if (dc >= 0) { val[q] = true; sc[q] = d * 0.125f - slope * (float)dc; }
                }
            }
            const float mx = wave_max(fmaxf(sc[0], sc[1]));
            float p0 = val[0] ? expf(sc[0] - mx) : 0.f, p1 = val[1] ? expf(sc[1] - mx) : 0.f;
            const float sum = wave_sum(p0 + p1);
            const float inv = sum > 0.f ? 1.f / sum : 0.f;
            ps[r * 128 + lane] = p0 * inv; ps[r * 128 + 64 + lane] = p1 * inv;
        }
        __syncthreads();
        for (int r = 0; r < NR; ++r) {
            const int h = g * NR + r;
            float o = 0.f;
            for (int c = 0; c < NC; ++c) o += ps[r * 128 + c] * vc[(size_t)c * NDK + lane];
            const float gate = sigmoidf_(ldp(P, t, PC_GATE + h));
            const size_t oi = (size_t)t * 512 + h * NDK + lane;
            NSA[oi] = (bf16)f2bf(bf2f(NSA[oi]) + gate * o);
        }
        float imp = 0.f; const int j = lane & 31;
        for (int r = 0; r < NR; ++r)
            for (int c = 4 * j - 1; c <= 4 * j + 3; ++c) if (c >= 0 && c < NC) imp += ps[r * 128 + c];
        const int cur = tl >> 6;
        if (j == 0 || j == cur || j == cur - 1) imp = 1e9f;
        if (j > cur) imp = -1e9f;
        int rank = 0;
        for (int i = 0; i < NS; ++i) { const float o = __shfl(imp, i); rank += (o > imp || (o == imp && i < j)) ? 1 : 0; }
        const unsigned long long bal = __ballot(rank < TOPK && lane < 32 && j <= cur);
        if (lane == 0) selmask[t * NG + g] = (unsigned)bal;
    }
}

__device__ __forceinline__ void n_retention(const Args& a, bf16* P, LAS unsigned char* lds, int G) {
    const int tid = threadIdx.x, sub = tid >> 8, lt = tid & 255;
    LAS float* Qs = (LAS float*)(lds + sub * 49152);
    LAS float* Ks = Qs + 32 * 129;
    LAS float* Vs = Ks + 16 * 129;
    LAS float* Ps = Vs + 16 * 256;
    const float* gn_g = a.in[3];
    for (int p = blockIdx.x; p < NBATCH * 2 * 64; p += G) {
        const int k_ = p >> 8, qt0 = p & 63, qt = (k_ & 1) ? 63 - qt0 : qt0, idx = p >> 6, hp = idx & 1, b = idx >> 1, h = hp * 2 + sub;
        const size_t rb = (size_t)b * SEQ;
        const float lg = log1pf(-exp2f(-5.0f - (float)h));
        const float scale = 0.08838834764831845f;
        __syncthreads();
        for (int i = lt; i < 32 * 128; i += 256) { const int r = i >> 7, c = i & 127; Qs[r * 129 + c] = ldp(P, rb + qt * 32 + r, PC_RQ + h * RDK + c); }
        float acc[32];
#pragma unroll
        for (int e = 0; e < 32; ++e) acc[e] = 0.f;
        const int pi = lt >> 3, pj0 = (lt & 7) * 2;
        for (int kt = 0; kt <= 2 * qt + 1; ++kt) {
            __syncthreads();
            for (int i = lt; i < 16 * 128; i += 256) { const int r = i >> 7, c = i & 127; Ks[r * 129 + c] = ldp(P, rb + kt * 16 + r, PC_RK + h * RDK + c); }
            for (int i = lt; i < 16 * 256; i += 256) { const int r = i >> 8, c = i & 255; Vs[r * 256 + c] = ldp(P, rb + kt * 16 + r, PC_RV + h * RDV + c); }
            __syncthreads();
#pragma unroll
            for (int jj = 0; jj < 2; ++jj) {
                const int j = pj0 + jj; float d = 0.f;
                for (int c = 0; c < 128; ++c) d += Qs[pi * 129 + c] * Ks[j * 129 + c];
                const int diff = (qt * 32 + pi) - (kt * 16 + j);
                Ps[pi * 17 + j] = diff >= 0 ? d * scale * expf(lg * (float)diff) : 0.f;
            }
            __syncthreads();
            for (int j = 0; j < 16; ++j) {
                const float pv = Ps[pi * 17 + j];
#pragma unroll
                for (int e = 0; e < 32; ++e) acc[e] += pv * Vs[j * 256 + (lt & 7) + 8 * e];
            }
        }
        float s = 0.f;
#pragma unroll
        for (int e = 0; e < 32; ++e) s += acc[e];
        s += __shfl_xor(s, 1); s += __shfl_xor(s, 2); s += __shfl_xor(s, 4);
        const float mu = s / 256.f;
        float q = 0.f;
#pragma unroll
        for (int e = 0; e < 32; ++e) { const float d = acc[e] - mu; q += d * d; }
        q += __shfl_xor(q, 1); q += __shfl_xor(q, 2); q += __shfl_xor(q, 4);
        const float rstd = rsqrtf(q / 256.f + EPS);
        const size_t t = rb + qt * 32 + pi;
#pragma unroll
        for (int e = 0; e < 32; ++e) {
            const int col = h * RDV + (lt & 7) + 8 * e;
            const float on = (acc[e] - mu) * rstd * gn_g[col];
            const float gg = ldp(P, t, PC_RG + col);
            P[t * PP + PC_RG + col] = (bf16)f2bf(gg * sigmoidf_(gg) * on);
        }
    }
}

__device__ __forceinline__ void n_conv(const Args& a, bf16* P, int G) {
    const float* cw = a.in[17]; const float* cb = a.in[18];
    const size_t total = (size_t)M * (DFF / 8);
    for (size_t i = (size_t)blockIdx.x * 512 + threadIdx.x; i < total; i += (size_t)G * 512) {
        const int t = (int)(i / (DFF / 8)), f8 = (int)(i % (DFF / 8)) * 8, pn = f8 >> 7, j = f8 & 127, tl = t & (SEQ - 1);
        bf16* pa = P + (size_t)t * PP + PC_UP + 256 * pn + j;
        const v4u a0 = *(const v4u*)pa, bb = *(const v4u*)(pa + 128);
        v4u a1 = (v4u){0u, 0u, 0u, 0u}, a2 = a1;
        if (tl >= 1) a1 = *(const v4u*)(pa - PP);
        if (tl >= 2) a2 = *(const v4u*)(pa - 2 * PP);
        unsigned o[4];
#pragma unroll
        for (int q = 0; q < 4; ++q) {
            float r2[2];
#pragma unroll
            for (int hh = 0; hh < 2; ++hh) {
                const int f = f8 + 2 * q + hh;
                const float x0 = hh ? pg8::bf_hi(a0[q]) : pg8::bf_lo(a0[q]), x1 = hh ? pg8::bf_hi(a1[q]) : pg8::bf_lo(a1[q]), x2 = hh ? pg8::bf_hi(a2[q]) : pg8::bf_lo(a2[q]);
                const float bv = hh ? pg8::bf_hi(bb[q]) : pg8::bf_lo(bb[q]);
                const float ac = cb[f] + cw[2 * DFF + f] * x0 + cw[DFF + f] * x1 + cw[f] * x2;
                r2[hh] = gelu_tanh(ac) * bv;
            }
            o[q] = pk2(r2[0], r2[1]);
        }
        *(v4u*)(pa + 128) = (v4u){o[0], o[1], o[2], o[3]};
    }
}

__device__ __forceinline__ void n_final(const Args& a, int G) {
    const int lane = threadIdx.x & 63, gw = blockIdx.x * 8 + (threadIdx.x >> 6), NGW = G * 8;
    const float* rs3 = (const float*)(a.ws + WS_RS3); const float* gf = a.in[20];
    for (int m = gw; m < M; m += NGW) {
        const float rstd = rsqrtf(rs3[m] * (1.f / DM) + EPS);
        f32x4* xr = (f32x4*)(a.out + (size_t)m * DM) + lane;
#pragma unroll
        for (int j = 0; j < 4; ++j) { const f32x4 gv = *((const f32x4*)gf + lane + 64 * j); f32x4 v = xr[64 * j]; v = v * rstd * gv; xr[64 * j] = v; }
    }
}

__global__ void __launch_bounds__(512, 2) mega_fwd(Args a) {
    extern __shared__ __attribute__((aligned(16))) unsigned char lds_raw[];
    LAS unsigned char* lds = (LAS unsigned char*)lds_raw;
    volatile LAS unsigned* MISC = (volatile LAS unsigned*)(lds + MISC_OFF);
    const int tid = threadIdx.x, G = gridDim.x;
    for (int u = tid; u < (LDS_BYTES - 131072) / 4; u += 512) ((LAS unsigned*)(lds + 131072))[u] = 0u;
    __syncthreads();
    unsigned* ctl = (unsigned*)(a.ws + WS_CTL);
    XcdBarrier bar = xcd_barrier_post(ctl + CW_BAR, MISC + 8);
    bf16* P = (bf16*)(a.ws + WS_PROJ);
    bf16* XB = (bf16*)((unsigned char*)a.out + DO_XB);
    bf16* NSA = (bf16*)((unsigned char*)a.out + DO_NSA);
    float* rs2 = (float*)(a.ws + WS_RS2); float* rs3 = (float*)(a.ws + WS_RS3);

    p0_prologue(a, lds, G);
    xcd_barrier(bar);
    { pg8::Gemm g{XB, (const bf16*)(a.ws + WS_WIN), DM, DM, 128, 256}; pg8::StaticOrder S; S.init(M, NPAD_IN, G, (int)blockIdx.x);
      pg8::EpiRowScale<0> E{P, PP, nullptr};
      pg8::gemm_phase<pg8::EpiRowScale<0>, pg8::StaticOrder, true, true>(lds, g, S, E); }
    xcd_barrier(bar);
    n_compress(a, P, lds, G);
    n_attn<1>(a, P, NSA, lds, G);
    xcd_barrier(bar);
    n_cmp(a, P, NSA, lds, G);
    xcd_barrier(bar);
    n_attn<0>(a, P, NSA, lds, G);
    n_retention(a, P, lds, G);
    xcd_barrier(bar);
    { pg8::Gemm g{P + PC_RG, (const bf16*)(a.ws + WS_WRO), PP, 1024, 128, 256}; pg8::StaticOrder S; S.init(M, DM, G, (int)blockIdx.x);
      pg8::EpiMerge<true> E{P + PC_MERGED, P + PC_GA, PP};
      pg8::gemm_phase<pg8::EpiMerge<true>, pg8::StaticOrder, true, true>(lds, g, S, E); }
    { pg8::Gemm g{NSA, (const bf16*)(a.ws + WS_WNO), 512, 512, 128, 256}; pg8::StaticOrder S; S.init(M, DM, G, (int)blockIdx.x);
      pg8::EpiMerge<false> E{P + PC_MERGED, P + PC_GB, PP};
      pg8::gemm_phase<pg8::EpiMerge<false>, pg8::StaticOrder, true, true>(lds, g, S, E); }
    xcd_barrier(bar);
    { pg8::Gemm g{P + PC_MERGED, (const bf16*)(a.ws + WS_WOUT), PP, DM, 128, 256}; pg8::StaticOrder S; S.init(M, DM, G, (int)blockIdx.x);
      pg8::EpiResid<true> E{a.in[0], a.out, P + PC_X1B, PP, rs2};
      pg8::gemm_phase<pg8::EpiResid<true>, pg8::StaticOrder, true, true>(lds, g, S, E); }
    xcd_barrier(bar);
    { pg8::Gemm g{P + PC_X1B, (const bf16*)(a.ws + WS_WUP), PP, DM, 128, 256}; pg8::StaticOrder S; S.init(M, NUP, G, (int)blockIdx.x);
      pg8::EpiRowScale<1> E{P + PC_UP, PP, rs2};
      pg8::gemm_phase<pg8::EpiRowScale<1>, pg8::StaticOrder, true, true>(lds, g, S, E); }
    xcd_barrier(bar);
    n_conv(a, P, G);
    xcd_barrier(bar);
    { pg8::Gemm g{P + PC_UP + 128, (const bf16*)(a.ws + WS_WDN), PP, DFF, 128, 512}; pg8::StaticOrder S; S.init(M, DM, G, (int)blockIdx.x);
      pg8::EpiResid<false> E{a.out, a.out, nullptr, 0, rs3};
      pg8::gemm_phase<pg8::EpiResid<false>, pg8::StaticOrder, true, true>(lds, g, S, E); }
    xcd_barrier(bar);
    n_final(a, G);
}

extern "C" void kernel_launch(void* const* d_in, const int* in_sizes, int n_in, void* d_out, int out_size, void* d_ws, size_t ws_size, hipStream_t stream) {
    static int grid = 0;
    if (grid == 0) {
        if (n_in != 21 || out_size != M * DM || ws_size < WS_END) { fprintf(stderr, "kernel_launch: unexpected sizes n_in %d out %d ws %zu (need %zu)\n", n_in, out_size, ws_size, (size_t)WS_END); grid = -1; return; }
        int dev = 0, cus = 0;
        if (hipGetDevice(&dev) != hipSuccess || hipDeviceGetAttribute(&cus, hipDeviceAttributeMultiprocessorCount, dev) != hipSuccess) { grid = -1; return; }
        if (hipFuncSetAttribute((const void*)mega_fwd, hipFuncAttributeMaxDynamicSharedMemorySize, LDS_BYTES) != hipSuccess) { fprintf(stderr, "kernel_launch: hipFuncSetAttribute failed\n"); grid = -1; return; }
        grid = cus;
    }
    if (grid < 0) return;
    (void)hipMemsetAsync((char*)d_ws + WS_CTL, 0, CTL_ZERO_BYTES, stream);
    Args a{};
    for (int i = 0; i < 21; ++i) a.in[i] = (const float*)d_in[i];
    a.out = (float*)d_out; a.ws = (unsigned char*)d_ws;
    hipLaunchKernelGGL(mega_fwd, dim3(grid), dim3(512), LDS_BYTES, stream, a);
}
```

```cpp
#include <hip/hip_runtime.h>
#include <cstdio>
#include <cstdint>
namespace pg8 {
#define PG8_LAS __attribute__((address_space(3)))
typedef unsigned short bf16_t;
typedef short bf16x8 __attribute__((ext_vector_type(8)));
typedef float f32x4 __attribute__((ext_vector_type(4)));
typedef unsigned u32x4 __attribute__((ext_vector_type(4)));
constexpr int BM = 256, BK = 64, HALF = 128, HTB = HALF * BK * 2  , STAGE_BYTES = 8 * HTB, NXCD = 8, WGM = 8;

__host__ __device__ __forceinline__ int lds_byte(int r, int c) { const int st = (r >> 4) * 2 + (c >> 5), rr = r & 15, cc = c & 31, ob = rr * 64 + cc * 2; return st * 1024 + (ob ^ (((ob >> 9) & 1) << 5)); }
__host__ __device__ __forceinline__ void stage_rc(int b, int& R, int& C) { const int st = b / 1024, sb = b % 1024, swz = sb ^ (((sb >> 9) & 1) << 5); R = (st >> 1) * 16 + swz / 64; C = (st & 1) * 32 + (swz % 64) / 2; }
__host__ __device__ __forceinline__ int perm32(int rho) { const int n = rho >> 4, i = rho & 15; return 8 * (i >> 2) + 4 * n + (i & 3); }

struct Unit { int pm, pn; };
struct Gemm { const bf16_t* A; const bf16_t* Bt; int lda, K, ks1, ks2; };

struct StaticOrder {
    int nM, nN, nwg, G, c;
    __host__ __device__ void init(int M, int N, int G_, int c_) { nM = M / BM; nN = N / BM; nwg = nM * nN; G = G_; c = c_; }
    __host__ __device__ bool next(int i, Unit& u) const {
        const long L = (long)i * G + c; if (L >= nwg) return false;
        int wgid = (int)L; { const int q = nwg / NXCD, r = nwg % NXCD, xcd = wgid % NXCD, off = wgid / NXCD; wgid = (xcd < r ? xcd * (q + 1) : r * (q + 1) + (xcd - r) * q) + off; }
        const int nig = WGM * nN, gid = wgid / nig, fm = gid * WGM, gsz = (nM - fm) < WGM ? (nM - fm) : WGM;
        u.pm = fm + ((wgid % nig) % gsz); u.pn = (wgid % nig) / gsz; return true;
    }
    __device__ __forceinline__ void a_ready(const Unit&) const {}
    __device__ __forceinline__ void done(const Unit&) const {}
};

__device__ __forceinline__ unsigned cvt_pk_bf16(float lo, float hi) { unsigned r; asm volatile("v_cvt_pk_bf16_f32 %0, %1, %2" : "=v"(r) : "v"(lo), "v"(hi)); return r; }
__device__ __forceinline__ float bf_lo(unsigned u) { return __builtin_bit_cast(float, u << 16); }
__device__ __forceinline__ float bf_hi(unsigned u) { return __builtin_bit_cast(float, u & 0xffff0000u); }
__device__ __forceinline__ float fsig(float x) { return __builtin_amdgcn_rcpf(1.f + __builtin_amdgcn_exp2f(-1.4426950408889634f * x)); }

template <int MODE> struct EpiRowScale {
    static constexpr bool PERM = true, AFTER_DRAIN = false;
    bf16_t* O; int ldc; const float* rs;
    __device__ __forceinline__ void operator()(const f32x4 (&acc)[2][2][4][2], const Unit& u, int wr, int wc, int fr, int fq) const {
        const int row0 = u.pm * BM + wr * 64 + fr, col0 = u.pn * BM + wc * 32 + 8 * fq;
#pragma unroll
        for (int ai = 0; ai < 2; ++ai)
#pragma unroll
            for (int m = 0; m < 4; ++m) { const int row = row0 + ai * HALF + m * 16; float s = 1.f;
                if (MODE == 1) s = __builtin_amdgcn_rsqf(rs[row] * (1.0f / 1024.0f) + 1e-6f);
                bf16_t* rowp = O + (size_t)row * ldc + col0;
#pragma unroll
                for (int bj = 0; bj < 2; ++bj) { const f32x4 v0 = acc[ai][bj][m][0] * s, v1 = acc[ai][bj][m][1] * s;
                    u32x4 w; w.x = cvt_pk_bf16(v0[0], v0[1]); w.y = cvt_pk_bf16(v0[2], v0[3]); w.z = cvt_pk_bf16(v1[0], v1[1]); w.w = cvt_pk_bf16(v1[2], v1[3]);
                    *(u32x4*)(rowp + bj * HALF) = w; } }
    }
};
template <bool FIRST> struct EpiMerge {
    static constexpr bool PERM = true, AFTER_DRAIN = false;
    bf16_t* O; const bf16_t* G; int ldc;
    __device__ __forceinline__ void operator()(const f32x4 (&acc)[2][2][4][2], const Unit& u, int wr, int wc, int fr, int fq) const {
        const int row0 = u.pm * BM + wr * 64 + fr, col0 = u.pn * BM + wc * 32 + 8 * fq;
#pragma unroll
        for (int ai = 0; ai < 2; ++ai)
#pragma unroll
            for (int m = 0; m < 4; ++m) { const size_t off = (size_t)(row0 + ai * HALF + m * 16) * ldc + col0;
#pragma unroll
                for (int bj = 0; bj < 2; ++bj) { const u32x4 gv = *(const u32x4*)(G + off + bj * HALF);
                    const f32x4 v0 = acc[ai][bj][m][0], v1 = acc[ai][bj][m][1];
                    float r[8];
                    r[0] = fsig(bf_lo(gv.x)) * v0[0]; r[1] = fsig(bf_hi(gv.x)) * v0[1]; r[2] = fsig(bf_lo(gv.y)) * v0[2]; r[3] = fsig(bf_hi(gv.y)) * v0[3];
                    r[4] = fsig(bf_lo(gv.z)) * v1[0]; r[5] = fsig(bf_hi(gv.z)) * v1[1]; r[6] = fsig(bf_lo(gv.w)) * v1[2]; r[7] = fsig(bf_hi(gv.w)) * v1[3];
                    if (!FIRST) { const u32x4 pv = *(const u32x4*)(O + off + bj * HALF);
                        r[0] += bf_lo(pv.x); r[1] += bf_hi(pv.x); r[2] += bf_lo(pv.y); r[3] += bf_hi(pv.y); r[4] += bf_lo(pv.z); r[5] += bf_hi(pv.z); r[6] += bf_lo(pv.w); r[7] += bf_hi(pv.w); }
                    u32x4 w; w.x = cvt_pk_bf16(r[0], r[1]); w.y = cvt_pk_bf16(r[2], r[3]); w.z = cvt_pk_bf16(r[4], r[5]); w.w = cvt_pk_bf16(r[6], r[7]);
                    *(u32x4*)(O + off + bj * HALF) = w; } }
    }
};
template <bool WB16> struct EpiResid {
    static constexpr bool PERM = false, AFTER_DRAIN = false;
    const float* X; float* X1; bf16_t* Xb; int ldb; float* sumsq;
    __device__ __forceinline__ void operator()(const f32x4 (&acc)[2][2][4][2], const Unit& u, int wr, int wc, int fr, int fq) const {
        const int row0 = u.pm * BM + wr * 64 + fr, col0 = u.pn * BM + wc * 32 + 4 * fq;
#pragma unroll
        for (int ai = 0; ai < 2; ++ai)
#pragma unroll
            for (int m = 0; m < 4; ++m) { const int row = row0 + ai * HALF + m * 16; float ss = 0.f;
#pragma unroll
                for (int bj = 0; bj < 2; ++bj)
#pragma unroll
                    for (int n = 0; n < 2; ++n) { const int c = col0 + bj * HALF + n * 16;
                        const f32x4 x = *(const f32x4*)(X + (size_t)row * 1024 + c) + acc[ai][bj][m][n];
                        *(f32x4*)(X1 + (size_t)row * 1024 + c) = x;
                        ss += (x[0] * x[0] + x[1] * x[1]) + (x[2] * x[2] + x[3] * x[3]);
                        if (WB16) { unsigned long long w = (unsigned long long)cvt_pk_bf16(x[0], x[1]) | ((unsigned long long)cvt_pk_bf16(x[2], x[3]) << 32);
                            *(unsigned long long*)(Xb + (size_t)row * ldb + c) = w; } }
                ss += __shfl_xor(ss, 16); ss += __shfl_xor(ss, 32);
                if (fq == 0) atomicAdd(sumsq + row, ss); }
    }
};

template <class Epi, class Sched, bool ALIGN_EPI = false, bool SP2 = false>
__device__ __forceinline__ void gemm_phase(PG8_LAS unsigned char* lds, const Gemm g, const Sched& S, const Epi& E) {
    const int tid = threadIdx.x, wid = __builtin_amdgcn_readfirstlane(tid >> 6), lane = tid & 63, wr = wid >> 2, wc = wid & 3, fr = lane & 15, fq = lane >> 4;
    const int K = g.K, nt = K / BK;
    unsigned voffA[2], voffB[2];
#pragma unroll
    for (int i = 0; i < 2; ++i) { int R, C; stage_rc(tid * 16 + i * 8192, R, C); const int Rb = Epi::PERM ? ((R & ~31) + perm32(R & 31)) : R;
        voffA[i] = (unsigned)(R * g.lda + C) * 2u; voffB[i] = (unsigned)(Rb * K + C) * 2u; }
    const size_t kstep = (size_t)(BK * 2);
    const size_t hstepB = (size_t)HALF * K * 2, hstepA = (size_t)HALF * g.lda * 2, ks1 = (size_t)g.ks1, ks2 = (size_t)g.ks2;
    const size_t tstepA = 2 * hstepA, tstepB = 2 * hstepB;
    const unsigned ldsw = (unsigned)wid * 1024u;
    const int aoff = lds_byte(wr * 64 + fr, fq * 8), boff = lds_byte(wc * 32 + fr, fq * 8);
#define PG8_SA(b, h) (((b) * 2 + (h)) * HTB)
#define PG8_SB(b, h) ((4 + (b) * 2 + (h)) * HTB)
#define PG8_STAGE(bufoff, gbase, voff) do { _Pragma("unroll") for (int _i = 0; _i < 2; ++_i) \
        __builtin_amdgcn_global_load_lds((const unsigned*)((const char*)(gbase) + (voff)[_i]), (PG8_LAS unsigned*)(lds + (bufoff) + ldsw + _i * 8192), 16, 0, 0); } while (0)
#define PG8_LDA(dst, b, h) do { _Pragma("unroll") for (int m = 0; m < 4; ++m) _Pragma("unroll") for (int k = 0; k < 2; ++k) dst[m][k] = *(const PG8_LAS bf16x8*)(lds + PG8_SA(b, h) + aoff + m * 2048 + k * 1024); } while (0)
#define PG8_LDB(dst, b, h) do { _Pragma("unroll") for (int n = 0; n < 2; ++n) _Pragma("unroll") for (int k = 0; k < 2; ++k) dst[n][k] = *(const PG8_LAS bf16x8*)(lds + PG8_SB(b, h) + boff + n * 2048 + k * 1024); } while (0)
#define PG8_MMA(ai, bj, At, Bt) do { __builtin_amdgcn_s_setprio(1); _Pragma("unroll") for (int m = 0; m < 4; ++m) _Pragma("unroll") for (int n = 0; n < 2; ++n) _Pragma("unroll") for (int k = 0; k < 2; ++k) \
        acc[ai][bj][m][n] = __builtin_amdgcn_mfma_f32_16x16x32_bf16(Bt[n][k], At[m][k], acc[ai][bj][m][n], 0, 0, 0); __builtin_amdgcn_s_setprio(0); } while (0)
#define PG8_WAIT_V(n) asm volatile("s_waitcnt vmcnt(" #n ")" ::: "memory")
#define PG8_WAIT_L(n) asm volatile("s_waitcnt lgkmcnt(" #n ")" ::: "memory")
#define PG8_BAR __builtin_amdgcn_s_barrier()
#define PG8_SCHED __builtin_amdgcn_sched_barrier(0)
    Unit cur, nxt; int ui = 0;
    if (!S.next(0, cur)) return;
    f32x4 acc[2][2][4][2];
#pragma unroll
    for (int a = 0; a < 2; ++a)
#pragma unroll
        for (int b = 0; b < 2; ++b)
#pragma unroll
            for (int m = 0; m < 4; ++m)
#pragma unroll
                for (int n = 0; n < 2; ++n) acc[a][b][m][n] = (f32x4){0.f, 0.f, 0.f, 0.f};
    bf16x8 At[4][2], B0[2][2], B1[2][2];
    const char* cA = (const char*)g.A + (size_t)cur.pm * tstepA; const char* cB = (const char*)g.Bt + (size_t)cur.pn * tstepB;
    S.a_ready(cur);
    if constexpr (SP2) {
        PG8_STAGE(PG8_SB(0, 0), cB, voffB); PG8_STAGE(PG8_SB(0, 1), cB + hstepB, voffB); PG8_STAGE(PG8_SA(0, 0), cA, voffA); PG8_STAGE(PG8_SA(0, 1), cA + hstepA, voffA);
        if (wr == 1) PG8_BAR;
        PG8_WAIT_V(2); PG8_BAR;
        PG8_STAGE(PG8_SB(1, 0), cB + kstep, voffB); PG8_STAGE(PG8_SA(1, 0), cA + ks1, voffA); PG8_STAGE(PG8_SB(1, 1), cB + hstepB + kstep, voffB);
        PG8_WAIT_V(6); PG8_BAR;
    } else {
        PG8_STAGE(PG8_SB(0, 0), cB, voffB); PG8_STAGE(PG8_SA(0, 0), cA, voffA); PG8_STAGE(PG8_SB(0, 1), cB + hstepB, voffB); PG8_STAGE(PG8_SA(0, 1), cA + hstepA, voffA);
        if (wr == 1) PG8_BAR;
        PG8_WAIT_V(4); PG8_BAR;
        PG8_STAGE(PG8_SB(1, 0), cB + kstep, voffB); PG8_STAGE(PG8_SA(1, 0), cA + ks1, voffA); PG8_STAGE(PG8_SB(1, 1), cB + hstepB + kstep, voffB);
        PG8_WAIT_V(6); PG8_BAR;
    }
    for (;;) {
        const bool has_next = S.next(ui + 1, nxt);
        const char* nA = has_next ? (const char*)g.A + (size_t)nxt.pm * tstepA : cA; const char* nB = has_next ? (const char*)g.Bt + (size_t)nxt.pn * tstepB : cB;
        for (int t = 0; t < nt; t += 2) {
            const bool last = (t == nt - 2);
            const char* a1 = cA + (size_t)(t >> 1) * ks2 + ks1;
            const char* a2 = last ? nA : cA + (size_t)((t + 2) >> 1) * ks2; const char* b2 = last ? nB : cB + (size_t)(t + 2) * kstep;
            const char* a3 = a2 + ks1; const char* b3 = b2 + kstep;
            if (last && has_next) S.a_ready(nxt);
            if constexpr (SP2) {
            PG8_LDB(B0, 0, 0); PG8_LDB(B1, 0, 1); PG8_SCHED; PG8_LDA(At, 0, 0); PG8_STAGE(PG8_SA(1, 1), a1 + hstepA, voffA);
            PG8_WAIT_V(8); PG8_WAIT_L(0); PG8_BAR; PG8_MMA(0, 0, At, B0); PG8_MMA(0, 1, At, B1); PG8_BAR; PG8_SCHED;
            PG8_LDA(At, 0, 1); PG8_STAGE(PG8_SB(0, 0), b2, voffB); PG8_STAGE(PG8_SB(0, 1), b2 + hstepB, voffB); PG8_STAGE(PG8_SA(0, 0), a2, voffA);
            PG8_WAIT_V(8); PG8_WAIT_L(0); PG8_BAR; PG8_MMA(1, 0, At, B0); PG8_MMA(1, 1, At, B1); PG8_BAR; PG8_SCHED;
            PG8_LDB(B0, 1, 0); PG8_LDB(B1, 1, 1); PG8_SCHED; PG8_LDA(At, 1, 0); PG8_STAGE(PG8_SA(0, 1), a2 + hstepA, voffA);
            PG8_WAIT_V(8); PG8_WAIT_L(0); PG8_BAR; PG8_MMA(0, 0, At, B0); PG8_MMA(0, 1, At, B1); PG8_BAR; PG8_SCHED;
            PG8_LDA(At, 1, 1); PG8_STAGE(PG8_SB(1, 0), b3, voffB); PG8_STAGE(PG8_SB(1, 1), b3 + hstepB, voffB); PG8_STAGE(PG8_SA(1, 0), a3, voffA);
            PG8_WAIT_V(8); PG8_WAIT_L(0); PG8_BAR; PG8_MMA(1, 0, At, B0); PG8_MMA(1, 1, At, B1); PG8_BAR; PG8_SCHED;
            } else {
            PG8_LDB(B0, 0, 0); PG8_SCHED; PG8_LDA(At, 0, 0); PG8_STAGE(PG8_SA(1, 1), a1 + hstepA, voffA);
            PG8_WAIT_L(8); PG8_BAR; PG8_WAIT_L(0); PG8_MMA(0, 0, At, B0); PG8_BAR; PG8_SCHED;
            PG8_LDB(B1, 0, 1); PG8_STAGE(PG8_SB(0, 0), b2, voffB);
            PG8_BAR; PG8_WAIT_L(0); PG8_MMA(0, 1, At, B1); PG8_BAR;
            PG8_LDA(At, 0, 1); PG8_STAGE(PG8_SA(0, 0), a2, voffA);
            PG8_BAR; PG8_WAIT_L(0); PG8_MMA(1, 0, At, B0); PG8_BAR; PG8_SCHED;
            PG8_STAGE(PG8_SB(0, 1), b2 + hstepB, voffB);
            PG8_WAIT_V(6); PG8_BAR; PG8_MMA(1, 1, At, B1); PG8_BAR;
            PG8_LDB(B0, 1, 0); PG8_SCHED; PG8_LDA(At, 1, 0); PG8_STAGE(PG8_SA(0, 1), a2 + hstepA, voffA);
            PG8_WAIT_L(8); PG8_BAR; PG8_WAIT_L(0); PG8_MMA(0, 0, At, B0); PG8_BAR; PG8_SCHED;
            PG8_LDB(B1, 1, 1); PG8_STAGE(PG8_SB(1, 0), b3, voffB);
            PG8_BAR; PG8_WAIT_L(0); PG8_MMA(0, 1, At, B1); PG8_BAR;
            PG8_LDA(At, 1, 1); PG8_STAGE(PG8_SA(1, 0), a3, voffA);
            PG8_BAR; PG8_WAIT_L(0); PG8_MMA(1, 0, At, B0); PG8_BAR; PG8_SCHED;
            PG8_STAGE(PG8_SB(1, 1), b3 + hstepB, voffB);
            PG8_WAIT_V(6); PG8_BAR; PG8_MMA(1, 1, At, B1); PG8_BAR;
            }
        }
        if constexpr (ALIGN_EPI) { if (wr == 0) PG8_BAR; }
        if constexpr (!Epi::AFTER_DRAIN) { E(acc, cur, wr, wc, fr, fq); S.done(cur); }
        if (!has_next) break;
#pragma unroll
        for (int a = 0; a < 2; ++a)
#pragma unroll
            for (int b = 0; b < 2; ++b)
#pragma unroll
                for (int m = 0; m < 4; ++m)
#pragma unroll
                    for (int n = 0; n < 2; ++n) acc[a][b][m][n] = (f32x4){0.f, 0.f, 0.f, 0.f};
        cur = nxt; cA = nA; cB = nB; ++ui;
        if constexpr (ALIGN_EPI) { if (wr == 1) PG8_BAR; }
    }
    PG8_WAIT_V(0);
    if constexpr (!ALIGN_EPI) { if (wr == 0) PG8_BAR; }
    PG8_BAR;
    if constexpr (Epi::AFTER_DRAIN) { E.fused(acc, cur, wr, wc, fr, fq, lds, wid, lane); S.done(cur); }
#undef PG8_SA
#undef PG8_SB
#undef PG8_STAGE
#undef PG8_LDA
#undef PG8_LDB
#undef PG8_MMA
#undef PG8_WAIT_V
#undef PG8_WAIT_L
#undef PG8_BAR
#undef PG8_SCHED
}
}
constexpr int M = 32768, DM = 1024, SEQ = 2048, NBATCH = 16;
constexpr int RH = 4, RDK = 128, RDV = 256;
constexpr int NG = 2, NR = 4, NDK = 64, CBLK = 32, CSTR = 16, CHID = 256, TOPK = 8, WIN = 512;
constexpr int DFF = 2816, NIN = 6424;
constexpr int NC = SEQ / CSTR - 1;
constexpr int NS = SEQ / 64;
constexpr float EPS = 1e-6f;
constexpr int C_GATE = 4352, C_GA = 4376, C_GB = 5400;
constexpr int PP = 6656;
constexpr int PC_RQ = 0, PC_RK = 512, PC_RV = 1024, PC_RG = 2048, PC_NQ = 3072, PC_KCR = 3584, PC_VCR = 3712, PC_KS = 3840, PC_VS = 3968,
              PC_KW = 4096, PC_VW = 4224, PC_GA = 4352, PC_GB = 5376, PC_GATE = 6400;
constexpr int PC_MERGED = 1024, PC_X1B = 0, PC_UP = 1024;
constexpr int NPAD_IN = 6656, NUP = 2 * DFF;
constexpr size_t MiB = 1u << 20;
constexpr size_t WS_CTL = 0, CTL_ZERO_BYTES = 1 * MiB;
constexpr size_t WS_RS2 = 256 * 1024, WS_RS3 = 512 * 1024;
constexpr size_t WS_WIN = 1 * MiB, WS_WUP = 14 * MiB, WS_WDN = 25 * MiB, WS_WRO = 31 * MiB, WS_WNO = 33 * MiB, WS_WOUT = 34 * MiB;
constexpr size_t WS_KCMP = 39 * MiB, WS_VCMP = 41 * MiB, WS_SEL = 43 * MiB;
constexpr size_t WS_PROJ = 48 * MiB;
constexpr size_t WS_END = WS_PROJ + (size_t)(M + 32) * PP * 2;
static_assert(WS_END <= 512 * MiB, "d_ws map");
constexpr int CW_BAR = 4096;
constexpr size_t DO_XB = 0, DO_NSA = 64 * MiB;

constexpr int LDS_BYTES = 163840;
constexpr int MISC_OFF = 163840 - 512;

typedef unsigned short bf16;
typedef unsigned v4u __attribute__((ext_vector_type(4)));
typedef float f32x4 __attribute__((ext_vector_type(4)));
#define GAS __attribute__((address_space(1)))
#define LDS_WAIT() asm volatile("s_waitcnt lgkmcnt(0)" ::: "memory")
__device__ __forceinline__ unsigned f2bf(float f) { unsigned u = __builtin_bit_cast(unsigned, f); return (u + 0x7fffu + ((u >> 16) & 1u)) >> 16; }
__device__ __forceinline__ unsigned pk2(float lo, float hi) { return f2bf(lo) | (f2bf(hi) << 16); }
__device__ __forceinline__ float bf2f(bf16 v) { return __builtin_bit_cast(float, (unsigned)v << 16); }
__device__ __forceinline__ float wave_sum(float v) {
#pragma unroll
    for (int o = 1; o < 64; o <<= 1) v += __shfl_xor(v, o);
    return v;
}
__device__ __forceinline__ float wave_max(float v) {
#pragma unroll
    for (int o = 1; o < 64; o <<= 1) v = fmaxf(v, __shfl_xor(v, o));
    return v;
}
__device__ __forceinline__ float gelu_tanh(float x) { const float c = 0.7978845608028654f; return 0.5f * x * (1.f + tanhf(c * (x + 0.044715f * x * x * x))); }
__device__ __forceinline__ float sigmoidf_(float x) { return 1.f / (1.f + expf(-x)); }

#define XB_TMO      128
#define XB_XCNT(j)  (256  + 64 * (j))
#define XB_XSUB(j)  (1280 + 64 * (j))
#define XB_XGEN(j)  (2304 + 64 * (j))
#define XB_TOP      3328
#define XB_TOPGEN   3392
#define XCD_BAR_WORDS 3456
#define XB_SPIN_CAP (1u << 21)
#define LAS __attribute__((address_space(3)))

__device__ __forceinline__ unsigned xb_ld(unsigned* p)              { return __hip_atomic_load(p, __ATOMIC_RELAXED, __HIP_MEMORY_SCOPE_AGENT); }
__device__ __forceinline__ unsigned xb_add(unsigned* p, unsigned v) { return __hip_atomic_fetch_add(p, v, __ATOMIC_RELAXED, __HIP_MEMORY_SCOPE_AGENT); }
__device__ __forceinline__ unsigned xb_xcc_id() { return (unsigned)__builtin_amdgcn_s_getreg((3 << 11) | 20) & 0xFu; }
#define XB_SPIN(cond, bar) do { unsigned _sp = 0; while (cond) { __builtin_amdgcn_s_sleep(1); \
    if ((++_sp & 255u) == 0u) { if (xb_ld(&(bar)[XB_TMO])) break; if (_sp > XB_SPIN_CAP) { atomicAdd(&(bar)[XB_TMO], 1u); break; } } } } while (0)

struct XcdBarrier {
    unsigned* bar; unsigned x;
    volatile LAS unsigned* st;
};

__device__ __forceinline__ XcdBarrier xcd_barrier_post(unsigned* bar, volatile LAS unsigned* st) {
    XcdBarrier b; b.bar = bar; b.x = xb_xcc_id(); b.st = st;
    if (threadIdx.x == 0) (void)xb_add(&bar[XB_XCNT(b.x)], 1u);
    return b;
}
__device__ __forceinline__ void xcd_barrier_complete(unsigned* bar, unsigned x, unsigned& nloc, unsigned& nx) {
    const unsigned G = gridDim.x * gridDim.y * gridDim.z;
    unsigned sum, cnt, mine, sp = 0u;
    for (;;) {
        sum = 0u; cnt = 0u; mine = 0u;
#pragma unroll
        for (unsigned j = 0; j < 16; ++j) { const unsigned c = xb_ld(&bar[XB_XCNT(j)]); sum += c; cnt += (c > 0u) ? 1u : 0u; mine = (j == x) ? c : mine; }
        if (sum == G) break;
        __builtin_amdgcn_s_sleep(1);
        if ((++sp & 255u) == 0u) { if (xb_ld(&bar[XB_TMO])) break; if (sp > XB_SPIN_CAP) { atomicAdd(&bar[XB_TMO], 1u); break; } }
    }
    nloc = mine > 0u ? mine : 1u; nx = cnt > 0u ? cnt : 1u;
}

__device__ __forceinline__ void xcd_barrier(const XcdBarrier& b) {
    asm volatile("s_waitcnt vmcnt(0)" ::: "memory");
    __syncthreads();
    if (threadIdx.x == 0) {
        unsigned* bar = b.bar;
        __builtin_amdgcn_s_waitcnt(0);
        unsigned nloc = b.st[0], nx = b.st[1];
        if (nloc == 0u) { xcd_barrier_complete(bar, b.x, nloc, nx); b.st[0] = nloc; b.st[1] = nx; }
        const unsigned old = xb_add(&bar[XB_XSUB(b.x)], 1u);
        const unsigned gen = old / nloc;
        if (old + 1u == (gen + 1u) * nloc) {
            __builtin_amdgcn_fence(__ATOMIC_RELEASE, "agent");
            asm volatile("s_waitcnt vmcnt(0)" ::: "memory");
            const unsigned og = xb_add(&bar[XB_TOP], 1u);
            const unsigned tg = og / nx;
            if (og + 1u == (tg + 1u) * nx) xb_add(&bar[XB_TOPGEN], 1u);
            else XB_SPIN(xb_ld(&bar[XB_TOPGEN]) == tg, bar);
            __builtin_amdgcn_fence(__ATOMIC_ACQUIRE, "agent");
            xb_add(&bar[XB_XGEN(b.x)], 1u);
            asm volatile("s_waitcnt vmcnt(0)" ::: "memory");
        } else {
            XB_SPIN(xb_ld(&bar[XB_XGEN(b.x)]) == gen, bar);
            __builtin_amdgcn_fence(__ATOMIC_ACQUIRE, "agent");
            asm volatile("s_waitcnt vmcnt(0)" ::: "memory");
        }
    }
    __syncthreads();
}

struct Args { const float* in[21]; float* out; unsigned char* ws; };

struct MapIn { __device__ __forceinline__ int operator()(int n) const { return n < 4352 ? n : (n < 6400 ? n + 24 : (n < 6424 ? n - 2048 : -1)); } };
struct MapUp { __device__ __forceinline__ int operator()(int n) const { const int pn = n >> 8, j = n & 255; return j < 128 ? 128 * pn + j : DFF + 128 * pn + (j - 128); } };
struct MapId { __device__ __forceinline__ int operator()(int n) const { return n; } };
template <class MAP>
__device__ __forceinline__ void p0_transpose_item(const float* W, int K, int Nsrc, int nblk, bf16* WT, const float* ksc, LAS float* scr, int item, int lane, MAP map) {
    const int kb = item / nblk, nb = item % nblk, k0 = 64 * kb, n0 = 32 * nb;
    const int sc = map(n0 + (lane & 31));
#pragma unroll 8
    for (int i = 0; i < 32; ++i) { const int kk = 2 * i + (lane >> 5); float v = 0.f; if (sc >= 0) { v = W[(size_t)(k0 + kk) * Nsrc + sc]; if (ksc) v *= ksc[k0 + kk]; } scr[kk * 33 + (lane & 31)] = v; }
    LDS_WAIT(); asm volatile("" ::: "memory");
    const int c = lane & 7;
#pragma unroll
    for (int j = 0; j < 4; ++j) { const int n = (lane >> 3) + 8 * j; const LAS float* s = scr + (8 * c) * 33 + n;
        v4u o; o.x = pk2(s[0 * 33], s[1 * 33]); o.y = pk2(s[2 * 33], s[3 * 33]); o.z = pk2(s[4 * 33], s[5 * 33]); o.w = pk2(s[6 * 33], s[7 * 33]);
        *(GAS v4u*)(WT + (size_t)(n0 + n) * K + k0 + 8 * c) = o; }
    LDS_WAIT(); asm volatile("" ::: "memory");
}
__device__ __forceinline__ void p0_prologue(const Args& a, LAS unsigned char* lds, int G) {
    const int tid = threadIdx.x, lane = tid & 63, wave = tid >> 6;
    LAS float* scr = (LAS float*)(lds + wave * 16384);
    const int gw = blockIdx.x * 8 + wave, NGW = G * 8;
    unsigned char* ws = a.ws;
    constexpr int I_IN = 16 * (NPAD_IN / 32), I_UP = 16 * (NUP / 32), I_DN = (DFF / 64) * 32, I_RO = 16 * 32, I_NO = 8 * 32, I_OUT = 16 * 32;
    constexpr int NITEMS = I_IN + I_UP + I_DN + I_RO + I_NO + I_OUT;
    for (int it = gw; it < NITEMS; it += NGW) {
        int r = it;
        if (r < I_IN) { p0_transpose_item(a.in[2], DM, NIN, NPAD_IN / 32, (bf16*)(ws + WS_WIN), a.in[1], scr, r, lane, MapIn()); continue; } r -= I_IN;
        if (r < I_UP) { p0_transpose_item(a.in[16], DM, NUP, NUP / 32, (bf16*)(ws + WS_WUP), a.in[15], scr, r, lane, MapUp()); continue; } r -= I_UP;
        if (r < I_DN) { p0_transpose_item(a.in[19], DFF, DM, 32, (bf16*)(ws + WS_WDN), nullptr, scr, r, lane, MapId()); continue; } r -= I_DN;
        if (r < I_RO) { p0_transpose_item(a.in[12], 1024, DM, 32, (bf16*)(ws + WS_WRO), nullptr, scr, r, lane, MapId()); continue; } r -= I_RO;
        if (r < I_NO) { p0_transpose_item(a.in[13], 512, DM, 32, (bf16*)(ws + WS_WNO), nullptr, scr, r, lane, MapId()); continue; } r -= I_NO;
        p0_transpose_item(a.in[14], DM, DM, 32, (bf16*)(ws + WS_WOUT), nullptr, scr, r, lane, MapId());
    }
    bf16* XB = (bf16*)((unsigned char*)a.out + DO_XB);
    for (int m = gw; m < M; m += NGW) {
        const GAS f32x4* xr = (const GAS f32x4*)(a.in[0] + (size_t)m * DM) + lane;
        f32x4 v[4]; float s = 0.f;
#pragma unroll
        for (int j = 0; j < 4; ++j) { v[j] = xr[64 * j]; s += (v[j].x * v[j].x + v[j].y * v[j].y) + (v[j].z * v[j].z + v[j].w * v[j].w); }
        const float rstd = rsqrtf(wave_sum(s) * (1.f / DM) + EPS);
        GAS unsigned long long* o8 = (GAS unsigned long long*)(XB + (size_t)m * DM) + lane;
#pragma unroll
        for (int j = 0; j < 4; ++j) o8[64 * j] = (unsigned long long)pk2(v[j].x * rstd, v[j].y * rstd) | ((unsigned long long)pk2(v[j].z * rstd, v[j].w * rstd) << 32);
    }
}

__device__ __forceinline__ float ldp(const bf16* P, size_t row, int col) { return bf2f(P[row * PP + col]); }

__device__ __forceinline__ void n_compress(const Args& a, const bf16* P, LAS unsigned char* lds, int G) {
    const int tid = threadIdx.x, sub = tid >> 8, lt = tid & 255;
    LAS float* bv = (LAS float*)(lds + sub * 16384); LAS float* hid = bv + CBLK * NDK;
    for (int it = blockIdx.x; it < NBATCH * NC * 2; it += G) {
        const int u = it * 2 + sub, kv = u & 1, g = (u >> 1) & 1, c = (u >> 2) % NC, b = (u >> 2) / NC;
        const float* pos = a.in[kv ? 8 : 4]; const float* w1 = a.in[kv ? 9 : 5]; const float* b1 = a.in[kv ? 10 : 6]; const float* w2 = a.in[kv ? 11 : 7];
        bf16* out = (bf16*)(a.ws + (kv ? WS_VCMP : WS_KCMP));
        const int colbase = (kv ? PC_VCR : PC_KCR) + g * NDK;
        __syncthreads();
        for (int i = lt; i < CBLK * NDK; i += 256) { const int ii = i >> 6, d = i & 63; bv[i] = ldp(P, (size_t)b * SEQ + c * CSTR + ii, colbase + d) + pos[i]; }
        __syncthreads();
        float acc = b1[lt];
        for (int k = 0; k < CBLK * NDK; ++k) acc += bv[k] * w1[(size_t)k * CHID + lt];
        hid[lt] = gelu_tanh(acc);
        __syncthreads();
        if (lt < NDK) { float o = 0.f; for (int j = 0; j < CHID; ++j) o += hid[j] * w2[j * NDK + lt]; out[(((size_t)b * NG + g) * 128 + c) * NDK + lt] = (bf16)f2bf(o); }
    }
}

template <int MODE>
__device__ __forceinline__ void n_attn(const Args& a, const bf16* P, bf16* NSA, LAS unsigned char* lds, int G) {
    const int tid = threadIdx.x, sub = tid >> 8, r = (tid >> 6) & 3, lane = tid & 63;
    LAS float* qs = (LAS float*)(lds + sub * 16384) + r * 64;
    LAS float* scs = (LAS float*)(lds + sub * 16384 + 1024) + r * 576;
    LAS int* blks = (LAS int*)(lds + sub * 16384 + 1024 + 9216) + r * 12;
    const unsigned* selmask = (const unsigned*)(a.ws + WS_SEL);
    const int kcol = MODE ? PC_KW : PC_KS, vcol = MODE ? PC_VW : PC_VS;
    for (int it = blockIdx.x; it < M; it += G) {
        const int u = it * 2 + sub, g = u & 1, t = u >> 1, tl = t & (SEQ - 1), h = g * NR + r, cur = tl >> 6;
        const size_t rb = (size_t)(t - tl);
        const float slope = exp2f(-(float)(h + 1));
        __syncthreads();
        qs[lane] = ldp(P, t, PC_NQ + h * NDK + lane);
        unsigned mask;
        if (MODE) { const int lo = (tl - (WIN - 1)) > 0 ? ((tl - (WIN - 1)) >> 6) : 0; mask = 0u; for (int j = lo; j <= cur; ++j) mask |= 1u << j; }
        else mask = selmask[t * NG + g];
        int nb = 0;
        for (int j = 0; j < NS; ++j) if ((mask >> j) & 1u) { if (lane == 0) blks[nb] = j; ++nb; }
        __syncthreads();
        float m = -1e30f;
        for (int b = 0; b < nb; ++b) {
            const int s = blks[b] * 64 + lane; const int d = tl - s;
            const bool valid = d >= 0 && (!MODE || d < WIN);
            float sc = -1e30f;
            if (valid) { float dot = 0.f; const bf16* kr = P + (rb + s) * PP + kcol + g * NDK; for (int x = 0; x < NDK; ++x) dot += qs[x] * bf2f(kr[x]); sc = dot * 0.125f - slope * (float)d; }
            scs[b * 64 + lane] = sc; m = fmaxf(m, sc);
        }
        m = wave_max(m);
        float sum = 0.f;
        for (int b = 0; b < nb; ++b) { const float sc = scs[b * 64 + lane]; const float p = sc > -1e29f ? expf(sc - m) : 0.f; scs[b * 64 + lane] = p; sum += p; }
        sum = wave_sum(sum);
        __syncthreads();
        float o = 0.f;
        for (int b = 0; b < nb; ++b) {
            const int s0 = blks[b] * 64;
            for (int i = 0; i < 64; ++i) { const float p = scs[b * 64 + i]; if (p != 0.f) o += p * ldp(P, rb + s0 + i, vcol + g * NDK + lane); }
        }
        const float gate = sigmoidf_(ldp(P, t, PC_GATE + (MODE ? 16 : 8) + h));
        const size_t oi = (size_t)t * 512 + h * NDK + lane;
        float res = gate * o / sum;
        if (!MODE) res += bf2f(NSA[oi]);
        NSA[oi] = (bf16)f2bf(res);
    }
}

__device__ __forceinline__ void n_cmp(const Args& a, const bf16* P, bf16* NSA, LAS unsigned char* lds, int G) {
    const int tid = threadIdx.x, w = tid >> 6, lane = tid & 63;
    LAS float* qs = (LAS float*)(lds + w * 4096);
    LAS float* ps = qs + 256;
    const float* kcmp = (const float*)(a.ws + WS_KCMP); const float* vcmp = (const float*)(a.ws + WS_VCMP);
    unsigned* selmask = (unsigned*)(a.ws + WS_SEL);
    for (int it = blockIdx.x; it < M * NG / 8; it += G) {
        const int u = it * 8 + w, g = u & 1, t = u >> 1, tl = t & (SEQ - 1), b = t >> 11;
        const float* kc = kcmp + ((size_t)b * NG + g) * NC * NDK; const float* vc = vcmp + ((size_t)b * NG + g) * NC * NDK;
        __syncthreads();
        for (int r = 0; r < NR; ++r) qs[r * 64 + lane] = ldp(P, t, PC_NQ + (g * NR + r) * NDK + lane);
        __syncthreads();
        for (int r = 0; r < NR; ++r) {
            const int h = g * NR + r; const float slope = exp2f(-(float)(h + 1));
            float sc[2]; bool val[2];
#pragma unroll
            for (int q = 0; q < 2; ++q) {
                const int c = lane + 64 * q; sc[q] = -1e30f; val[q] = false;
                if (c < NC) {
                    float d = 0.f; const float* kr = kc + (size_t)c * NDK;
                    for (int x = 0; x < NDK; ++x) d += qs[r * 64 + x] * kr[x];
                    const int dc = tl - (c * CSTR + CBLK - 1);
                    if (dc >= 0) { val[q] = true; sc[q] = d * 0.125f - slope * (float)dc; }
                }
            }
            const float mx = wave_max(fmaxf(sc[0], sc[1]));
            float p0 = val[0] ? expf(sc[0] - mx) : 0.f, p1 = val[1] ? expf(sc[1] - mx) : 0.f;
            const float sum = wave_sum(p0 + p1);
            const float inv = sum > 0.f ? 1.f / sum : 0.f;
            ps[r * 128 + lane] = p0 * inv; ps[r * 128 + 64 + lane] = p1 * inv;
        }
        __syncthreads();
        for (int r = 0; r < NR; ++r) {
            const int h = g * NR + r;
            float o = 0.f;
            for (int c = 0; c < NC; ++c) o += ps[r * 128 + c] * vc[(size_t)c * NDK + lane];
            const float gate = sigmoidf_(ldp(P, t, PC_GATE + h));
            const size_t oi = (size_t)t * 512 + h * NDK + lane;
            NSA[oi] = (bf16)f2bf(bf2f(NSA[oi]) + gate * o);
        }
        float imp = 0.f; const int j = lane & 31;
        for (int r = 0; r < NR; ++r)
            for (int c = 4 * j - 1; c <= 4 * j + 3; ++c) if (c >= 0 && c < NC) imp += ps[r * 128 + c];
        const int cur = tl >> 6;
        if (j == 0 || j == cur || j == cur - 1) imp = 1e9f;
        if (j > cur) imp = -1e9f;
        int rank = 0;
        for (int i = 0; i < NS; ++i) { const float o = __shfl(imp, i); rank += (o > imp || (o == imp && i < j)) ? 1 : 0; }
        const unsigned long long bal = __ballot(rank < TOPK && lane < 32 && j <= cur);
        if (lane == 0) selmask[t * NG + g] = (unsigned)bal;
    }
}

__device__ __forceinline__ void n_retention(const Args& a, bf16* P, LAS unsigned char* lds, int G) {
    const int tid = threadIdx.x, sub = tid >> 8, lt = tid & 255;
    LAS float* Qs = (LAS float*)(lds + sub * 49152);
    LAS float* Ks = Qs + 32 * 129;
    LAS float* Vs = Ks + 16 * 129;
    LAS float* Ps = Vs + 16 * 256;
    const float* gn_g = a.in[3];
    for (int p = blockIdx.x; p < NBATCH * 2 * 64; p += G) {
        const int k_ = p >> 8, qt0 = p & 63, qt = (k_ & 1) ? 63 - qt0 : qt0, idx = p >> 6, hp = idx & 1, b = idx >> 1, h = hp * 2 + sub;
        const size_t rb = (size_t)b * SEQ;
        const float lg = log1pf(-exp2f(-5.0f - (float)h));
        const float scale = 0.08838834764831845f;
        __syncthreads();
        for (int i = lt; i < 32 * 128; i += 256) { const int r = i >> 7, c = i & 127; Qs[r * 129 + c] = ldp(P, rb + qt * 32 + r, PC_RQ + h * RDK + c); }
        float acc[32];
#pragma unroll
        for (int e = 0; e < 32; ++e) acc[e] = 0.f;
        const int pi = lt >> 3, pj0 = (lt & 7) * 2;
        for (int kt = 0; kt <= 2 * qt + 1; ++kt) {
            __syncthreads();
            for (int i = lt; i < 16 * 128; i += 256) { const int r = i >> 7, c = i & 127; Ks[r * 129 + c] = ldp(P, rb + kt * 16 + r, PC_RK + h * RDK + c); }
            for (int i = lt; i < 16 * 256; i += 256) { const int r = i >> 8, c = i & 255; Vs[r * 256 + c] = ldp(P, rb + kt * 16 + r, PC_RV + h * RDV + c); }
            __syncthreads();
#pragma unroll
            for (int jj = 0; jj < 2; ++jj) {
                const int j = pj0 + jj; float d = 0.f;
                for (int c = 0; c < 128; ++c) d += Qs[pi * 129 + c] * Ks[j * 129 + c];
                const int diff = (qt * 32 + pi) - (kt * 16 + j);
                Ps[pi * 17 + j] = diff >= 0 ? d * scale * expf(lg * (float)diff) : 0.f;
            }
            __syncthreads();
            for (int j = 0; j < 16; ++j) {
                const float pv = Ps[pi * 17 + j];
#pragma unroll
                for (int e = 0; e < 32; ++e) acc[e] += pv * Vs[j * 256 + (lt & 7) + 8 * e];
            }
        }
        float s = 0.f;
#pragma unroll
        for (int e = 0; e < 32; ++e) s += acc[e];
        s += __shfl_xor(s, 1); s += __shfl_xor(s, 2); s += __shfl_xor(s, 4);
        const float mu = s / 256.f;
        float q = 0.f;
#pragma unroll
        for (int e = 0; e < 32; ++e) { const float d = acc[e] - mu; q += d * d; }
        q += __shfl_xor(q, 1); q += __shfl_xor(q, 2); q += __shfl_xor(q, 4);
        const float rstd = rsqrtf(q / 256.f + EPS);
        const size_t t = rb + qt * 32 + pi;
#pragma unroll
        for (int e = 0; e < 32; ++e) {
            const int col = h * RDV + (lt & 7) + 8 * e;
            const float on = (acc[e] - mu) * rstd * gn_g[col];
            const float gg = ldp(P, t, PC_RG + col);
            P[t * PP + PC_RG + col] = (bf16)f2bf(gg * sigmoidf_(gg) * on);
        }
    }
}

__device__ __forceinline__ void n_conv(const Args& a, bf16* P, int G) {
    const float* cw = a.in[17]; const float* cb = a.in[18];
    const size_t total = (size_t)M * (DFF / 8);
    for (size_t i = (size_t)blockIdx.x * 512 + threadIdx.x; i < total; i += (size_t)G * 512) {
        const int t = (int)(i / (DFF / 8)), f8 = (int)(i % (DFF / 8)) * 8, pn = f8 >> 7, j = f8 & 127, tl = t & (SEQ - 1);
        bf16* pa = P + (size_t)t * PP + PC_UP + 256 * pn + j;
        const v4u a0 = *(const v4u*)pa, bb = *(const v4u*)(pa + 128);
        v4u a1 = (v4u){0u, 0u, 0u, 0u}, a2 = a1;
        if (tl >= 1) a1 = *(const v4u*)(pa - PP);
        if (tl >= 2) a2 = *(const v4u*)(pa - 2 * PP);
        unsigned o[4];
#pragma unroll
        for (int q = 0; q < 4; ++q) {
            float r2[2];
#pragma unroll
            for (int hh = 0; hh < 2; ++hh) {
                const int f = f8 + 2 * q + hh;
                const float x0 = hh ? pg8::bf_hi(a0[q]) : pg8::bf_lo(a0[q]), x1 = hh ? pg8::bf_hi(a1[q]) : pg8::bf_lo(a1[q]), x2 = hh ? pg8::bf_hi(a2[q]) : pg8::bf_lo(a2[q]);
                const float bv = hh ? pg8::bf_hi(bb[q]) : pg8::bf_lo(bb[q]);
                const float ac = cb[f] + cw[2 * DFF + f] * x0 + cw[DFF + f] * x1 + cw[f] * x2;
                r2[hh] = gelu_tanh(ac) * bv;
            }
            o[q] = pk2(r2[0], r2[1]);
        }
        *(v4u*)(pa + 128) = (v4u){o[0], o[1], o[2], o[3]};
    }
}

__device__ __forceinline__ void n_final(const Args& a, int G) {
    const int lane = threadIdx.x & 63, gw = blockIdx.x * 8 + (threadIdx.x >> 6), NGW = G * 8;
    const float* rs3 = (const float*)(a.ws + WS_RS3); const float* gf = a.in[20];
    for (int m = gw; m < M; m += NGW) {
        const float rstd = rsqrtf(rs3[m] * (1.f / DM) + EPS);
        f32x4* xr = (f32x4*)(a.out + (size_t)m * DM) + lane;
#pragma unroll
        for (int j = 0; j < 4; ++j) { const f32x4 gv = *((const f32x4*)gf + lane + 64 * j); f32x4 v = xr[64 * j]; v = v * rstd * gv; xr[64 * j] = v; }
    }
}


typedef short bf16x8 __attribute__((ext_vector_type(8)));
typedef float f32x16 __attribute__((ext_vector_type(16)));
typedef float f32x2_t __attribute__((ext_vector_type(2))); typedef __bf16 bf16x2_t __attribute__((ext_vector_type(2)));
typedef unsigned v2u __attribute__((ext_vector_type(2)));
#define MFMA32(a, b, c) __builtin_amdgcn_mfma_f32_32x32x16_bf16((a), (b), (c), 0, 0, 0)
__device__ __forceinline__ unsigned cvtpk(float lo, float hi) { f32x2_t v = {lo, hi}; bf16x2_t b = __builtin_convertvector(v, bf16x2_t); return __builtin_bit_cast(unsigned, b); }
__device__ __forceinline__ float xhalf_max(float m) { auto rr = __builtin_amdgcn_permlane32_swap(__float_as_uint(m), __float_as_uint(m), false, false); return fmaxf(__uint_as_float(rr[0]), __uint_as_float(rr[1])); }
__device__ __forceinline__ float xhalf_sum(float m) { auto rr = __builtin_amdgcn_permlane32_swap(__float_as_uint(m), __float_as_uint(m), false, false); return __uint_as_float(rr[0]) + __uint_as_float(rr[1]); }
__device__ __forceinline__ bf16x8 pack8(const f32x16& x, int s) {
    v4u p; p.x = cvtpk(x[8 * s], x[8 * s + 1]); p.y = cvtpk(x[8 * s + 2], x[8 * s + 3]); p.z = cvtpk(x[8 * s + 4], x[8 * s + 5]); p.w = cvtpk(x[8 * s + 6], x[8 * s + 7]);
    return __builtin_bit_cast(bf16x8, p);
}
constexpr float LOG2E = 1.4426950408889634f;
constexpr int AT_KSTR = 144, AT_VSTR = 136, AT_VOFF = 64 * AT_KSTR, AT_BUF = AT_VOFF + 64 * AT_VSTR;

template <int MODE>
__device__ __forceinline__ void attn_unit(const bf16* P, bf16* NSA, const unsigned* selmask, LAS unsigned char* lds, int b, int g, int n) {
    const int tid = threadIdx.x, lane = tid & 63, wid = tid >> 6, q = lane & 31, h = lane >> 5;
    const int r = wid >> 1, th = wid & 1, head = g * NR + r;
    const int tl = 64 * n + 32 * th + q;
    const size_t rb = (size_t)b * SEQ, trow = rb + tl;
    bf16x8 qf[4];
    { const bf16* qp = P + trow * PP + PC_NQ + head * NDK + 8 * h;
#pragma unroll
      for (int ks = 0; ks < 4; ++ks) qf[ks] = *(const bf16x8*)(qp + 16 * ks); }
    const float slope2 = exp2f(-(float)(head + 1)) * LOG2E, c1 = 0.125f * LOG2E;
    const unsigned smask = MODE == 0 ? selmask[trow * NG + g] : 0u;
    const int j0 = MODE == 1 ? (n > 8 ? n - 8 : 0) : 0, j1 = n;
    f32x16 o0, o1;
#pragma unroll
    for (int i = 0; i < 16; ++i) { o0[i] = 0.f; o1[i] = 0.f; }
    float m = -1e30f, l = 0.f;
    const int skey = tid >> 3, sch = tid & 7;
    const bf16* kg = P + (rb + skey) * PP + (MODE ? PC_KW : PC_KS) + g * NDK + 8 * sch;
    const bf16* vg = P + (rb + skey) * PP + (MODE ? PC_VW : PC_VS) + g * NDK + 8 * sch;
    v4u kreg = *(const v4u*)(kg + (size_t)(64 * j0) * PP), vreg = *(const v4u*)(vg + (size_t)(64 * j0) * PP);
#define AT_WRITE(bufi) do { LAS unsigned char* kb_ = lds + (bufi) * AT_BUF; *(LAS v4u*)(kb_ + skey * AT_KSTR + sch * 16) = kreg; \
        LAS bf16* vb_ = (LAS bf16*)(kb_ + AT_VOFF) + skey; \
        _Pragma("unroll") for (int i_ = 0; i_ < 4; ++i_) { vb_[(8 * sch + 2 * i_) * (AT_VSTR / 2)] = (bf16)(vreg[i_] & 0xffffu); vb_[(8 * sch + 2 * i_ + 1) * (AT_VSTR / 2)] = (bf16)(vreg[i_] >> 16); } } while (0)
    AT_WRITE(0);
    __syncthreads();
    for (int j = j0; j <= j1; ++j) {
        const int cur = (j - j0) & 1;
        if (j < j1) { kreg = *(const v4u*)(kg + (size_t)(64 * (j + 1)) * PP); vreg = *(const v4u*)(vg + (size_t)(64 * (j + 1)) * PP); }
        LAS unsigned char* kb = lds + cur * AT_BUF;
        f32x16 s0, s1;
#pragma unroll
        for (int i = 0; i < 16; ++i) { s0[i] = 0.f; s1[i] = 0.f; }
#pragma unroll
        for (int ks = 0; ks < 4; ++ks) {
            const bf16x8 a0 = *(const LAS bf16x8*)(kb + q * AT_KSTR + ks * 32 + h * 16);
            const bf16x8 a1 = *(const LAS bf16x8*)(kb + (q + 32) * AT_KSTR + ks * 32 + h * 16);
            s0 = MFMA32(a0, qf[ks], s0); s1 = MFMA32(a1, qf[ks], s1);
        }
        const float lt = slope2 * (float)(64 * j + 4 * h - tl);
        const bool need_mask = (j == n) || (MODE == 1 && j == n - 8);
        const bool lane_ok = MODE == 0 ? ((smask >> j) & 1u) != 0u : true;
        const int dbase = tl - 64 * j - 4 * h;
        float mx = -INFINITY;
#pragma unroll
        for (int i = 0; i < 16; ++i) {
            const int kk = (i & 3) + 8 * (i >> 2);
            float z0 = fmaf(s0[i], c1, lt + slope2 * (float)kk), z1 = fmaf(s1[i], c1, lt + slope2 * (float)(kk + 32));
            if (need_mask) { const int d0 = dbase - kk, d1 = d0 - 32;
                if (!(d0 >= 0 && (MODE == 0 || d0 < WIN))) z0 = -INFINITY;
                if (!(d1 >= 0 && (MODE == 0 || d1 < WIN))) z1 = -INFINITY; }
            if (!lane_ok) { z0 = -INFINITY; z1 = -INFINITY; }
            s0[i] = z0; s1[i] = z1; mx = fmaxf(mx, fmaxf(z0, z1));
        }
        mx = xhalf_max(mx);
        const float mn = fmaxf(m, mx), alpha = __builtin_amdgcn_exp2f(m - mn);
        m = mn;
        float ps = 0.f;
#pragma unroll
        for (int i = 0; i < 16; ++i) { s0[i] = __builtin_amdgcn_exp2f(s0[i] - mn); s1[i] = __builtin_amdgcn_exp2f(s1[i] - mn); ps += s0[i] + s1[i]; }
        l = l * alpha + ps;
#pragma unroll
        for (int i = 0; i < 16; ++i) { o0[i] *= alpha; o1[i] *= alpha; }
        bf16x8 pf[4];
        pf[0] = pack8(s0, 0); pf[1] = pack8(s0, 1); pf[2] = pack8(s1, 0); pf[3] = pack8(s1, 1);
        const LAS unsigned char* vb = kb + AT_VOFF + q * AT_VSTR + 8 * h;
#pragma unroll
        for (int ks = 0; ks < 4; ++ks) {
            { const v2u lo = *(const LAS v2u*)(vb + ks * 32), hi = *(const LAS v2u*)(vb + ks * 32 + 16);
              const v4u av = (v4u){lo.x, lo.y, hi.x, hi.y}; o0 = MFMA32(__builtin_bit_cast(bf16x8, av), pf[ks], o0); }
            { const v2u lo = *(const LAS v2u*)(vb + 32 * AT_VSTR + ks * 32), hi = *(const LAS v2u*)(vb + 32 * AT_VSTR + ks * 32 + 16);
              const v4u av = (v4u){lo.x, lo.y, hi.x, hi.y}; o1 = MFMA32(__builtin_bit_cast(bf16x8, av), pf[ks], o1); }
        }
        if (j < j1) AT_WRITE(cur ^ 1);
        __syncthreads();
    }
#undef AT_WRITE
    l = xhalf_sum(l);
    const float gate = pg8::fsig(bf2f(P[trow * PP + PC_GATE + (MODE ? 16 : 8) + head]));
    const float f = gate / l;
    bf16* op = NSA + trow * 512 + head * NDK + 4 * h;
#pragma unroll
    for (int dt = 0; dt < 2; ++dt)
#pragma unroll
        for (int rg = 0; rg < 4; ++rg) {
            const f32x16& o = dt ? o1 : o0;
            float v0 = o[4 * rg] * f, v1 = o[4 * rg + 1] * f, v2 = o[4 * rg + 2] * f, v3 = o[4 * rg + 3] * f;
            v2u* dst = (v2u*)(op + 32 * dt + 8 * rg);
            if (MODE == 0) { const v2u pv = *dst; v0 += pg8::bf_lo(pv.x); v1 += pg8::bf_hi(pv.x); v2 += pg8::bf_lo(pv.y); v3 += pg8::bf_hi(pv.y); }
            *dst = (v2u){cvtpk(v0, v1), cvtpk(v2, v3)};
        }
}
template <int MODE>
__device__ __forceinline__ void attn_phase(const Args& a, const bf16* P, bf16* NSA, LAS unsigned char* lds, int G) {
    const unsigned* selmask = (const unsigned*)(a.ws + WS_SEL);
    __syncthreads();
    for (int u = blockIdx.x; u < NBATCH * NG * NS; u += G) {
        const int i = u & 255, k = u >> 8, aa = i & 15, hi = i >> 4;
        const int nn = (k & 2) ? ((aa + 8) & 15) : aa, n = (k & 1) ? 31 - nn : nn, bg = hi + 16 * (k >> 1);
        attn_unit<MODE>(P, NSA, selmask, lds, bg >> 1, bg & 1, n);
    }
}


typedef short v4i16_t __attribute__((ext_vector_type(4)));
__device__ __forceinline__ v4i16_t ds_tr(const LAS unsigned char* p) { return __builtin_amdgcn_ds_read_tr16_b64_v4i16((LAS v4i16_t*)p); }
__device__ __forceinline__ bf16x8 tr_frag(const LAS unsigned char* base, int R, int k0, int n0, int lane) {
    const int grp = lane >> 4, li = lane & 15, qq = li >> 2, pp = li & 3, ngrp = grp & 1, hh = grp >> 1;
    const LAS unsigned char* a = base + (k0 + 8 * hh + qq) * R + (n0 + 16 * ngrp + 4 * pp) * 2;
    const v4i16_t lo = ds_tr(a), hi = ds_tr(a + 4 * R);
    return (bf16x8){lo[0], lo[1], lo[2], lo[3], hi[0], hi[1], hi[2], hi[3]};
}
__device__ __forceinline__ bf16x8 tr_frag_perm(const LAS unsigned char* base, int R, int k0, int n0, int lane) {
    const int grp = lane >> 4, li = lane & 15, qq = li >> 2, pp = li & 3, ngrp = grp & 1, hh = grp >> 1;
    const LAS unsigned char* a = base + (k0 + 4 * hh + qq) * R + (n0 + 16 * ngrp + 4 * pp) * 2;
    const v4i16_t lo = ds_tr(a), hi = ds_tr(a + 8 * R);
    return (bf16x8){lo[0], lo[1], lo[2], lo[3], hi[0], hi[1], hi[2], hi[3]};
}
__device__ __forceinline__ v4u scale8(v4u v, float sc) {
    v4u o;
#pragma unroll
    for (int i = 0; i < 4; ++i) o[i] = cvtpk(pg8::bf_lo(v[i]) * sc, pg8::bf_hi(v[i]) * sc);
    return o;
}
__device__ __forceinline__ float ret_lg2(int hd) { return log2f(1.0f - exp2f(-5.0f - (float)hd)); }

constexpr int RT_VSTR = 576, RT_KSTR = 320, RO_STR = 272;
constexpr size_t KV_UNIT = 256 * 128;
__device__ __forceinline__ void ret_kv_unit(const bf16* P, bf16* KVS, LAS unsigned char* lds, int b, int hd, int n) {
    const int tid = threadIdx.x, lane = tid & 63, wid = tid >> 6, h = lane >> 5;
    const float lg2 = ret_lg2(hd);
    LAS unsigned char* Vs = lds; LAS unsigned char* Ks = lds + 128 * RT_VSTR;
    const size_t rowbase = (size_t)b * SEQ + 128 * n;
    __syncthreads();
#pragma unroll
    for (int i = 0; i < 8; ++i) { const int idx = tid + 512 * i, row = idx >> 5, ch = idx & 31;
        *(LAS v4u*)(Vs + row * RT_VSTR + ch * 16) = *(const v4u*)(P + (rowbase + row) * PP + PC_RV + hd * RDV + 8 * ch); }
#pragma unroll
    for (int i = 0; i < 4; ++i) { const int idx = tid + 512 * i, row = idx >> 4, ch = idx & 15;
        const float sc = 0.08838834764831845f * exp2f(lg2 * (float)(127 - row));
        *(LAS v4u*)(Ks + row * RT_KSTR + ch * 16) = scale8(*(const v4u*)(P + (rowbase + row) * PP + PC_RK + hd * RDK + 8 * ch), sc); }
    __syncthreads();
    f32x16 acc[4];
#pragma unroll
    for (int d = 0; d < 4; ++d)
#pragma unroll
        for (int i = 0; i < 16; ++i) acc[d][i] = 0.f;
#pragma unroll 2
    for (int ks = 0; ks < 8; ++ks) {
        const bf16x8 A = tr_frag(Vs, RT_VSTR, 16 * ks, 32 * wid, lane);
#pragma unroll
        for (int dt = 0; dt < 4; ++dt) { const bf16x8 B = tr_frag(Ks, RT_KSTR, 16 * ks, 32 * dt, lane); acc[dt] = MFMA32(A, B, acc[dt]); }
    }
    bf16* ob = KVS + (size_t)(((b * RH + hd) * 16 + n)) * KV_UNIT;
#pragma unroll
    for (int dt = 0; dt < 4; ++dt)
#pragma unroll
        for (int i = 0; i < 16; ++i) { const int e = 32 * wid + (i & 3) + 8 * (i >> 2) + 4 * h, d = 32 * dt + (lane & 31); ob[e * 128 + d] = (bf16)f2bf(acc[dt][i]); }
}
__device__ __forceinline__ void ret_kv_phase(const bf16* P, bf16* KVS, LAS unsigned char* lds, int G) {
    for (int u = blockIdx.x; u < NBATCH * RH * 16; u += G) ret_kv_unit(P, KVS, lds, u >> 6, (u >> 4) & 3, u & 15);
}
__device__ __forceinline__ void ret_scan_phase(bf16* KVS, int G) {
    for (int it = blockIdx.x * 512 + threadIdx.x; it < NBATCH * RH * 4096; it += G * 512) {
        const int bh = it >> 12, off = (it & 4095) * 8, hd = bh & 3;
        const float decay = exp2f(128.0f * ret_lg2(hd));
        float st[8];
#pragma unroll
        for (int i = 0; i < 8; ++i) st[i] = 0.f;
        bf16* p = KVS + (size_t)bh * 16 * KV_UNIT + off;
        for (int n = 0; n < 16; ++n, p += KV_UNIT) {
            const v4u v = *(const v4u*)p;
            *(v4u*)p = (v4u){cvtpk(st[0], st[1]), cvtpk(st[2], st[3]), cvtpk(st[4], st[5]), cvtpk(st[6], st[7])};
#pragma unroll
            for (int i = 0; i < 4; ++i) { st[2 * i] = st[2 * i] * decay + pg8::bf_lo(v[i]); st[2 * i + 1] = st[2 * i + 1] * decay + pg8::bf_hi(v[i]); }
        }
    }
}
constexpr int RO_QS = 0, RO_SB = 128 * RO_STR, RO_X = 2 * 128 * RO_STR, RO_STATS = RO_X + 128 * RT_VSTR;
static_assert(RO_STATS + 2048 <= 147456 && 256 * RO_STR <= 128 * RT_VSTR, "retention LDS map");
__device__ __forceinline__ void ret_out_unit(bf16* P, const bf16* KVS, const float* gn_g, LAS unsigned char* lds, int b, int hd, int n) {
    const int tid = threadIdx.x, lane = tid & 63, wid = tid >> 6, q = lane & 31, h = lane >> 5;
    const float lg2 = ret_lg2(hd);
    LAS unsigned char* Qs = lds + RO_QS; LAS unsigned char* Sb = lds + RO_SB; LAS unsigned char* X = lds + RO_X;
    const size_t rowbase = (size_t)b * SEQ + 128 * n;
    __syncthreads();
#pragma unroll
    for (int i = 0; i < 4; ++i) { const int idx = tid + 512 * i, row = idx >> 4, ch = idx & 15;
        const float e1 = exp2f(lg2 * (float)(row + 1));
        *(LAS v4u*)(Qs + row * RO_STR + ch * 16) = scale8(*(const v4u*)(P + (rowbase + row) * PP + PC_RQ + hd * RDK + 8 * ch), e1);
        *(LAS v4u*)(X + row * RO_STR + ch * 16) = scale8(*(const v4u*)(P + (rowbase + row) * PP + PC_RK + hd * RDK + 8 * ch), 0.08838834764831845f / e1); }
    __syncthreads();
    const int tt = wid & 3, sh = wid >> 2, trl = 32 * tt + q;
#pragma unroll
    for (int si = 0; si < 2; ++si) {
        const int st = 2 * sh + si;
        if (st > tt) {
#pragma unroll
            for (int rg = 0; rg < 4; ++rg) *(LAS v2u*)(Sb + trl * RO_STR + (32 * st + 8 * rg + 4 * h) * 2) = (v2u){0u, 0u};
        } else {
            f32x16 s;
#pragma unroll
            for (int i = 0; i < 16; ++i) s[i] = 0.f;
#pragma unroll
            for (int ks = 0; ks < 8; ++ks) {
                const bf16x8 a = *(const LAS bf16x8*)(X + (32 * st + q) * RO_STR + ks * 32 + h * 16);
                const bf16x8 bq = *(const LAS bf16x8*)(Qs + trl * RO_STR + ks * 32 + h * 16);
                s = MFMA32(a, bq, s);
            }
#pragma unroll
            for (int rg = 0; rg < 4; ++rg) { const int s0 = 32 * st + 8 * rg + 4 * h;
                const float v0 = (s0 <= trl) ? s[4 * rg] : 0.f, v1 = (s0 + 1 <= trl) ? s[4 * rg + 1] : 0.f, v2 = (s0 + 2 <= trl) ? s[4 * rg + 2] : 0.f, v3 = (s0 + 3 <= trl) ? s[4 * rg + 3] : 0.f;
                *(LAS v2u*)(Sb + trl * RO_STR + s0 * 2) = (v2u){cvtpk(v0, v1), cvtpk(v2, v3)}; }
        }
    }
    __syncthreads();
#pragma unroll
    for (int i = 0; i < 8; ++i) { const int idx = tid + 512 * i, row = idx >> 5, ch = idx & 31;
        *(LAS v4u*)(X + row * RT_VSTR + ch * 16) = *(const v4u*)(P + (rowbase + row) * PP + PC_RV + hd * RDV + 8 * ch); }
    __syncthreads();
    const int eh = wid >> 2;
    f32x16 acc[4];
#pragma unroll
    for (int d = 0; d < 4; ++d)
#pragma unroll
        for (int i = 0; i < 16; ++i) acc[d][i] = 0.f;
    for (int ks = 0; ks < 2 * (tt + 1); ++ks) {
        const bf16x8 bS = *(const LAS bf16x8*)(Sb + trl * RO_STR + ks * 32 + h * 16);
#pragma unroll
        for (int et = 0; et < 4; ++et) { const bf16x8 A = tr_frag(X, RT_VSTR, 16 * ks, 32 * (4 * eh + et), lane); acc[et] = MFMA32(A, bS, acc[et]); }
    }
    __syncthreads();
    { const bf16* rt = KVS + (size_t)(((b * RH + hd) * 16 + n)) * KV_UNIT;
#pragma unroll
      for (int i = 0; i < 8; ++i) { const int idx = tid + 512 * i, row = idx >> 4, ch = idx & 15;
          *(LAS v4u*)(X + row * RO_STR + ch * 16) = *(const v4u*)(rt + row * 128 + 8 * ch); } }
    __syncthreads();
#pragma unroll 2
    for (int ks = 0; ks < 8; ++ks) {
        const bf16x8 bQ = *(const LAS bf16x8*)(Qs + trl * RO_STR + ks * 32 + h * 16);
#pragma unroll
        for (int et = 0; et < 4; ++et) { const bf16x8 A = *(const LAS bf16x8*)(X + (32 * (4 * eh + et) + q) * RO_STR + ks * 32 + h * 16); acc[et] = MFMA32(A, bQ, acc[et]); }
    }
    float s1 = 0.f, s2 = 0.f;
#pragma unroll
    for (int et = 0; et < 4; ++et)
#pragma unroll
        for (int i = 0; i < 16; ++i) { s1 += acc[et][i]; s2 += acc[et][i] * acc[et][i]; }
    s1 = xhalf_sum(s1); s2 = xhalf_sum(s2);
    LAS float* stats = (LAS float*)(lds + RO_STATS);
    if (h == 0) { stats[(eh * 128 + trl) * 2] = s1; stats[(eh * 128 + trl) * 2 + 1] = s2; }
    __syncthreads();
    s1 = stats[trl * 2] + stats[(128 + trl) * 2]; s2 = stats[trl * 2 + 1] + stats[(128 + trl) * 2 + 1];
    const float mu = s1 * (1.f / 256.f), rstd = rsqrtf(fmaxf(s2 * (1.f / 256.f) - mu * mu, 0.f) + EPS);
    bf16* gp = P + (rowbase + trl) * PP + PC_RG + hd * RDV;
    const float* gg = gn_g + hd * RDV;
#pragma unroll
    for (int et = 0; et < 4; ++et)
#pragma unroll
        for (int rg = 0; rg < 4; ++rg) {
            const int e0 = 32 * (4 * eh + et) + 8 * rg + 4 * h;
            const v2u gv = *(const v2u*)(gp + e0); const f32x4 gn = *(const f32x4*)(gg + e0);
            const float g0 = pg8::bf_lo(gv.x), g1 = pg8::bf_hi(gv.x), g2 = pg8::bf_lo(gv.y), g3 = pg8::bf_hi(gv.y);
            const float o0 = (acc[et][4 * rg] - mu) * rstd * gn[0] * g0 * pg8::fsig(g0), o1 = (acc[et][4 * rg + 1] - mu) * rstd * gn[1] * g1 * pg8::fsig(g1);
            const float o2 = (acc[et][4 * rg + 2] - mu) * rstd * gn[2] * g2 * pg8::fsig(g2), o3 = (acc[et][4 * rg + 3] - mu) * rstd * gn[3] * g3 * pg8::fsig(g3);
            *(v2u*)(gp + e0) = (v2u){cvtpk(o0, o1), cvtpk(o2, o3)};
        }
}
__device__ __forceinline__ void ret_out_phase(bf16* P, const bf16* KVS, const float* gn_g, LAS unsigned char* lds, int G) {
    for (int u = blockIdx.x; u < NBATCH * RH * 16; u += G) ret_out_unit(P, KVS, gn_g, lds, u >> 6, (u >> 4) & 3, u & 15);
}

constexpr int CM_KSTR = 144, CM_VSTR = 192;
constexpr int CM_K = 0, CM_V = 128 * CM_KSTR, CM_GW = CM_V + 128 * CM_VSTR, CM_TW = CM_GW + 32768, CM_IMP = CM_TW + 32768;
__device__ __forceinline__ void cmp_unit(const bf16* P, bf16* NSA, const bf16* KC, const bf16* VC, unsigned* selmask, LAS unsigned char* lds, int b, int g, int n) {
    const int tid = threadIdx.x, lane = tid & 63, wid = tid >> 6, q = lane & 31, h = lane >> 5;
    const int r = wid >> 1, th = wid & 1, head = g * NR + r;
    const int tok = 32 * th + q, tl = 64 * n + tok;
    const size_t rb = (size_t)b * SEQ, trow = rb + tl;
    bf16x8 qf[4];
    { const bf16* qp = P + trow * PP + PC_NQ + head * NDK + 8 * h;
#pragma unroll
      for (int ks = 0; ks < 4; ++ks) qf[ks] = *(const bf16x8*)(qp + 16 * ks); }
    const float slope2 = exp2f(-(float)(head + 1)) * LOG2E, c1 = 0.125f * LOG2E;
    __syncthreads();
#pragma unroll
    for (int i = 0; i < 2; ++i) { const int idx = tid + 512 * i, row = idx >> 3, ch = idx & 7;
        v4u kv = (v4u){0u, 0u, 0u, 0u}, vv = kv;
        if (row < NC) { kv = *(const v4u*)(KC + ((size_t)(b * NG + g) * 128 + row) * NDK + 8 * ch); vv = *(const v4u*)(VC + ((size_t)(b * NG + g) * 128 + row) * NDK + 8 * ch); }
        *(LAS v4u*)(lds + CM_K + row * CM_KSTR + ch * 16) = kv; *(LAS v4u*)(lds + CM_V + row * CM_VSTR + ch * 16) = vv; }
    __syncthreads();
    const int ktmax = (4 * n + 2) >> 5;
    f32x16 s[4];
#pragma unroll
    for (int kt = 0; kt < 4; ++kt) {
#pragma unroll
        for (int i = 0; i < 16; ++i) s[kt][i] = 0.f;
        if (kt <= ktmax) {
#pragma unroll
            for (int ks = 0; ks < 4; ++ks) { const bf16x8 a = *(const LAS bf16x8*)(lds + CM_K + (32 * kt + q) * CM_KSTR + ks * 32 + h * 16); s[kt] = MFMA32(a, qf[ks], s[kt]); }
        }
    }
    float mx = -INFINITY;
#pragma unroll
    for (int kt = 0; kt < 4; ++kt)
#pragma unroll
        for (int i = 0; i < 16; ++i) { const int c = 32 * kt + (i & 3) + 8 * (i >> 2) + 4 * h, dc = tl - (c * CSTR + CBLK - 1);
            const float z = (dc >= 0 && kt <= ktmax) ? fmaf(s[kt][i], c1, -slope2 * (float)dc) : -INFINITY;
            s[kt][i] = z; mx = fmaxf(mx, z); }
    mx = xhalf_max(mx);
    const float mref = (mx == -INFINITY) ? 0.f : mx;
    float sum = 0.f;
#pragma unroll
    for (int kt = 0; kt < 4; ++kt)
#pragma unroll
        for (int i = 0; i < 16; ++i) { s[kt][i] = __builtin_amdgcn_exp2f(s[kt][i] - mref); sum += s[kt][i]; }
    sum = xhalf_sum(sum);
    const float inv = sum > 0.f ? 1.f / sum : 0.f;
    LAS float* GW = (LAS float*)(lds + CM_GW); LAS float* TW = (LAS float*)(lds + CM_TW);
#pragma unroll
    for (int kt = 0; kt < 4; ++kt) {
#pragma unroll
        for (int i = 0; i < 16; ++i) s[kt][i] *= inv;
#pragma unroll
        for (int rg = 0; rg < 4; ++rg) { const int j = 8 * kt + 2 * rg + h;
            GW[(r * 64 + tok) * 32 + j] = (s[kt][4 * rg] + s[kt][4 * rg + 1]) + (s[kt][4 * rg + 2] + s[kt][4 * rg + 3]);
            TW[(r * 64 + tok) * 32 + j] = s[kt][4 * rg + 3]; }
    }
    f32x16 o0, o1;
#pragma unroll
    for (int i = 0; i < 16; ++i) { o0[i] = 0.f; o1[i] = 0.f; }
#pragma unroll
    for (int kt = 0; kt < 4; ++kt) {
        if (kt <= ktmax) {
#pragma unroll
            for (int sp = 0; sp < 2; ++sp) { const bf16x8 pf = pack8(s[kt], sp);
                const bf16x8 A0 = tr_frag_perm(lds + CM_V, CM_VSTR, 32 * kt + 16 * sp, 0, lane), A1 = tr_frag_perm(lds + CM_V, CM_VSTR, 32 * kt + 16 * sp, 32, lane);
                o0 = MFMA32(A0, pf, o0); o1 = MFMA32(A1, pf, o1); }
        }
    }
    { const float gate = pg8::fsig(bf2f(P[trow * PP + PC_GATE + head]));
      bf16* op = NSA + trow * 512 + head * NDK + 4 * h;
#pragma unroll
      for (int dt = 0; dt < 2; ++dt)
#pragma unroll
          for (int rg = 0; rg < 4; ++rg) {
              const f32x16& o = dt ? o1 : o0;
              v2u* dst = (v2u*)(op + 32 * dt + 8 * rg); const v2u pv = *dst;
              const float v0 = o[4 * rg] * gate + pg8::bf_lo(pv.x), v1 = o[4 * rg + 1] * gate + pg8::bf_hi(pv.x), v2 = o[4 * rg + 2] * gate + pg8::bf_lo(pv.y), v3 = o[4 * rg + 3] * gate + pg8::bf_hi(pv.y);
              *dst = (v2u){cvtpk(v0, v1), cvtpk(v2, v3)};
          } }
    __syncthreads();
    LAS float* IMP = (LAS float*)(lds + CM_IMP);
    const int j = tid & 31;
#pragma unroll
    for (int pass = 0; pass < 4; ++pass) { const int tk = (tid >> 5) + 16 * pass;
        float imp = 0.f;
#pragma unroll
        for (int rr = 0; rr < 4; ++rr) { imp += GW[(rr * 64 + tk) * 32 + j]; if (j > 0) imp += TW[(rr * 64 + tk) * 32 + j - 1]; }
        if (j == 0 || j == n || j == n - 1) imp = 1e9f;
        if (j > n) imp = -1e9f;
        IMP[tk * 32 + j] = imp; }
    __syncthreads();
#pragma unroll
    for (int pass = 0; pass < 4; ++pass) { const int tk = (tid >> 5) + 16 * pass;
        const float mine = IMP[tk * 32 + j]; int rank = 0;
        for (int i = 0; i < 32; ++i) { const float o = IMP[tk * 32 + i]; rank += (o > mine || (o == mine && i < j)) ? 1 : 0; }
        const unsigned long long bal = __ballot(rank < TOPK && j <= n);
        if ((lane & 31) == 0) selmask[(rb + 64 * n + tk) * NG + g] = (unsigned)(bal >> (lane & 32)); }
}
__device__ __forceinline__ void cmp_phase(const Args& a, const bf16* P, bf16* NSA, LAS unsigned char* lds, int G) {
    const bf16* KC = (const bf16*)(a.ws + WS_KCMP); const bf16* VC = (const bf16*)(a.ws + WS_VCMP);
    unsigned* selmask = (unsigned*)(a.ws + WS_SEL);
    for (int u = blockIdx.x; u < NBATCH * NG * NS; u += G) {
        const int i = u & 255, k = u >> 8, aa = i & 15, hi = i >> 4;
        const int nn = (k & 2) ? ((aa + 8) & 15) : aa, n = (k & 1) ? 31 - nn : nn, bg = hi + 16 * (k >> 1);
        cmp_unit(P, NSA, KC, VC, selmask, lds, bg >> 1, bg & 1, n);
    }
}

__global__ void __launch_bounds__(512, 2) mega_fwd(Args a) {
    extern __shared__ __attribute__((aligned(16))) unsigned char lds_raw[];
    LAS unsigned char* lds = (LAS unsigned char*)lds_raw;
    volatile LAS unsigned* MISC = (volatile LAS unsigned*)(lds + MISC_OFF);
    const int tid = threadIdx.x, G = gridDim.x;
    for (int u = tid; u < (LDS_BYTES - 131072) / 4; u += 512) ((LAS unsigned*)(lds + 131072))[u] = 0u;
    __syncthreads();
    unsigned* ctl = (unsigned*)(a.ws + WS_CTL);
    XcdBarrier bar = xcd_barrier_post(ctl + CW_BAR, MISC + 8);
    bf16* P = (bf16*)(a.ws + WS_PROJ);
    bf16* XB = (bf16*)((unsigned char*)a.out + DO_XB);
    bf16* NSA = (bf16*)((unsigned char*)a.out + DO_NSA);
    bf16* KVS = (bf16*)((unsigned char*)a.out + DO_XB);
    float* rs2 = (float*)(a.ws + WS_RS2); float* rs3 = (float*)(a.ws + WS_RS3);

    p0_prologue(a, lds, G);
    xcd_barrier(bar);
    { pg8::Gemm g{XB, (const bf16*)(a.ws + WS_WIN), DM, DM, 128, 256}; pg8::StaticOrder S; S.init(M, NPAD_IN, G, (int)blockIdx.x);
      pg8::EpiRowScale<0> E{P, PP, nullptr};
      pg8::gemm_phase<pg8::EpiRowScale<0>, pg8::StaticOrder, true, true>(lds, g, S, E); }
    xcd_barrier(bar);
    n_compress(a, P, lds, G);
    attn_phase<1>(a, P, NSA, lds, G);
    ret_kv_phase(P, KVS, lds, G);
    xcd_barrier(bar);
    cmp_phase(a, P, NSA, lds, G);
    ret_scan_phase(KVS, G);
    xcd_barrier(bar);
    attn_phase<0>(a, P, NSA, lds, G);
    ret_out_phase(P, KVS, a.in[3], lds, G);
    xcd_barrier(bar);
    { pg8::Gemm g{P + PC_RG, (const bf16*)(a.ws + WS_WRO), PP, 1024, 128, 256}; pg8::StaticOrder S; S.init(M, DM, G, (int)blockIdx.x);
      pg8::EpiMerge<true> E{P + PC_MERGED, P + PC_GA, PP};
      pg8::gemm_phase<pg8::EpiMerge<true>, pg8::StaticOrder, true, true>(lds, g, S, E); }
    { pg8::Gemm g{NSA, (const bf16*)(a.ws + WS_WNO), 512, 512, 128, 256}; pg8::StaticOrder S; S.init(M, DM, G, (int)blockIdx.x);
      pg8::EpiMerge<false> E{P + PC_MERGED, P + PC_GB, PP};
      pg8::gemm_phase<pg8::EpiMerge<false>, pg8::StaticOrder, true, true>(lds, g, S, E); }
    xcd_barrier(bar);
    { pg8::Gemm g{P + PC_MERGED, (const bf16*)(a.ws + WS_WOUT), PP, DM, 128, 256}; pg8::StaticOrder S; S.init(M, DM, G, (int)blockIdx.x);
      pg8::EpiResid<true> E{a.in[0], a.out, P + PC_X1B, PP, rs2};
      pg8::gemm_phase<pg8::EpiResid<true>, pg8::StaticOrder, true, true>(lds, g, S, E); }
    xcd_barrier(bar);
    { pg8::Gemm g{P + PC_X1B, (const bf16*)(a.ws + WS_WUP), PP, DM, 128, 256}; pg8::StaticOrder S; S.init(M, NUP, G, (int)blockIdx.x);
      pg8::EpiRowScale<1> E{P + PC_UP, PP, rs2};
      pg8::gemm_phase<pg8::EpiRowScale<1>, pg8::StaticOrder, true, true>(lds, g, S, E); }
    xcd_barrier(bar);
    n_conv(a, P, G);
    xcd_barrier(bar);
    { pg8::Gemm g{P + PC_UP + 128, (const bf16*)(a.ws + WS_WDN), PP, DFF, 128, 512}; pg8::StaticOrder S; S.init(M, DM, G, (int)blockIdx.x);
      pg8::EpiResid<false> E{a.out, a.out, nullptr, 0, rs3};
      pg8::gemm_phase<pg8::EpiResid<false>, pg8::StaticOrder, true, true>(lds, g, S, E); }
    xcd_barrier(bar);
    n_final(a, G);
}

extern "C" void kernel_launch(void* const* d_in, const int* in_sizes, int n_in, void* d_out, int out_size, void* d_ws, size_t ws_size, hipStream_t stream) {
    static int grid = 0;
    if (grid == 0) {
        if (n_in != 21 || out_size != M * DM || ws_size < WS_END) { fprintf(stderr, "kernel_launch: unexpected sizes n_in %d out %d ws %zu (need %zu)\n", n_in, out_size, ws_size, (size_t)WS_END); grid = -1; return; }
        int dev = 0, cus = 0;
        if (hipGetDevice(&dev) != hipSuccess || hipDeviceGetAttribute(&cus, hipDeviceAttributeMultiprocessorCount, dev) != hipSuccess) { grid = -1; return; }
        if (hipFuncSetAttribute((const void*)mega_fwd, hipFuncAttributeMaxDynamicSharedMemorySize, LDS_BYTES) != hipSuccess) { fprintf(stderr, "kernel_launch: hipFuncSetAttribute failed\n"); grid = -1; return; }
        grid = cus;
    }
    if (grid < 0) return;
    (void)hipMemsetAsync((char*)d_ws + WS_CTL, 0, CTL_ZERO_BYTES, stream);
    Args a{};
    for (int i = 0; i < 21; ++i) a.in[i] = (const float*)d_in[i];
    a.out = (float*)d_out; a.ws = (unsigned char*)d_ws;
    hipLaunchKernelGGL(mega_fwd, dim3(grid), dim3(512), LDS_BYTES, stream, a);
}
```

```cpp
#include <hip/hip_runtime.h>
#include <cstdio>
#include <cstdint>
namespace pg8 {
#define PG8_LAS __attribute__((address_space(3)))
typedef unsigned short bf16_t;
typedef short bf16x8 __attribute__((ext_vector_type(8)));
typedef float f32x4 __attribute__((ext_vector_type(4)));
typedef unsigned u32x4 __attribute__((ext_vector_type(4)));
constexpr int BM = 256, BK = 64, HALF = 128, HTB = HALF * BK * 2  , STAGE_BYTES = 8 * HTB, NXCD = 8, WGM = 8;

__host__ __device__ __forceinline__ int lds_byte(int r, int c) { const int st = (r >> 4) * 2 + (c >> 5), rr = r & 15, cc = c & 31, ob = rr * 64 + cc * 2; return st * 1024 + (ob ^ (((ob >> 9) & 1) << 5)); }
__host__ __device__ __forceinline__ void stage_rc(int b, int& R, int& C) { const int st = b / 1024, sb = b % 1024, swz = sb ^ (((sb >> 9) & 1) << 5); R = (st >> 1) * 16 + swz / 64; C = (st & 1) * 32 + (swz % 64) / 2; }
__host__ __device__ __forceinline__ int perm32(int rho) { const int n = rho >> 4, i = rho & 15; return 8 * (i >> 2) + 4 * n + (i & 3); }

struct Unit { int pm, pn; };
struct Gemm { const bf16_t* A; const bf16_t* Bt; int lda, K, ks1, ks2; long hsA, tsA; };

struct StaticOrder {
    int nM, nN, nwg, G, c;
    __host__ __device__ void init(int M, int N, int G_, int c_) { nM = M / BM; nN = N / BM; nwg = nM * nN; G = G_; c = c_; }
    __host__ __device__ bool next(int i, Unit& u) const {
        const long L = (long)i * G + c; if (L >= nwg) return false;
        int wgid = (int)L; { const int q = nwg / NXCD, r = nwg % NXCD, xcd = wgid % NXCD, off = wgid / NXCD; wgid = (xcd < r ? xcd * (q + 1) : r * (q + 1) + (xcd - r) * q) + off; }
        const int nig = WGM * nN, gid = wgid / nig, fm = gid * WGM, gsz = (nM - fm) < WGM ? (nM - fm) : WGM;
        u.pm = fm + ((wgid % nig) % gsz); u.pn = (wgid % nig) / gsz; return true;
    }
    __device__ __forceinline__ void a_ready(const Unit&) const {}
    __device__ __forceinline__ void done(const Unit&) const {}
};

__device__ __forceinline__ unsigned cvt_pk_bf16(float lo, float hi) { unsigned r; asm volatile("v_cvt_pk_bf16_f32 %0, %1, %2" : "=v"(r) : "v"(lo), "v"(hi)); return r; }
__device__ __forceinline__ float bf_lo(unsigned u) { return __builtin_bit_cast(float, u << 16); }
__device__ __forceinline__ float bf_hi(unsigned u) { return __builtin_bit_cast(float, u & 0xffff0000u); }
__device__ __forceinline__ float fsig(float x) { return __builtin_amdgcn_rcpf(1.f + __builtin_amdgcn_exp2f(-1.4426950408889634f * x)); }

template <int MODE> struct EpiRowScale {
    static constexpr bool PERM = true, AFTER_DRAIN = false;
    bf16_t* O; int ldc; const float* rs;
    __device__ __forceinline__ void operator()(const f32x4 (&acc)[2][2][4][2], const Unit& u, int wr, int wc, int fr, int fq) const {
        const int row0 = u.pm * BM + wr * 64 + fr, col0 = u.pn * BM + wc * 32 + 8 * fq;
#pragma unroll
        for (int ai = 0; ai < 2; ++ai)
#pragma unroll
            for (int m = 0; m < 4; ++m) { const int row = row0 + ai * HALF + m * 16; float s = 1.f;
                if (MODE == 1) s = __builtin_amdgcn_rsqf(rs[row] * (1.0f / 1024.0f) + 1e-6f);
                bf16_t* rowp = O + (size_t)row * ldc + col0;
#pragma unroll
                for (int bj = 0; bj < 2; ++bj) { const f32x4 v0 = acc[ai][bj][m][0] * s, v1 = acc[ai][bj][m][1] * s;
                    u32x4 w; w.x = cvt_pk_bf16(v0[0], v0[1]); w.y = cvt_pk_bf16(v0[2], v0[3]); w.z = cvt_pk_bf16(v1[0], v1[1]); w.w = cvt_pk_bf16(v1[2], v1[3]);
                    *(u32x4*)(rowp + bj * HALF) = w; } }
    }
};
template <bool FIRST> struct EpiMerge {
    static constexpr bool PERM = true, AFTER_DRAIN = false;
    bf16_t* O; const bf16_t* G; int ldc;
    __device__ __forceinline__ void operator()(const f32x4 (&acc)[2][2][4][2], const Unit& u, int wr, int wc, int fr, int fq) const {
        const int row0 = u.pm * BM + wr * 64 + fr, col0 = u.pn * BM + wc * 32 + 8 * fq;
#pragma unroll
        for (int ai = 0; ai < 2; ++ai)
#pragma unroll
            for (int m = 0; m < 4; ++m) { const size_t off = (size_t)(row0 + ai * HALF + m * 16) * ldc + col0;
#pragma unroll
                for (int bj = 0; bj < 2; ++bj) { const u32x4 gv = *(const u32x4*)(G + off + bj * HALF);
                    const f32x4 v0 = acc[ai][bj][m][0], v1 = acc[ai][bj][m][1];
                    float r[8];
                    r[0] = fsig(bf_lo(gv.x)) * v0[0]; r[1] = fsig(bf_hi(gv.x)) * v0[1]; r[2] = fsig(bf_lo(gv.y)) * v0[2]; r[3] = fsig(bf_hi(gv.y)) * v0[3];
                    r[4] = fsig(bf_lo(gv.z)) * v1[0]; r[5] = fsig(bf_hi(gv.z)) * v1[1]; r[6] = fsig(bf_lo(gv.w)) * v1[2]; r[7] = fsig(bf_hi(gv.w)) * v1[3];
                    if (!FIRST) { const u32x4 pv = *(const u32x4*)(O + off + bj * HALF);
                        r[0] += bf_lo(pv.x); r[1] += bf_hi(pv.x); r[2] += bf_lo(pv.y); r[3] += bf_hi(pv.y); r[4] += bf_lo(pv.z); r[5] += bf_hi(pv.z); r[6] += bf_lo(pv.w); r[7] += bf_hi(pv.w); }
                    u32x4 w; w.x = cvt_pk_bf16(r[0], r[1]); w.y = cvt_pk_bf16(r[2], r[3]); w.z = cvt_pk_bf16(r[4], r[5]); w.w = cvt_pk_bf16(r[6], r[7]);
                    *(u32x4*)(O + off + bj * HALF) = w; } }
    }
};
template <bool WB16> struct EpiResid {
    static constexpr bool PERM = false, AFTER_DRAIN = false;
    const float* X; float* X1; bf16_t* Xb; int ldb; float* sumsq;
    __device__ __forceinline__ void operator()(const f32x4 (&acc)[2][2][4][2], const Unit& u, int wr, int wc, int fr, int fq) const {
        const int row0 = u.pm * BM + wr * 64 + fr, col0 = u.pn * BM + wc * 32 + 4 * fq;
#pragma unroll
        for (int ai = 0; ai < 2; ++ai)
#pragma unroll
            for (int m = 0; m < 4; ++m) { const int row = row0 + ai * HALF + m * 16; float ss = 0.f;
#pragma unroll
                for (int bj = 0; bj < 2; ++bj)
#pragma unroll
                    for (int n = 0; n < 2; ++n) { const int c = col0 + bj * HALF + n * 16;
                        const f32x4 x = *(const f32x4*)(X + (size_t)row * 1024 + c) + acc[ai][bj][m][n];
                        *(f32x4*)(X1 + (size_t)row * 1024 + c) = x;
                        ss += (x[0] * x[0] + x[1] * x[1]) + (x[2] * x[2] + x[3] * x[3]);
                        if (WB16) { unsigned long long w = (unsigned long long)cvt_pk_bf16(x[0], x[1]) | ((unsigned long long)cvt_pk_bf16(x[2], x[3]) << 32);
                            *(unsigned long long*)(Xb + (size_t)row * ldb + c) = w; } }
                ss += __shfl_xor(ss, 16); ss += __shfl_xor(ss, 32);
                if (fq == 0) atomicAdd(sumsq + row, ss); }
    }
};

__device__ __forceinline__ float gelu_fast(float x) { return x * fsig(1.5957691216057308f * (x + 0.044715f * x * x * x)); }
typedef float f32x16 __attribute__((ext_vector_type(16)));
struct EpiCompress {
    static constexpr bool PERM = false, AFTER_DRAIN = true;
    const float* bias; const bf16_t* w2t; bf16_t* out;
    __device__ __forceinline__ void fused(f32x4 (&acc)[2][2][4][2], const Unit& u, int wr, int wc, int fr, int fq, PG8_LAS unsigned char* lds, int wid, int lane) const {
        const int col0 = wc * 32 + 4 * fq;
#pragma unroll
        for (int bj = 0; bj < 2; ++bj)
#pragma unroll
            for (int n = 0; n < 2; ++n) { const int c = col0 + bj * HALF + n * 16; const f32x4 bv = *(const f32x4*)(bias + c);
#pragma unroll
                for (int ai = 0; ai < 2; ++ai)
#pragma unroll
                    for (int m = 0; m < 4; ++m) { const int r = ai * HALF + wr * 64 + m * 16 + fr; const f32x4 v = acc[ai][bj][m][n] + bv;
                        const unsigned long long w = (unsigned long long)cvt_pk_bf16(gelu_fast(v[0]), gelu_fast(v[1])) | ((unsigned long long)cvt_pk_bf16(gelu_fast(v[2]), gelu_fast(v[3])) << 32);
                        *(PG8_LAS unsigned long long*)(lds + r * 528 + c * 2) = w; asm volatile("" ::: "memory"); } }
        asm volatile("s_waitcnt lgkmcnt(0)" ::: "memory"); __builtin_amdgcn_s_barrier(); asm volatile("" ::: "memory");
        const int q = lane & 31, h = lane >> 5;
        f32x16 o0, o1;
#pragma unroll
        for (int i = 0; i < 16; ++i) { o0[i] = 0.f; o1[i] = 0.f; }
#pragma unroll 4
        for (int ks = 0; ks < 16; ++ks) {
            const bf16x8 a = *(const PG8_LAS bf16x8*)(lds + (32 * wid + q) * 528 + ks * 32 + h * 16);
            const bf16x8 b0 = *(const bf16x8*)(w2t + q * 256 + 16 * ks + 8 * h), b1 = *(const bf16x8*)(w2t + (q + 32) * 256 + 16 * ks + 8 * h);
            o0 = __builtin_amdgcn_mfma_f32_32x32x16_bf16(a, b0, o0, 0, 0, 0); o1 = __builtin_amdgcn_mfma_f32_32x32x16_bf16(a, b1, o1, 0, 0, 0);
        }
#pragma unroll
        for (int i = 0; i < 16; ++i) { const int r = 32 * wid + (i & 3) + 8 * (i >> 2) + 4 * h, gg = r >> 7, c = r & 127;
            if (c < 127) { bf16_t* op = out + ((size_t)(u.pm * 2 + gg) * 128 + c) * 64 + q;
                op[0] = (bf16_t)(cvt_pk_bf16(o0[i], 0.f) & 0xffffu); op[32] = (bf16_t)(cvt_pk_bf16(o1[i], 0.f) & 0xffffu); } }
    }
};
struct FewUnits {
    int n, c;
    __device__ __forceinline__ bool next(int i, Unit& u) const { if (i != 0 || c >= n || c < 0) return false; u.pm = c; u.pn = 0; return true; }
    __device__ __forceinline__ void a_ready(const Unit&) const {}
    __device__ __forceinline__ void done(const Unit&) const {}
};

template <class Epi, class Sched, bool ALIGN_EPI = false, bool SP2 = false>
__device__ __forceinline__ void gemm_phase(PG8_LAS unsigned char* lds, const Gemm g, const Sched& S, const Epi& E) {
    const int tid = threadIdx.x, wid = __builtin_amdgcn_readfirstlane(tid >> 6), lane = tid & 63, wr = wid >> 2, wc = wid & 3, fr = lane & 15, fq = lane >> 4;
    const int K = g.K, nt = K / BK;
    unsigned voffA[2], voffB[2];
#pragma unroll
    for (int i = 0; i < 2; ++i) { int R, C; stage_rc(tid * 16 + i * 8192, R, C); const int Rb = Epi::PERM ? ((R & ~31) + perm32(R & 31)) : R;
        voffA[i] = (unsigned)(R * g.lda + C) * 2u; voffB[i] = (unsigned)(Rb * K + C) * 2u; }
    const size_t kstep = (size_t)(BK * 2);
    const size_t hstepB = (size_t)HALF * K * 2, hstepA = (size_t)g.hsA, ks1 = (size_t)g.ks1, ks2 = (size_t)g.ks2;
    const size_t tstepA = (size_t)g.tsA, tstepB = 2 * hstepB;
    const unsigned ldsw = (unsigned)wid * 1024u;
    const int aoff = lds_byte(wr * 64 + fr, fq * 8), boff = lds_byte(wc * 32 + fr, fq * 8);
#define PG8_SA(b, h) (((b) * 2 + (h)) * HTB)
#define PG8_SB(b, h) ((4 + (b) * 2 + (h)) * HTB)
#define PG8_STAGE(bufoff, gbase, voff) do { _Pragma("unroll") for (int _i = 0; _i < 2; ++_i) \
        __builtin_amdgcn_global_load_lds((const unsigned*)((const char*)(gbase) + (voff)[_i]), (PG8_LAS unsigned*)(lds + (bufoff) + ldsw + _i * 8192), 16, 0, 0); } while (0)
#define PG8_LDA(dst, b, h) do { _Pragma("unroll") for (int m = 0; m < 4; ++m) _Pragma("unroll") for (int k = 0; k < 2; ++k) dst[m][k] = *(const PG8_LAS bf16x8*)(lds + PG8_SA(b, h) + aoff + m * 2048 + k * 1024); } while (0)
#define PG8_LDB(dst, b, h) do { _Pragma("unroll") for (int n = 0; n < 2; ++n) _Pragma("unroll") for (int k = 0; k < 2; ++k) dst[n][k] = *(const PG8_LAS bf16x8*)(lds + PG8_SB(b, h) + boff + n * 2048 + k * 1024); } while (0)
#define PG8_MMA(ai, bj, At, Bt) do { __builtin_amdgcn_s_setprio(1); _Pragma("unroll") for (int m = 0; m < 4; ++m) _Pragma("unroll") for (int n = 0; n < 2; ++n) _Pragma("unroll") for (int k = 0; k < 2; ++k) \
        acc[ai][bj][m][n] = __builtin_amdgcn_mfma_f32_16x16x32_bf16(Bt[n][k], At[m][k], acc[ai][bj][m][n], 0, 0, 0); __builtin_amdgcn_s_setprio(0); } while (0)
#define PG8_WAIT_V(n) asm volatile("s_waitcnt vmcnt(" #n ")" ::: "memory")
#define PG8_WAIT_L(n) asm volatile("s_waitcnt lgkmcnt(" #n ")" ::: "memory")
#define PG8_BAR __builtin_amdgcn_s_barrier()
#define PG8_SCHED __builtin_amdgcn_sched_barrier(0)
    Unit cur, nxt; int ui = 0;
    if (!S.next(0, cur)) return;
    f32x4 acc[2][2][4][2];
#pragma unroll
    for (int a = 0; a < 2; ++a)
#pragma unroll
        for (int b = 0; b < 2; ++b)
#pragma unroll
            for (int m = 0; m < 4; ++m)
#pragma unroll
                for (int n = 0; n < 2; ++n) acc[a][b][m][n] = (f32x4){0.f, 0.f, 0.f, 0.f};
    bf16x8 At[4][2], B0[2][2], B1[2][2];
    const char* cA = (const char*)g.A + (size_t)cur.pm * tstepA; const char* cB = (const char*)g.Bt + (size_t)cur.pn * tstepB;
    S.a_ready(cur);
    if constexpr (SP2) {
        PG8_STAGE(PG8_SB(0, 0), cB, voffB); PG8_STAGE(PG8_SB(0, 1), cB + hstepB, voffB); PG8_STAGE(PG8_SA(0, 0), cA, voffA); PG8_STAGE(PG8_SA(0, 1), cA + hstepA, voffA);
        if (wr == 1) PG8_BAR;
        PG8_WAIT_V(2); PG8_BAR;
        PG8_STAGE(PG8_SB(1, 0), cB + kstep, voffB); PG8_STAGE(PG8_SA(1, 0), cA + ks1, voffA); PG8_STAGE(PG8_SB(1, 1), cB + hstepB + kstep, voffB);
        PG8_WAIT_V(6); PG8_BAR;
    } else {
        PG8_STAGE(PG8_SB(0, 0), cB, voffB); PG8_STAGE(PG8_SA(0, 0), cA, voffA); PG8_STAGE(PG8_SB(0, 1), cB + hstepB, voffB); PG8_STAGE(PG8_SA(0, 1), cA + hstepA, voffA);
        if (wr == 1) PG8_BAR;
        PG8_WAIT_V(4); PG8_BAR;
        PG8_STAGE(PG8_SB(1, 0), cB + kstep, voffB); PG8_STAGE(PG8_SA(1, 0), cA + ks1, voffA); PG8_STAGE(PG8_SB(1, 1), cB + hstepB + kstep, voffB);
        PG8_WAIT_V(6); PG8_BAR;
    }
    for (;;) {
        const bool has_next = S.next(ui + 1, nxt);
        const char* nA = has_next ? (const char*)g.A + (size_t)nxt.pm * tstepA : cA; const char* nB = has_next ? (const char*)g.Bt + (size_t)nxt.pn * tstepB : cB;
        for (int t = 0; t < nt; t += 2) {
            const bool last = (t == nt - 2);
            const char* a1 = cA + (size_t)(t >> 1) * ks2 + ks1;
            const char* a2 = last ? nA : cA + (size_t)((t + 2) >> 1) * ks2; const char* b2 = last ? nB : cB + (size_t)(t + 2) * kstep;
            const char* a3 = a2 + ks1; const char* b3 = b2 + kstep;
            if (last && has_next) S.a_ready(nxt);
            if constexpr (SP2) {
            PG8_LDB(B0, 0, 0); PG8_LDB(B1, 0, 1); PG8_SCHED; PG8_LDA(At, 0, 0); PG8_STAGE(PG8_SA(1, 1), a1 + hstepA, voffA);
            PG8_WAIT_V(8); PG8_WAIT_L(0); PG8_BAR; PG8_MMA(0, 0, At, B0); PG8_MMA(0, 1, At, B1); PG8_BAR; PG8_SCHED;
            PG8_LDA(At, 0, 1); PG8_STAGE(PG8_SB(0, 0), b2, voffB); PG8_STAGE(PG8_SB(0, 1), b2 + hstepB, voffB); PG8_STAGE(PG8_SA(0, 0), a2, voffA);
            PG8_WAIT_V(8); PG8_WAIT_L(0); PG8_BAR; PG8_MMA(1, 0, At, B0); PG8_MMA(1, 1, At, B1); PG8_BAR; PG8_SCHED;
            PG8_LDB(B0, 1, 0); PG8_LDB(B1, 1, 1); PG8_SCHED; PG8_LDA(At, 1, 0); PG8_STAGE(PG8_SA(0, 1), a2 + hstepA, voffA);
            PG8_WAIT_V(8); PG8_WAIT_L(0); PG8_BAR; PG8_MMA(0, 0, At, B0); PG8_MMA(0, 1, At, B1); PG8_BAR; PG8_SCHED;
            PG8_LDA(At, 1, 1); PG8_STAGE(PG8_SB(1, 0), b3, voffB); PG8_STAGE(PG8_SB(1, 1), b3 + hstepB, voffB); PG8_STAGE(PG8_SA(1, 0), a3, voffA);
            PG8_WAIT_V(8); PG8_WAIT_L(0); PG8_BAR; PG8_MMA(1, 0, At, B0); PG8_MMA(1, 1, At, B1); PG8_BAR; PG8_SCHED;
            } else {
            PG8_LDB(B0, 0, 0); PG8_SCHED; PG8_LDA(At, 0, 0); PG8_STAGE(PG8_SA(1, 1), a1 + hstepA, voffA);
            PG8_WAIT_L(8); PG8_BAR; PG8_WAIT_L(0); PG8_MMA(0, 0, At, B0); PG8_BAR; PG8_SCHED;
            PG8_LDB(B1, 0, 1); PG8_STAGE(PG8_SB(0, 0), b2, voffB);
            PG8_BAR; PG8_WAIT_L(0); PG8_MMA(0, 1, At, B1); PG8_BAR;
            PG8_LDA(At, 0, 1); PG8_STAGE(PG8_SA(0, 0), a2, voffA);
            PG8_BAR; PG8_WAIT_L(0); PG8_MMA(1, 0, At, B0); PG8_BAR; PG8_SCHED;
            PG8_STAGE(PG8_SB(0, 1), b2 + hstepB, voffB);
            PG8_WAIT_V(6); PG8_BAR; PG8_MMA(1, 1, At, B1); PG8_BAR;
            PG8_LDB(B0, 1, 0); PG8_SCHED; PG8_LDA(At, 1, 0); PG8_STAGE(PG8_SA(0, 1), a2 + hstepA, voffA);
            PG8_WAIT_L(8); PG8_BAR; PG8_WAIT_L(0); PG8_MMA(0, 0, At, B0); PG8_BAR; PG8_SCHED;
            PG8_LDB(B1, 1, 1); PG8_STAGE(PG8_SB(1, 0), b3, voffB);
            PG8_BAR; PG8_WAIT_L(0); PG8_MMA(0, 1, At, B1); PG8_BAR;
            PG8_LDA(At, 1, 1); PG8_STAGE(PG8_SA(1, 0), a3, voffA);
            PG8_BAR; PG8_WAIT_L(0); PG8_MMA(1, 0, At, B0); PG8_BAR; PG8_SCHED;
            PG8_STAGE(PG8_SB(1, 1), b3 + hstepB, voffB);
            PG8_WAIT_V(6); PG8_BAR; PG8_MMA(1, 1, At, B1); PG8_BAR;
            }
        }
        if constexpr (ALIGN_EPI) { if (wr == 0) PG8_BAR; }
        if constexpr (!Epi::AFTER_DRAIN) { E(acc, cur, wr, wc, fr, fq); S.done(cur); }
        if (!has_next) break;
#pragma unroll
        for (int a = 0; a < 2; ++a)
#pragma unroll
            for (int b = 0; b < 2; ++b)
#pragma unroll
                for (int m = 0; m < 4; ++m)
#pragma unroll
                    for (int n = 0; n < 2; ++n) acc[a][b][m][n] = (f32x4){0.f, 0.f, 0.f, 0.f};
        cur = nxt; cA = nA; cB = nB; ++ui;
        if constexpr (ALIGN_EPI) { if (wr == 1) PG8_BAR; }
    }
    PG8_WAIT_V(0);
    if constexpr (!ALIGN_EPI) { if (wr == 0) PG8_BAR; }
    PG8_BAR;
    if constexpr (Epi::AFTER_DRAIN) { E.fused(acc, cur, wr, wc, fr, fq, lds, wid, lane); S.done(cur); }
#undef PG8_SA
#undef PG8_SB
#undef PG8_STAGE
#undef PG8_LDA
#undef PG8_LDB
#undef PG8_MMA
#undef PG8_WAIT_V
#undef PG8_WAIT_L
#undef PG8_BAR
#undef PG8_SCHED
}
}
constexpr int M = 32768, DM = 1024, SEQ = 2048, NBATCH = 16;
constexpr int RH = 4, RDK = 128, RDV = 256;
constexpr int NG = 2, NR = 4, NDK = 64, CBLK = 32, CSTR = 16, CHID = 256, TOPK = 8, WIN = 512;
constexpr int DFF = 2816, NIN = 6424;
constexpr int NC = SEQ / CSTR - 1;
constexpr int NS = SEQ / 64;
constexpr float EPS = 1e-6f;
constexpr int C_GATE = 4352, C_GA = 4376, C_GB = 5400;
constexpr int PP = 6656;
constexpr int PC_RQ = 0, PC_RK = 512, PC_RV = 1024, PC_RG = 2048, PC_NQ = 3072, PC_KCR = 3584, PC_VCR = 3712, PC_KS = 3840, PC_VS = 3968,
              PC_KW = 4096, PC_VW = 4224, PC_GA = 4352, PC_GB = 5376, PC_GATE = 6400;
constexpr int PC_MERGED = 1024, PC_X1B = 0, PC_UP = 1024;
constexpr int NPAD_IN = 6656, NUP = 2 * DFF;
constexpr size_t MiB = 1u << 20;
constexpr size_t WS_CTL = 0, CTL_ZERO_BYTES = 1 * MiB;
constexpr size_t WS_RS2 = 256 * 1024, WS_RS3 = 512 * 1024;
constexpr size_t WS_WIN = 1 * MiB, WS_WUP = 14 * MiB, WS_WDN = 25 * MiB, WS_WRO = 31 * MiB, WS_WNO = 33 * MiB, WS_WOUT = 34 * MiB;
constexpr size_t WS_KCMP = 39 * MiB, WS_VCMP = 41 * MiB, WS_SEL = 43 * MiB;
constexpr size_t WS_WC1K = 36 * MiB, WS_WC1V = 37 * MiB, WS_W2T = 38 * MiB, WS_CBIAS = 38 * MiB + 128 * 1024;
constexpr size_t WS_PROJ = 48 * MiB;
constexpr size_t WS_END = WS_PROJ + (size_t)(M + 32) * PP * 2;
static_assert(WS_END <= 512 * MiB, "d_ws map");
constexpr int CW_BAR = 4096;
constexpr size_t DO_XB = 0, DO_NSA = 64 * MiB;

constexpr int LDS_BYTES = 163840;
constexpr int MISC_OFF = 163840 - 512;

typedef unsigned short bf16;
typedef unsigned v4u __attribute__((ext_vector_type(4)));
typedef float f32x4 __attribute__((ext_vector_type(4)));
#define GAS __attribute__((address_space(1)))
#define LDS_WAIT() asm volatile("s_waitcnt lgkmcnt(0)" ::: "memory")
__device__ __forceinline__ unsigned f2bf(float f) { unsigned u = __builtin_bit_cast(unsigned, f); return (u + 0x7fffu + ((u >> 16) & 1u)) >> 16; }
__device__ __forceinline__ unsigned pk2(float lo, float hi) { return f2bf(lo) | (f2bf(hi) << 16); }
__device__ __forceinline__ float bf2f(bf16 v) { return __builtin_bit_cast(float, (unsigned)v << 16); }
__device__ __forceinline__ float wave_sum(float v) {
#pragma unroll
    for (int o = 1; o < 64; o <<= 1) v += __shfl_xor(v, o);
    return v;
}
__device__ __forceinline__ float wave_max(float v) {
#pragma unroll
    for (int o = 1; o < 64; o <<= 1) v = fmaxf(v, __shfl_xor(v, o));
    return v;
}
__device__ __forceinline__ float gelu_tanh(float x) { const float c = 0.7978845608028654f; return 0.5f * x * (1.f + tanhf(c * (x + 0.044715f * x * x * x))); }
__device__ __forceinline__ float sigmoidf_(float x) { return 1.f / (1.f + expf(-x)); }

__device__ __forceinline__ int tid_opaque() { int t = threadIdx.x; asm volatile("" : "+v"(t)); return t; }
#define XB_TMO      128
#define XB_XCNT(j)  (256  + 64 * (j))
#define XB_XSUB(j)  (1280 + 64 * (j))
#define XB_XGEN(j)  (2304 + 64 * (j))
#define XB_TOP      3328
#define XB_TOPGEN   3392
#define XCD_BAR_WORDS 3456
#define XB_SPIN_CAP (1u << 21)
#define LAS __attribute__((address_space(3)))

__device__ __forceinline__ unsigned xb_ld(unsigned* p)              { return __hip_atomic_load(p, __ATOMIC_RELAXED, __HIP_MEMORY_SCOPE_AGENT); }
__device__ __forceinline__ unsigned xb_add(unsigned* p, unsigned v) { return __hip_atomic_fetch_add(p, v, __ATOMIC_RELAXED, __HIP_MEMORY_SCOPE_AGENT); }
__device__ __forceinline__ unsigned xb_xcc_id() { return (unsigned)__builtin_amdgcn_s_getreg((3 << 11) | 20) & 0xFu; }
#define XB_SPIN(cond, bar) do { unsigned _sp = 0; while (cond) { __builtin_amdgcn_s_sleep(1); \
    if ((++_sp & 255u) == 0u) { if (xb_ld(&(bar)[XB_TMO])) break; if (_sp > XB_SPIN_CAP) { atomicAdd(&(bar)[XB_TMO], 1u); break; } } } } while (0)

struct XcdBarrier {
    unsigned* bar; unsigned x;
    volatile LAS unsigned* st;
};

__device__ __forceinline__ XcdBarrier xcd_barrier_post(unsigned* bar, volatile LAS unsigned* st) {
    XcdBarrier b; b.bar = bar; b.x = xb_xcc_id(); b.st = st;
    if (threadIdx.x == 0) (void)xb_add(&bar[XB_XCNT(b.x)], 1u);
    return b;
}
__device__ __forceinline__ void xcd_barrier_complete(unsigned* bar, unsigned x, unsigned& nloc, unsigned& nx) {
    const unsigned G = gridDim.x * gridDim.y * gridDim.z;
    unsigned sum, cnt, mine, sp = 0u;
    for (;;) {
        sum = 0u; cnt = 0u; mine = 0u;
#pragma unroll
        for (unsigned j = 0; j < 16; ++j) { const unsigned c = xb_ld(&bar[XB_XCNT(j)]); sum += c; cnt += (c > 0u) ? 1u : 0u; mine = (j == x) ? c : mine; }
        if (sum == G) break;
        __builtin_amdgcn_s_sleep(1);
        if ((++sp & 255u) == 0u) { if (xb_ld(&bar[XB_TMO])) break; if (sp > XB_SPIN_CAP) { atomicAdd(&bar[XB_TMO], 1u); break; } }
    }
    nloc = mine > 0u ? mine : 1u; nx = cnt > 0u ? cnt : 1u;
}

__device__ __forceinline__ void xcd_barrier(const XcdBarrier& b) {
    asm volatile("s_waitcnt vmcnt(0)" ::: "memory");
    __syncthreads();
    if (threadIdx.x == 0) {
        unsigned* bar = b.bar;
        __builtin_amdgcn_s_waitcnt(0);
        unsigned nloc = b.st[0], nx = b.st[1];
        if (nloc == 0u) { xcd_barrier_complete(bar, b.x, nloc, nx); b.st[0] = nloc; b.st[1] = nx; }
        const unsigned old = xb_add(&bar[XB_XSUB(b.x)], 1u);
        const unsigned gen = old / nloc;
        if (old + 1u == (gen + 1u) * nloc) {
            __builtin_amdgcn_fence(__ATOMIC_RELEASE, "agent");
            asm volatile("s_waitcnt vmcnt(0)" ::: "memory");
            const unsigned og = xb_add(&bar[XB_TOP], 1u);
            const unsigned tg = og / nx;
            if (og + 1u == (tg + 1u) * nx) xb_add(&bar[XB_TOPGEN], 1u);
            else XB_SPIN(xb_ld(&bar[XB_TOPGEN]) == tg, bar);
            __builtin_amdgcn_fence(__ATOMIC_ACQUIRE, "agent");
            xb_add(&bar[XB_XGEN(b.x)], 1u);
            asm volatile("s_waitcnt vmcnt(0)" ::: "memory");
        } else {
            XB_SPIN(xb_ld(&bar[XB_XGEN(b.x)]) == gen, bar);
            __builtin_amdgcn_fence(__ATOMIC_ACQUIRE, "agent");
            asm volatile("s_waitcnt vmcnt(0)" ::: "memory");
        }
    }
    __syncthreads();
}

struct Args { const float* in[21]; float* out; unsigned char* ws; };

struct MapIn { __device__ __forceinline__ int operator()(int n) const { return n < 4352 ? n : (n < 6400 ? n + 24 : (n < 6424 ? n - 2048 : -1)); } };
struct MapUp { __device__ __forceinline__ int operator()(int n) const { const int pn = n >> 8, j = n & 255; return j < 128 ? 128 * pn + j : DFF + 128 * pn + (j - 128); } };
struct MapId { __device__ __forceinline__ int operator()(int n) const { return n; } };
template <class MAP>
__device__ __forceinline__ void p0_transpose_item(const float* W, int K, int Nsrc, int nblk, bf16* WT, const float* ksc, LAS float* scr, int item, int lane, MAP map) {
    const int kb = item / nblk, nb = item % nblk, k0 = 64 * kb, n0 = 32 * nb;
    const int sc = map(n0 + (lane & 31));
#pragma unroll 8
    for (int i = 0; i < 32; ++i) { const int kk = 2 * i + (lane >> 5); float v = 0.f; if (sc >= 0) { v = W[(size_t)(k0 + kk) * Nsrc + sc]; if (ksc) v *= ksc[k0 + kk]; } scr[kk * 33 + (lane & 31)] = v; }
    LDS_WAIT(); asm volatile("" ::: "memory");
    const int c = lane & 7;
#pragma unroll
    for (int j = 0; j < 4; ++j) { const int n = (lane >> 3) + 8 * j; const LAS float* s = scr + (8 * c) * 33 + n;
        v4u o; o.x = pk2(s[0 * 33], s[1 * 33]); o.y = pk2(s[2 * 33], s[3 * 33]); o.z = pk2(s[4 * 33], s[5 * 33]); o.w = pk2(s[6 * 33], s[7 * 33]);
        *(GAS v4u*)(WT + (size_t)(n0 + n) * K + k0 + 8 * c) = o; }
    LDS_WAIT(); asm volatile("" ::: "memory");
}
__device__ __forceinline__ void p0_prologue(const Args& a, LAS unsigned char* lds, int G) {
    const int tid = tid_opaque(), lane = tid & 63, wave = tid >> 6;
    LAS float* scr = (LAS float*)(lds + wave * 16384);
    const int gw = blockIdx.x * 8 + wave, NGW = G * 8;
    unsigned char* ws = a.ws;
    constexpr int I_IN = 16 * (NPAD_IN / 32), I_UP = 16 * (NUP / 32), I_DN = (DFF / 64) * 32, I_RO = 16 * 32, I_NO = 8 * 32, I_OUT = 16 * 32;
    constexpr int NITEMS = I_IN + I_UP + I_DN + I_RO + I_NO + I_OUT;
    for (int it = gw; it < NITEMS; it += NGW) {
        int r = it;
        if (r < I_IN) { p0_transpose_item(a.in[2], DM, NIN, NPAD_IN / 32, (bf16*)(ws + WS_WIN), a.in[1], scr, r, lane, MapIn()); continue; } r -= I_IN;
        if (r < I_UP) { p0_transpose_item(a.in[16], DM, NUP, NUP / 32, (bf16*)(ws + WS_WUP), a.in[15], scr, r, lane, MapUp()); continue; } r -= I_UP;
        if (r < I_DN) { p0_transpose_item(a.in[19], DFF, DM, 32, (bf16*)(ws + WS_WDN), nullptr, scr, r, lane, MapId()); continue; } r -= I_DN;
        if (r < I_RO) { p0_transpose_item(a.in[12], 1024, DM, 32, (bf16*)(ws + WS_WRO), nullptr, scr, r, lane, MapId()); continue; } r -= I_RO;
        if (r < I_NO) { p0_transpose_item(a.in[13], 512, DM, 32, (bf16*)(ws + WS_WNO), nullptr, scr, r, lane, MapId()); continue; } r -= I_NO;
        p0_transpose_item(a.in[14], DM, DM, 32, (bf16*)(ws + WS_WOUT), nullptr, scr, r, lane, MapId());
    }
    for (int it = gw; it < 2 * 256; it += NGW) { const int kv = it >> 8, r = it & 255;
        p0_transpose_item(a.in[kv ? 9 : 5], 2048, CHID, CHID / 32, (bf16*)(ws + (kv ? WS_WC1V : WS_WC1K)), nullptr, scr, r, lane, MapId()); }
    for (int it = gw; it < 2 * 8; it += NGW) { const int kv = it >> 3, r = it & 7;
        p0_transpose_item(a.in[kv ? 11 : 7], CHID, NDK, 2, (bf16*)(ws + WS_W2T) + kv * (NDK * CHID), nullptr, scr, r, lane, MapId()); }
    for (int it = gw; it < 2 * 4; it += NGW) { const int kv = it >> 2, j = (it & 3) * 64 + lane;
        const float* pos = a.in[kv ? 8 : 4]; const float* w1 = a.in[kv ? 9 : 5]; const float* b1 = a.in[kv ? 10 : 6];
        float acc = b1[j];
        for (int k = 0; k < CBLK * NDK; ++k) acc += pos[k] * w1[(size_t)k * CHID + j];
        ((float*)(ws + WS_CBIAS))[kv * CHID + j] = acc; }
    bf16* XB = (bf16*)((unsigned char*)a.out + DO_XB);
    for (int m = gw; m < M; m += NGW) {
        const GAS f32x4* xr = (const GAS f32x4*)(a.in[0] + (size_t)m * DM) + lane;
        f32x4 v[4]; float s = 0.f;
#pragma unroll
        for (int j = 0; j < 4; ++j) { v[j] = xr[64 * j]; s += (v[j].x * v[j].x + v[j].y * v[j].y) + (v[j].z * v[j].z + v[j].w * v[j].w); }
        const float rstd = rsqrtf(wave_sum(s) * (1.f / DM) + EPS);
        GAS unsigned long long* o8 = (GAS unsigned long long*)(XB + (size_t)m * DM) + lane;
#pragma unroll
        for (int j = 0; j < 4; ++j) o8[64 * j] = (unsigned long long)pk2(v[j].x * rstd, v[j].y * rstd) | ((unsigned long long)pk2(v[j].z * rstd, v[j].w * rstd) << 32);
    }
}

__device__ __forceinline__ float ldp(const bf16* P, size_t row, int col) { return bf2f(P[row * PP + col]); }

__device__ __forceinline__ void n_compress(const Args& a, const bf16* P, LAS unsigned char* lds, int G) {
    const int tid = tid_opaque(), sub = tid >> 8, lt = tid & 255;
    LAS float* bv = (LAS float*)(lds + sub * 16384); LAS float* hid = bv + CBLK * NDK;
    for (int it = blockIdx.x; it < NBATCH * NC * 2; it += G) {
        const int u = it * 2 + sub, kv = u & 1, g = (u >> 1) & 1, c = (u >> 2) % NC, b = (u >> 2) / NC;
        const float* pos = a.in[kv ? 8 : 4]; const float* w1 = a.in[kv ? 9 : 5]; const float* b1 = a.in[kv ? 10 : 6]; const float* w2 = a.in[kv ? 11 : 7];
        bf16* out = (bf16*)(a.ws + (kv ? WS_VCMP : WS_KCMP));
        const int colbase = (kv ? PC_VCR : PC_KCR) + g * NDK;
        __syncthreads();
        for (int i = lt; i < CBLK * NDK; i += 256) { const int ii = i >> 6, d = i & 63; bv[i] = ldp(P, (size_t)b * SEQ + c * CSTR + ii, colbase + d) + pos[i]; }
        __syncthreads();
        float acc = b1[lt];
        for (int k = 0; k < CBLK * NDK; ++k) acc += bv[k] * w1[(size_t)k * CHID + lt];
        hid[lt] = gelu_tanh(acc);
        __syncthreads();
        if (lt < NDK) { float o = 0.f; for (int j = 0; j < CHID; ++j) o += hid[j] * w2[j * NDK + lt]; out[(((size_t)b * NG + g) * 128 + c) * NDK + lt] = (bf16)f2bf(o); }
    }
}

template <int MODE>
__device__ __forceinline__ void n_attn(const Args& a, const bf16* P, bf16* NSA, LAS unsigned char* lds, int G) {
    const int tid = tid_opaque(), sub = tid >> 8, r = (tid >> 6) & 3, lane = tid & 63;
    LAS float* qs = (LAS float*)(lds + sub * 16384) + r * 64;
    LAS float* scs = (LAS float*)(lds + sub * 16384 + 1024) + r * 576;
    LAS int* blks = (LAS int*)(lds + sub * 16384 + 1024 + 9216) + r * 12;
    const unsigned* selmask = (const unsigned*)(a.ws + WS_SEL);
    const int kcol = MODE ? PC_KW : PC_KS, vcol = MODE ? PC_VW : PC_VS;
    for (int it = blockIdx.x; it < M; it += G) {
        const int u = it * 2 + sub, g = u & 1, t = u >> 1, tl = t & (SEQ - 1), h = g * NR + r, cur = tl >> 6;
        const size_t rb = (size_t)(t - tl);
        const float slope = exp2f(-(float)(h + 1));
        __syncthreads();
        qs[lane] = ldp(P, t, PC_NQ + h * NDK + lane);
        unsigned mask;
        if (MODE) { const int lo = (tl - (WIN - 1)) > 0 ? ((tl - (WIN - 1)) >> 6) : 0; mask = 0u; for (int j = lo; j <= cur; ++j) mask |= 1u << j; }
        else mask = selmask[t * NG + g];
        int nb = 0;
        for (int j = 0; j < NS; ++j) if ((mask >> j) & 1u) { if (lane == 0) blks[nb] = j; ++nb; }
        __syncthreads();
        float m = -1e30f;
        for (int b = 0; b < nb; ++b) {
            const int s = blks[b] * 64 + lane; const int d = tl - s;
            const bool valid = d >= 0 && (!MODE || d < WIN);
            float sc = -1e30f;
            if (valid) { float dot = 0.f; const bf16* kr = P + (rb + s) * PP + kcol + g * NDK; for (int x = 0; x < NDK; ++x) dot += qs[x] * bf2f(kr[x]); sc = dot * 0.125f - slope * (float)d; }
            scs[b * 64 + lane] = sc; m = fmaxf(m, sc);
        }
        m = wave_max(m);
        float sum = 0.f;
        for (int b = 0; b < nb; ++b) { const float sc = scs[b * 64 + lane]; const float p = sc > -1e29f ? expf(sc - m) : 0.f; scs[b * 64 + lane] = p; sum += p; }
        sum = wave_sum(sum);
        __syncthreads();
        float o = 0.f;
        for (int b = 0; b < nb; ++b) {
            const int s0 = blks[b] * 64;
            for (int i = 0; i < 64; ++i) { const float p = scs[b * 64 + i]; if (p != 0.f) o += p * ldp(P, rb + s0 + i, vcol + g * NDK + lane); }
        }
        const float gate = sigmoidf_(ldp(P, t, PC_GATE + (MODE ? 16 : 8) + h));
        const size_t oi = (size_t)t * 512 + h * NDK + lane;
        float res = gate * o / sum;
        if (!MODE) res += bf2f(NSA[oi]);
        NSA[oi] = (bf16)f2bf(res);
    }
}

__device__ __forceinline__ void n_cmp(const Args& a, const bf16* P, bf16* NSA, LAS unsigned char* lds, int G) {
    const int tid = tid_opaque(), w = tid >> 6, lane = tid & 63;
    LAS float* qs = (LAS float*)(lds + w * 4096);
    LAS float* ps = qs + 256;
    const float* kcmp = (const float*)(a.ws + WS_KCMP); const float* vcmp = (const float*)(a.ws + WS_VCMP);
    unsigned* selmask = (unsigned*)(a.ws + WS_SEL);
    for (int it = blockIdx.x; it < M * NG / 8; it += G) {
        const int u = it * 8 + w, g = u & 1, t = u >> 1, tl = t & (SEQ - 1), b = t >> 11;
        const float* kc = kcmp + ((size_t)b * NG + g) * NC * NDK; const float* vc = vcmp + ((size_t)b * NG + g) * NC * NDK;
        __syncthreads();
        for (int r = 0; r < NR; ++r) qs[r * 64 + lane] = ldp(P, t, PC_NQ + (g * NR + r) * NDK + lane);
        __syncthreads();
        for (int r = 0; r < NR; ++r) {
            const int h = g * NR + r; const float slope = exp2f(-(float)(h + 1));
            float sc[2]; bool val[2];
#pragma unroll
            for (int q = 0; q < 2; ++q) {
                const int c = lane + 64 * q; sc[q] = -1e30f; val[q] = false;
                if (c < NC) {
                    float d = 0.f; const float* kr = kc + (size_t)c * NDK;
                    for (int x = 0; x < NDK; ++x) d += qs[r * 64 + x] * kr[x];
                    const int dc = tl - (c * CSTR + CBLK - 1);
                    if (dc >= 0) { val[q] = true; sc[q] = d * 0.125f - slope * (float)dc; }
                }
            }
            const float mx = wave_max(fmaxf(sc[0], sc[1]));
            float p0 = val[0] ? expf(sc[0] - mx) : 0.f, p1 = val[1] ? expf(sc[1] - mx) : 0.f;
            const float sum = wave_sum(p0 + p1);
            const float inv = sum > 0.f ? 1.f / sum : 0.f;
            ps[r * 128 + lane] = p0 * inv; ps[r * 128 + 64 + lane] = p1 * inv;
        }
        __syncthreads();
        for (int r = 0; r < NR; ++r) {
            const int h = g * NR + r;
            float o = 0.f;
            for (int c = 0; c < NC; ++c) o += ps[r * 128 + c] * vc[(size_t)c * NDK + lane];
            const float gate = sigmoidf_(ldp(P, t, PC_GATE + h));
            const size_t oi = (size_t)t * 512 + h * NDK + lane;
            NSA[oi] = (bf16)f2bf(bf2f(NSA[oi]) + gate * o);
        }
        float imp = 0.f; const int j = lane & 31;
        for (int r = 0; r < NR; ++r)
            for (int c = 4 * j - 1; c <= 4 * j + 3; ++c) if (c >= 0 && c < NC) imp += ps[r * 128 + c];
        const int cur = tl >> 6;
        if (j == 0 || j == cur || j == cur - 1) imp = 1e9f;
        if (j > cur) imp = -1e9f;
        int rank = 0;
        for (int i = 0; i < NS; ++i) { const float o = __shfl(imp, i); rank += (o > imp || (o == imp && i < j)) ? 1 : 0; }
        const unsigned long long bal = __ballot(rank < TOPK && lane < 32 && j <= cur);
        if (lane == 0) selmask[t * NG + g] = (unsigned)bal;
    }
}

__device__ __forceinline__ void n_retention(const Args& a, bf16* P, LAS unsigned char* lds, int G) {
    const int tid = tid_opaque(), sub = tid >> 8, lt = tid & 255;
    LAS float* Qs = (LAS float*)(lds + sub * 49152);
    LAS float* Ks = Qs + 32 * 129;
    LAS float* Vs = Ks + 16 * 129;
    LAS float* Ps = Vs + 16 * 256;
    const float* gn_g = a.in[3];
    for (int p = blockIdx.x; p < NBATCH * 2 * 64; p += G) {
        const int k_ = p >> 8, qt0 = p & 63, qt = (k_ & 1) ? 63 - qt0 : qt0, idx = p >> 6, hp = idx & 1, b = idx >> 1, h = hp * 2 + sub;
        const size_t rb = (size_t)b * SEQ;
        const float lg = log1pf(-exp2f(-5.0f - (float)h));
        const float scale = 0.08838834764831845f;
        __syncthreads();
        for (int i = lt; i < 32 * 128; i += 256) { const int r = i >> 7, c = i & 127; Qs[r * 129 + c] = ldp(P, rb + qt * 32 + r, PC_RQ + h * RDK + c); }
        float acc[32];
#pragma unroll
        for (int e = 0; e < 32; ++e) acc[e] = 0.f;
        const int pi = lt >> 3, pj0 = (lt & 7) * 2;
        for (int kt = 0; kt <= 2 * qt + 1; ++kt) {
            __syncthreads();
            for (int i = lt; i < 16 * 128; i += 256) { const int r = i >> 7, c = i & 127; Ks[r * 129 + c] = ldp(P, rb + kt * 16 + r, PC_RK + h * RDK + c); }
            for (int i = lt; i < 16 * 256; i += 256) { const int r = i >> 8, c = i & 255; Vs[r * 256 + c] = ldp(P, rb + kt * 16 + r, PC_RV + h * RDV + c); }
            __syncthreads();
#pragma unroll
            for (int jj = 0; jj < 2; ++jj) {
                const int j = pj0 + jj; float d = 0.f;
                for (int c = 0; c < 128; ++c) d += Qs[pi * 129 + c] * Ks[j * 129 + c];
                const int diff = (qt * 32 + pi) - (kt * 16 + j);
                Ps[pi * 17 + j] = diff >= 0 ? d * scale * expf(lg * (float)diff) : 0.f;
            }
            __syncthreads();
            for (int j = 0; j < 16; ++j) {
                const float pv = Ps[pi * 17 + j];
#pragma unroll
                for (int e = 0; e < 32; ++e) acc[e] += pv * Vs[j * 256 + (lt & 7) + 8 * e];
            }
        }
        float s = 0.f;
#pragma unroll
        for (int e = 0; e < 32; ++e) s += acc[e];
        s += __shfl_xor(s, 1); s += __shfl_xor(s, 2); s += __shfl_xor(s, 4);
        const float mu = s / 256.f;
        float q = 0.f;
#pragma unroll
        for (int e = 0; e < 32; ++e) { const float d = acc[e] - mu; q += d * d; }
        q += __shfl_xor(q, 1); q += __shfl_xor(q, 2); q += __shfl_xor(q, 4);
        const float rstd = rsqrtf(q / 256.f + EPS);
        const size_t t = rb + qt * 32 + pi;
#pragma unroll
        for (int e = 0; e < 32; ++e) {
            const int col = h * RDV + (lt & 7) + 8 * e;
            const float on = (acc[e] - mu) * rstd * gn_g[col];
            const float gg = ldp(P, t, PC_RG + col);
            P[t * PP + PC_RG + col] = (bf16)f2bf(gg * sigmoidf_(gg) * on);
        }
    }
}

__device__ __forceinline__ void n_conv(const Args& a, bf16* P, int G) {
    const float* cw = a.in[17]; const float* cb = a.in[18];
    const size_t total = (size_t)M * (DFF / 8);
    for (size_t i = (size_t)blockIdx.x * 512 + tid_opaque(); i < total; i += (size_t)G * 512) {
        const int t = (int)(i / (DFF / 8)), f8 = (int)(i % (DFF / 8)) * 8, pn = f8 >> 7, j = f8 & 127, tl = t & (SEQ - 1);
        bf16* pa = P + (size_t)t * PP + PC_UP + 256 * pn + j;
        const v4u a0 = *(const v4u*)pa, bb = *(const v4u*)(pa + 128);
        v4u a1 = (v4u){0u, 0u, 0u, 0u}, a2 = a1;
        if (tl >= 1) a1 = *(const v4u*)(pa - PP);
        if (tl >= 2) a2 = *(const v4u*)(pa - 2 * PP);
        unsigned o[4];
#pragma unroll
        for (int q = 0; q < 4; ++q) {
            float r2[2];
#pragma unroll
            for (int hh = 0; hh < 2; ++hh) {
                const int f = f8 + 2 * q + hh;
                const float x0 = hh ? pg8::bf_hi(a0[q]) : pg8::bf_lo(a0[q]), x1 = hh ? pg8::bf_hi(a1[q]) : pg8::bf_lo(a1[q]), x2 = hh ? pg8::bf_hi(a2[q]) : pg8::bf_lo(a2[q]);
                const float bv = hh ? pg8::bf_hi(bb[q]) : pg8::bf_lo(bb[q]);
                const float ac = cb[f] + cw[2 * DFF + f] * x0 + cw[DFF + f] * x1 + cw[f] * x2;
                r2[hh] = gelu_tanh(ac) * bv;
            }
            o[q] = pk2(r2[0], r2[1]);
        }
        *(v4u*)(pa + 128) = (v4u){o[0], o[1], o[2], o[3]};
    }
}

__device__ __forceinline__ void n_final(const Args& a, int G) {
    const int tid_ = tid_opaque(), lane = tid_ & 63, gw = blockIdx.x * 8 + (tid_ >> 6), NGW = G * 8;
    const float* rs3 = (const float*)(a.ws + WS_RS3); const float* gf = a.in[20];
    for (int m = gw; m < M; m += NGW) {
        const float rstd = rsqrtf(rs3[m] * (1.f / DM) + EPS);
        f32x4* xr = (f32x4*)(a.out + (size_t)m * DM) + lane;
#pragma unroll
        for (int j = 0; j < 4; ++j) { const f32x4 gv = *((const f32x4*)gf + lane + 64 * j); f32x4 v = xr[64 * j]; v = v * rstd * gv; xr[64 * j] = v; }
    }
}


typedef short bf16x8 __attribute__((ext_vector_type(8)));
typedef float f32x16 __attribute__((ext_vector_type(16)));
typedef float f32x2_t __attribute__((ext_vector_type(2))); typedef __bf16 bf16x2_t __attribute__((ext_vector_type(2)));
typedef unsigned v2u __attribute__((ext_vector_type(2)));
#define MFMA32(a, b, c) __builtin_amdgcn_mfma_f32_32x32x16_bf16((a), (b), (c), 0, 0, 0)
__device__ __forceinline__ unsigned cvtpk(float lo, float hi) { f32x2_t v = {lo, hi}; bf16x2_t b = __builtin_convertvector(v, bf16x2_t); return __builtin_bit_cast(unsigned, b); }
__device__ __forceinline__ float xhalf_max(float m) { auto rr = __builtin_amdgcn_permlane32_swap(__float_as_uint(m), __float_as_uint(m), false, false); return fmaxf(__uint_as_float(rr[0]), __uint_as_float(rr[1])); }
__device__ __forceinline__ float xhalf_sum(float m) { auto rr = __builtin_amdgcn_permlane32_swap(__float_as_uint(m), __float_as_uint(m), false, false); return __uint_as_float(rr[0]) + __uint_as_float(rr[1]); }
__device__ __forceinline__ bf16x8 pack8(const f32x16& x, int s) {
    v4u p; p.x = cvtpk(x[8 * s], x[8 * s + 1]); p.y = cvtpk(x[8 * s + 2], x[8 * s + 3]); p.z = cvtpk(x[8 * s + 4], x[8 * s + 5]); p.w = cvtpk(x[8 * s + 6], x[8 * s + 7]);
    return __builtin_bit_cast(bf16x8, p);
}
constexpr float LOG2E = 1.4426950408889634f;
constexpr int AT_KSTR = 144, AT_VSTR = 136, AT_VOFF = 64 * AT_KSTR, AT_BUF = AT_VOFF + 64 * AT_VSTR;

template <int MODE>
__device__ __forceinline__ void attn_unit(const bf16* P, bf16* NSA, const unsigned* selmask, LAS unsigned char* lds, int b, int g, int n) {
    const int tid = tid_opaque(), lane = tid & 63, wid = tid >> 6, q = lane & 31, h = lane >> 5;
    const int r = wid >> 1, th = wid & 1, head = g * NR + r;
    const int tl = 64 * n + 32 * th + q;
    const size_t rb = (size_t)b * SEQ, trow = rb + tl;
    bf16x8 qf[4];
    { const bf16* qp = P + trow * PP + PC_NQ + head * NDK + 8 * h;
#pragma unroll
      for (int ks = 0; ks < 4; ++ks) qf[ks] = *(const bf16x8*)(qp + 16 * ks); }
    const float slope2 = exp2f(-(float)(head + 1)) * LOG2E, c1 = 0.125f * LOG2E;
    const unsigned smask = MODE == 0 ? selmask[trow * NG + g] : 0u;
    const int j0 = MODE == 1 ? (n > 8 ? n - 8 : 0) : 0, j1 = n;
    f32x16 o0, o1;
#pragma unroll
    for (int i = 0; i < 16; ++i) { o0[i] = 0.f; o1[i] = 0.f; }
    float m = -1e30f, l = 0.f;
    const int skey = tid >> 3, sch = tid & 7;
    const bf16* kg = P + (rb + skey) * PP + (MODE ? PC_KW : PC_KS) + g * NDK + 8 * sch;
    const bf16* vg = P + (rb + skey) * PP + (MODE ? PC_VW : PC_VS) + g * NDK + 8 * sch;
    v4u kreg = *(const v4u*)(kg + (size_t)(64 * j0) * PP), vreg = *(const v4u*)(vg + (size_t)(64 * j0) * PP);
#define AT_WRITE(bufi) do { LAS unsigned char* kb_ = lds + (bufi) * AT_BUF; *(LAS v4u*)(kb_ + skey * AT_KSTR + sch * 16) = kreg; \
        LAS bf16* vb_ = (LAS bf16*)(kb_ + AT_VOFF) + skey; \
        _Pragma("unroll") for (int i_ = 0; i_ < 4; ++i_) { vb_[(8 * sch + 2 * i_) * (AT_VSTR / 2)] = (bf16)(vreg[i_] & 0xffffu); vb_[(8 * sch + 2 * i_ + 1) * (AT_VSTR / 2)] = (bf16)(vreg[i_] >> 16); } } while (0)
    AT_WRITE(0);
    __syncthreads();
    for (int j = j0; j <= j1; ++j) {
        const int cur = (j - j0) & 1;
        if (j < j1) { kreg = *(const v4u*)(kg + (size_t)(64 * (j + 1)) * PP); vreg = *(const v4u*)(vg + (size_t)(64 * (j + 1)) * PP); }
        LAS unsigned char* kb = lds + cur * AT_BUF;
        f32x16 s0, s1;
#pragma unroll
        for (int i = 0; i < 16; ++i) { s0[i] = 0.f; s1[i] = 0.f; }
#pragma unroll
        for (int ks = 0; ks < 4; ++ks) {
            const bf16x8 a0 = *(const LAS bf16x8*)(kb + q * AT_KSTR + ks * 32 + h * 16);
            const bf16x8 a1 = *(const LAS bf16x8*)(kb + (q + 32) * AT_KSTR + ks * 32 + h * 16);
            s0 = MFMA32(a0, qf[ks], s0); s1 = MFMA32(a1, qf[ks], s1);
        }
        const float lt = slope2 * (float)(64 * j + 4 * h - tl);
        const bool need_mask = (j == n) || (MODE == 1 && j == n - 8);
        const bool lane_ok = MODE == 0 ? ((smask >> j) & 1u) != 0u : true;
        const int dbase = tl - 64 * j - 4 * h;
        float mx = -INFINITY;
#pragma unroll
        for (int i = 0; i < 16; ++i) {
            const int kk = (i & 3) + 8 * (i >> 2);
            float z0 = fmaf(s0[i], c1, lt + slope2 * (float)kk), z1 = fmaf(s1[i], c1, lt + slope2 * (float)(kk + 32));
            if (need_mask) { const int d0 = dbase - kk, d1 = d0 - 32;
                if (!(d0 >= 0 && (MODE == 0 || d0 < WIN))) z0 = -INFINITY;
                if (!(d1 >= 0 && (MODE == 0 || d1 < WIN))) z1 = -INFINITY; }
            if (!lane_ok) { z0 = -INFINITY; z1 = -INFINITY; }
            s0[i] = z0; s1[i] = z1; mx = fmaxf(mx, fmaxf(z0, z1));
        }
        mx = xhalf_max(mx);
        const float mn = fmaxf(m, mx), alpha = __builtin_amdgcn_exp2f(m - mn);
        m = mn;
        float ps = 0.f;
#pragma unroll
        for (int i = 0; i < 16; ++i) { s0[i] = __builtin_amdgcn_exp2f(s0[i] - mn); s1[i] = __builtin_amdgcn_exp2f(s1[i] - mn); ps += s0[i] + s1[i]; }
        l = l * alpha + ps;
#pragma unroll
        for (int i = 0; i < 16; ++i) { o0[i] *= alpha; o1[i] *= alpha; }
        bf16x8 pf[4];
        pf[0] = pack8(s0, 0); pf[1] = pack8(s0, 1); pf[2] = pack8(s1, 0); pf[3] = pack8(s1, 1);
        const LAS unsigned char* vb = kb + AT_VOFF + q * AT_VSTR + 8 * h;
#pragma unroll
        for (int ks = 0; ks < 4; ++ks) {
            { const v2u lo = *(const LAS v2u*)(vb + ks * 32), hi = *(const LAS v2u*)(vb + ks * 32 + 16);
              const v4u av = (v4u){lo.x, lo.y, hi.x, hi.y}; o0 = MFMA32(__builtin_bit_cast(bf16x8, av), pf[ks], o0); }
            { const v2u lo = *(const LAS v2u*)(vb + 32 * AT_VSTR + ks * 32), hi = *(const LAS v2u*)(vb + 32 * AT_VSTR + ks * 32 + 16);
              const v4u av = (v4u){lo.x, lo.y, hi.x, hi.y}; o1 = MFMA32(__builtin_bit_cast(bf16x8, av), pf[ks], o1); }
        }
        if (j < j1) AT_WRITE(cur ^ 1);
        __syncthreads();
    }
#undef AT_WRITE
    l = xhalf_sum(l);
    const float gate = pg8::fsig(bf2f(P[trow * PP + PC_GATE + (MODE ? 16 : 8) + head]));
    const float f = gate / l;
    bf16* op = NSA + trow * 512 + head * NDK + 4 * h;
#pragma unroll
    for (int dt = 0; dt < 2; ++dt)
#pragma unroll
        for (int rg = 0; rg < 4; ++rg) {
            const f32x16& o = dt ? o1 : o0;
            float v0 = o[4 * rg] * f, v1 = o[4 * rg + 1] * f, v2 = o[4 * rg + 2] * f, v3 = o[4 * rg + 3] * f;
            v2u* dst = (v2u*)(op + 32 * dt + 8 * rg);
            if (MODE == 0) { const v2u pv = *dst; v0 += pg8::bf_lo(pv.x); v1 += pg8::bf_hi(pv.x); v2 += pg8::bf_lo(pv.y); v3 += pg8::bf_hi(pv.y); }
            *dst = (v2u){cvtpk(v0, v1), cvtpk(v2, v3)};
        }
}
template <int MODE>
__device__ __forceinline__ void attn_phase(const Args& a, const bf16* P, bf16* NSA, LAS unsigned char* lds, int G, int id) {
    const unsigned* selmask = (const unsigned*)(a.ws + WS_SEL);
    __syncthreads();
    for (int u = id; u < NBATCH * NG * NS; u += G) {
        const int n = 31 - (u >> 5), bg = u & 31;
        attn_unit<MODE>(P, NSA, selmask, lds, bg >> 1, bg & 1, n);
    }
}


typedef short v4i16_t __attribute__((ext_vector_type(4)));
__device__ __forceinline__ v4i16_t ds_tr(const LAS unsigned char* p) { return __builtin_amdgcn_ds_read_tr16_b64_v4i16((LAS v4i16_t*)p); }
__device__ __forceinline__ bf16x8 tr_frag(const LAS unsigned char* base, int R, int k0, int n0, int lane) {
    const int grp = lane >> 4, li = lane & 15, qq = li >> 2, pp = li & 3, ngrp = grp & 1, hh = grp >> 1;
    const LAS unsigned char* a = base + (k0 + 8 * hh + qq) * R + (n0 + 16 * ngrp + 4 * pp) * 2;
    const v4i16_t lo = ds_tr(a), hi = ds_tr(a + 4 * R);
    return (bf16x8){lo[0], lo[1], lo[2], lo[3], hi[0], hi[1], hi[2], hi[3]};
}
__device__ __forceinline__ bf16x8 tr_frag_perm(const LAS unsigned char* base, int R, int k0, int n0, int lane) {
    const int grp = lane >> 4, li = lane & 15, qq = li >> 2, pp = li & 3, ngrp = grp & 1, hh = grp >> 1;
    const LAS unsigned char* a = base + (k0 + 4 * hh + qq) * R + (n0 + 16 * ngrp + 4 * pp) * 2;
    const v4i16_t lo = ds_tr(a), hi = ds_tr(a + 8 * R);
    return (bf16x8){lo[0], lo[1], lo[2], lo[3], hi[0], hi[1], hi[2], hi[3]};
}
__device__ __forceinline__ v4u scale8(v4u v, float sc) {
    v4u o;
#pragma unroll
    for (int i = 0; i < 4; ++i) o[i] = cvtpk(pg8::bf_lo(v[i]) * sc, pg8::bf_hi(v[i]) * sc);
    return o;
}
__device__ __forceinline__ float ret_lg2(int hd) { return log2f(1.0f - exp2f(-5.0f - (float)hd)); }

constexpr int RT_VSTR = 576, RT_KSTR = 320, RO_STR = 272;
constexpr size_t KV_UNIT = 256 * 128;
__device__ __forceinline__ void ret_kv_unit(const bf16* P, bf16* KVS, LAS unsigned char* lds, int b, int hd, int n) {
    const int tid = tid_opaque(), lane = tid & 63, wid = tid >> 6, h = lane >> 5;
    const float lg2 = ret_lg2(hd);
    LAS unsigned char* Vs = lds; LAS unsigned char* Ks = lds + 128 * RT_VSTR;
    const size_t rowbase = (size_t)b * SEQ + 128 * n;
    __syncthreads();
#pragma unroll
    for (int i = 0; i < 8; ++i) { const int idx = tid + 512 * i, row = idx >> 5, ch = idx & 31;
        *(LAS v4u*)(Vs + row * RT_VSTR + ch * 16) = *(const v4u*)(P + (rowbase + row) * PP + PC_RV + hd * RDV + 8 * ch); }
#pragma unroll
    for (int i = 0; i < 4; ++i) { const int idx = tid + 512 * i, row = idx >> 4, ch = idx & 15;
        const float sc = 0.08838834764831845f * exp2f(lg2 * (float)(127 - row));
        *(LAS v4u*)(Ks + row * RT_KSTR + ch * 16) = scale8(*(const v4u*)(P + (rowbase + row) * PP + PC_RK + hd * RDK + 8 * ch), sc); }
    __syncthreads();
    f32x16 acc[4];
#pragma unroll
    for (int d = 0; d < 4; ++d)
#pragma unroll
        for (int i = 0; i < 16; ++i) acc[d][i] = 0.f;
#pragma unroll 2
    for (int ks = 0; ks < 8; ++ks) {
        const bf16x8 A = tr_frag(Vs, RT_VSTR, 16 * ks, 32 * wid, lane);
#pragma unroll
        for (int dt = 0; dt < 4; ++dt) { const bf16x8 B = tr_frag(Ks, RT_KSTR, 16 * ks, 32 * dt, lane); acc[dt] = MFMA32(A, B, acc[dt]); }
    }
    bf16* ob = KVS + (size_t)(((b * RH + hd) * 16 + n)) * KV_UNIT;
#pragma unroll
    for (int dt = 0; dt < 4; ++dt)
#pragma unroll
        for (int i = 0; i < 16; ++i) { const int e = 32 * wid + (i & 3) + 8 * (i >> 2) + 4 * h, d = 32 * dt + (lane & 31); ob[e * 128 + d] = (bf16)f2bf(acc[dt][i]); }
}
__device__ __forceinline__ void ret_kv_phase(const bf16* P, bf16* KVS, LAS unsigned char* lds, int G, int id) {
    for (int u = id; u < NBATCH * RH * 16; u += G) ret_kv_unit(P, KVS, lds, u >> 6, (u >> 4) & 3, u & 15);
}
__device__ __forceinline__ void ret_scan_phase(bf16* KVS, int G) {
    for (int it = blockIdx.x * 512 + tid_opaque(); it < NBATCH * RH * 4096; it += G * 512) {
        const int bh = it >> 12, off = (it & 4095) * 8, hd = bh & 3;
        const float decay = exp2f(128.0f * ret_lg2(hd));
        float st[8];
#pragma unroll
        for (int i = 0; i < 8; ++i) st[i] = 0.f;
        bf16* p = KVS + (size_t)bh * 16 * KV_UNIT + off;
        for (int n = 0; n < 16; ++n, p += KV_UNIT) {
            const v4u v = *(const v4u*)p;
            *(v4u*)p = (v4u){cvtpk(st[0], st[1]), cvtpk(st[2], st[3]), cvtpk(st[4], st[5]), cvtpk(st[6], st[7])};
#pragma unroll
            for (int i = 0; i < 4; ++i) { st[2 * i] = st[2 * i] * decay + pg8::bf_lo(v[i]); st[2 * i + 1] = st[2 * i + 1] * decay + pg8::bf_hi(v[i]); }
        }
    }
}
constexpr int RO_QS = 0, RO_SB = 128 * RO_STR, RO_X = 2 * 128 * RO_STR, RO_STATS = RO_X + 128 * RT_VSTR;
static_assert(RO_STATS + 2048 <= 147456 && 256 * RO_STR <= 128 * RT_VSTR, "retention LDS map");
__device__ __forceinline__ void ret_out_unit(bf16* P, const bf16* KVS, const float* gn_g, LAS unsigned char* lds, int b, int hd, int n) {
    const int tid = tid_opaque(), lane = tid & 63, wid = tid >> 6, q = lane & 31, h = lane >> 5;
    const float lg2 = ret_lg2(hd);
    LAS unsigned char* Qs = lds + RO_QS; LAS unsigned char* Sb = lds + RO_SB; LAS unsigned char* X = lds + RO_X;
    const size_t rowbase = (size_t)b * SEQ + 128 * n;
    __syncthreads();
#pragma unroll
    for (int i = 0; i < 4; ++i) { const int idx = tid + 512 * i, row = idx >> 4, ch = idx & 15;
        const float e1 = exp2f(lg2 * (float)(row + 1));
        *(LAS v4u*)(Qs + row * RO_STR + ch * 16) = scale8(*(const v4u*)(P + (rowbase + row) * PP + PC_RQ + hd * RDK + 8 * ch), e1);
        *(LAS v4u*)(X + row * RO_STR + ch * 16) = scale8(*(const v4u*)(P + (rowbase + row) * PP + PC_RK + hd * RDK + 8 * ch), 0.08838834764831845f / e1); }
    __syncthreads();
    const int tt = wid & 3, sh = wid >> 2, trl = 32 * tt + q;
#pragma unroll
    for (int si = 0; si < 2; ++si) {
        const int st = 2 * sh + si;
        if (st > tt) {
#pragma unroll
            for (int rg = 0; rg < 4; ++rg) *(LAS v2u*)(Sb + trl * RO_STR + (32 * st + 8 * rg + 4 * h) * 2) = (v2u){0u, 0u};
        } else {
            f32x16 s;
#pragma unroll
            for (int i = 0; i < 16; ++i) s[i] = 0.f;
#pragma unroll
            for (int ks = 0; ks < 8; ++ks) {
                const bf16x8 a = *(const LAS bf16x8*)(X + (32 * st + q) * RO_STR + ks * 32 + h * 16);
                const bf16x8 bq = *(const LAS bf16x8*)(Qs + trl * RO_STR + ks * 32 + h * 16);
                s = MFMA32(a, bq, s);
            }
#pragma unroll
            for (int rg = 0; rg < 4; ++rg) { const int s0 = 32 * st + 8 * rg + 4 * h;
                const float v0 = (s0 <= trl) ? s[4 * rg] : 0.f, v1 = (s0 + 1 <= trl) ? s[4 * rg + 1] : 0.f, v2 = (s0 + 2 <= trl) ? s[4 * rg + 2] : 0.f, v3 = (s0 + 3 <= trl) ? s[4 * rg + 3] : 0.f;
                *(LAS v2u*)(Sb + trl * RO_STR + s0 * 2) = (v2u){cvtpk(v0, v1), cvtpk(v2, v3)}; }
        }
    }
    __syncthreads();
#pragma unroll
    for (int i = 0; i < 8; ++i) { const int idx = tid + 512 * i, row = idx >> 5, ch = idx & 31;
        *(LAS v4u*)(X + row * RT_VSTR + ch * 16) = *(const v4u*)(P + (rowbase + row) * PP + PC_RV + hd * RDV + 8 * ch); }
    __syncthreads();
    const int eh = wid >> 2;
    f32x16 acc[4];
#pragma unroll
    for (int d = 0; d < 4; ++d)
#pragma unroll
        for (int i = 0; i < 16; ++i) acc[d][i] = 0.f;
    for (int ks = 0; ks < 2 * (tt + 1); ++ks) {
        const bf16x8 bS = *(const LAS bf16x8*)(Sb + trl * RO_STR + ks * 32 + h * 16);
#pragma unroll
        for (int et = 0; et < 4; ++et) { const bf16x8 A = tr_frag(X, RT_VSTR, 16 * ks, 32 * (4 * eh + et), lane); acc[et] = MFMA32(A, bS, acc[et]); }
    }
    __syncthreads();
    { const bf16* rt = KVS + (size_t)(((b * RH + hd) * 16 + n)) * KV_UNIT;
#pragma unroll
      for (int i = 0; i < 8; ++i) { const int idx = tid + 512 * i, row = idx >> 4, ch = idx & 15;
          *(LAS v4u*)(X + row * RO_STR + ch * 16) = *(const v4u*)(rt + row * 128 + 8 * ch); } }
    __syncthreads();
#pragma unroll 2
    for (int ks = 0; ks < 8; ++ks) {
        const bf16x8 bQ = *(const LAS bf16x8*)(Qs + trl * RO_STR + ks * 32 + h * 16);
#pragma unroll
        for (int et = 0; et < 4; ++et) { const bf16x8 A = *(const LAS bf16x8*)(X + (32 * (4 * eh + et) + q) * RO_STR + ks * 32 + h * 16); acc[et] = MFMA32(A, bQ, acc[et]); }
    }
    float s1 = 0.f, s2 = 0.f;
#pragma unroll
    for (int et = 0; et < 4; ++et)
#pragma unroll
        for (int i = 0; i < 16; ++i) { s1 += acc[et][i]; s2 += acc[et][i] * acc[et][i]; }
    s1 = xhalf_sum(s1); s2 = xhalf_sum(s2);
    LAS float* stats = (LAS float*)(lds + RO_STATS);
    if (h == 0) { stats[(eh * 128 + trl) * 2] = s1; stats[(eh * 128 + trl) * 2 + 1] = s2; }
    __syncthreads();
    s1 = stats[trl * 2] + stats[(128 + trl) * 2]; s2 = stats[trl * 2 + 1] + stats[(128 + trl) * 2 + 1];
    const float mu = s1 * (1.f / 256.f), rstd = rsqrtf(fmaxf(s2 * (1.f / 256.f) - mu * mu, 0.f) + EPS);
    bf16* gp = P + (rowbase + trl) * PP + PC_RG + hd * RDV;
    const float* gg = gn_g + hd * RDV;
#pragma unroll
    for (int et = 0; et < 4; ++et)
#pragma unroll
        for (int rg = 0; rg < 4; ++rg) {
            const int e0 = 32 * (4 * eh + et) + 8 * rg + 4 * h;
            const v2u gv = *(const v2u*)(gp + e0); const f32x4 gn = *(const f32x4*)(gg + e0);
            const float g0 = pg8::bf_lo(gv.x), g1 = pg8::bf_hi(gv.x), g2 = pg8::bf_lo(gv.y), g3 = pg8::bf_hi(gv.y);
            const float o0 = (acc[et][4 * rg] - mu) * rstd * gn[0] * g0 * pg8::fsig(g0), o1 = (acc[et][4 * rg + 1] - mu) * rstd * gn[1] * g1 * pg8::fsig(g1);
            const float o2 = (acc[et][4 * rg + 2] - mu) * rstd * gn[2] * g2 * pg8::fsig(g2), o3 = (acc[et][4 * rg + 3] - mu) * rstd * gn[3] * g3 * pg8::fsig(g3);
            *(v2u*)(gp + e0) = (v2u){cvtpk(o0, o1), cvtpk(o2, o3)};
        }
}
__device__ __forceinline__ void ret_out_phase(bf16* P, const bf16* KVS, const float* gn_g, LAS unsigned char* lds, int G) {
    for (int u = blockIdx.x; u < NBATCH * RH * 16; u += G) ret_out_unit(P, KVS, gn_g, lds, u >> 6, (u >> 4) & 3, u & 15);
}

constexpr int CM_KSTR = 144, CM_VSTR = 192;
constexpr int CM_K = 0, CM_V = 128 * CM_KSTR, CM_GW = CM_V + 128 * CM_VSTR, CM_TW = CM_GW + 32768, CM_IMP = CM_TW + 32768;
__device__ __forceinline__ void cmp_unit(const bf16* P, bf16* NSA, const bf16* KC, const bf16* VC, unsigned* selmask, LAS unsigned char* lds, int b, int g, int n) {
    const int tid = tid_opaque(), lane = tid & 63, wid = tid >> 6, q = lane & 31, h = lane >> 5;
    const int r = wid >> 1, th = wid & 1, head = g * NR + r;
    const int tok = 32 * th + q, tl = 64 * n + tok;
    const size_t rb = (size_t)b * SEQ, trow = rb + tl;
    bf16x8 qf[4];
    { const bf16* qp = P + trow * PP + PC_NQ + head * NDK + 8 * h;
#pragma unroll
      for (int ks = 0; ks < 4; ++ks) qf[ks] = *(const bf16x8*)(qp + 16 * ks); }
    const float slope2 = exp2f(-(float)(head + 1)) * LOG2E, c1 = 0.125f * LOG2E;
    __syncthreads();
#pragma unroll
    for (int i = 0; i < 2; ++i) { const int idx = tid + 512 * i, row = idx >> 3, ch = idx & 7;
        v4u kv = (v4u){0u, 0u, 0u, 0u}, vv = kv;
        if (row < NC) { kv = *(const v4u*)(KC + ((size_t)(b * NG + g) * 128 + row) * NDK + 8 * ch); vv = *(const v4u*)(VC + ((size_t)(b * NG + g) * 128 + row) * NDK + 8 * ch); }
        *(LAS v4u*)(lds + CM_K + row * CM_KSTR + ch * 16) = kv; *(LAS v4u*)(lds + CM_V + row * CM_VSTR + ch * 16) = vv; }
    __syncthreads();
    const int ktmax = (4 * n + 2) >> 5;
    f32x16 s[4];
#pragma unroll
    for (int kt = 0; kt < 4; ++kt) {
#pragma unroll
        for (int i = 0; i < 16; ++i) s[kt][i] = 0.f;
        if (kt <= ktmax) {
#pragma unroll
            for (int ks = 0; ks < 4; ++ks) { const bf16x8 a = *(const LAS bf16x8*)(lds + CM_K + (32 * kt + q) * CM_KSTR + ks * 32 + h * 16); s[kt] = MFMA32(a, qf[ks], s[kt]); }
        }
    }
    float mx = -INFINITY;
#pragma unroll
    for (int kt = 0; kt < 4; ++kt)
#pragma unroll
        for (int i = 0; i < 16; ++i) { const int c = 32 * kt + (i & 3) + 8 * (i >> 2) + 4 * h, dc = tl - (c * CSTR + CBLK - 1);
            const float z = (dc >= 0 && kt <= ktmax) ? fmaf(s[kt][i], c1, -slope2 * (float)dc) : -INFINITY;
            s[kt][i] = z; mx = fmaxf(mx, z); }
    mx = xhalf_max(mx);
    const float mref = (mx == -INFINITY) ? 0.f : mx;
    float sum = 0.f;
#pragma unroll
    for (int kt = 0; kt < 4; ++kt)
#pragma unroll
        for (int i = 0; i < 16; ++i) { s[kt][i] = __builtin_amdgcn_exp2f(s[kt][i] - mref); sum += s[kt][i]; }
    sum = xhalf_sum(sum);
    const float inv = sum > 0.f ? 1.f / sum : 0.f;
    LAS float* GW = (LAS float*)(lds + CM_GW); LAS float* TW = (LAS float*)(lds + CM_TW);
#pragma unroll
    for (int kt = 0; kt < 4; ++kt) {
#pragma unroll
        for (int i = 0; i < 16; ++i) s[kt][i] *= inv;
#pragma unroll
        for (int rg = 0; rg < 4; ++rg) { const int j = 8 * kt + 2 * rg + h;
            GW[(r * 64 + tok) * 32 + j] = (s[kt][4 * rg] + s[kt][4 * rg + 1]) + (s[kt][4 * rg + 2] + s[kt][4 * rg + 3]);
            TW[(r * 64 + tok) * 32 + j] = s[kt][4 * rg + 3]; }
    }
    f32x16 o0, o1;
#pragma unroll
    for (int i = 0; i < 16; ++i) { o0[i] = 0.f; o1[i] = 0.f; }
#pragma unroll
    for (int kt = 0; kt < 4; ++kt) {
        if (kt <= ktmax) {
#pragma unroll
            for (int sp = 0; sp < 2; ++sp) { const bf16x8 pf = pack8(s[kt], sp);
                const bf16x8 A0 = tr_frag_perm(lds + CM_V, CM_VSTR, 32 * kt + 16 * sp, 0, lane), A1 = tr_frag_perm(lds + CM_V, CM_VSTR, 32 * kt + 16 * sp, 32, lane);
                o0 = MFMA32(A0, pf, o0); o1 = MFMA32(A1, pf, o1); }
        }
    }
    { const float gate = pg8::fsig(bf2f(P[trow * PP + PC_GATE + head]));
      bf16* op = NSA + trow * 512 + head * NDK + 4 * h;
#pragma unroll
      for (int dt = 0; dt < 2; ++dt)
#pragma unroll
          for (int rg = 0; rg < 4; ++rg) {
              const f32x16& o = dt ? o1 : o0;
              v2u* dst = (v2u*)(op + 32 * dt + 8 * rg); const v2u pv = *dst;
              const float v0 = o[4 * rg] * gate + pg8::bf_lo(pv.x), v1 = o[4 * rg + 1] * gate + pg8::bf_hi(pv.x), v2 = o[4 * rg + 2] * gate + pg8::bf_lo(pv.y), v3 = o[4 * rg + 3] * gate + pg8::bf_hi(pv.y);
              *dst = (v2u){cvtpk(v0, v1), cvtpk(v2, v3)};
          } }
    __syncthreads();
    LAS float* IMP = (LAS float*)(lds + CM_IMP);
    const int j = tid & 31;
#pragma unroll
    for (int pass = 0; pass < 4; ++pass) { const int tk = (tid >> 5) + 16 * pass;
        float imp = 0.f;
#pragma unroll
        for (int rr = 0; rr < 4; ++rr) { imp += GW[(rr * 64 + tk) * 32 + j]; if (j > 0) imp += TW[(rr * 64 + tk) * 32 + j - 1]; }
        if (j == 0 || j == n || j == n - 1) imp = 1e9f;
        if (j > n) imp = -1e9f;
        IMP[tk * 32 + j] = imp; }
    __syncthreads();
#pragma unroll
    for (int pass = 0; pass < 4; ++pass) { const int tk = (tid >> 5) + 16 * pass;
        const float mine = IMP[tk * 32 + j]; int rank = 0;
        for (int i = 0; i < 32; ++i) { const float o = IMP[tk * 32 + i]; rank += (o > mine || (o == mine && i < j)) ? 1 : 0; }
        const unsigned long long bal = __ballot(rank < TOPK && j <= n);
        if ((lane & 31) == 0) selmask[(rb + 64 * n + tk) * NG + g] = (unsigned)(bal >> (lane & 32)); }
}
__device__ __forceinline__ void cmp_phase(const Args& a, const bf16* P, bf16* NSA, LAS unsigned char* lds, int G) {
    const bf16* KC = (const bf16*)(a.ws + WS_KCMP); const bf16* VC = (const bf16*)(a.ws + WS_VCMP);
    unsigned* selmask = (unsigned*)(a.ws + WS_SEL);
    for (int u = blockIdx.x; u < NBATCH * NG * NS; u += G) {
        const int i = u & 255, k = u >> 8, aa = i & 15, hi = i >> 4;
        const int nn = (k & 2) ? ((aa + 8) & 15) : aa, n = (k & 1) ? 31 - nn : nn, bg = hi + 16 * (k >> 1);
        cmp_unit(P, NSA, KC, VC, selmask, lds, bg >> 1, bg & 1, n);
    }
}

__global__ void __launch_bounds__(512, 2) mega_fwd(Args a) {
    extern __shared__ __attribute__((aligned(16))) unsigned char lds_raw[];
    LAS unsigned char* lds = (LAS unsigned char*)lds_raw;
    volatile LAS unsigned* MISC = (volatile LAS unsigned*)(lds + MISC_OFF);
    const int tid = tid_opaque(), G = gridDim.x;
    for (int u = tid; u < (LDS_BYTES - 131072) / 4; u += 512) ((LAS unsigned*)(lds + 131072))[u] = 0u;
    __syncthreads();
    unsigned* ctl = (unsigned*)(a.ws + WS_CTL);
    XcdBarrier bar = xcd_barrier_post(ctl + CW_BAR, MISC + 8);
    bf16* P = (bf16*)(a.ws + WS_PROJ);
    bf16* XB = (bf16*)((unsigned char*)a.out + DO_XB);
    bf16* NSA = (bf16*)((unsigned char*)a.out + DO_NSA);
    bf16* KVS = (bf16*)((unsigned char*)a.out + DO_XB);
    float* rs2 = (float*)(a.ws + WS_RS2); float* rs3 = (float*)(a.ws + WS_RS3);

    p0_prologue(a, lds, G);
    xcd_barrier(bar);
    { pg8::Gemm g{XB, (const bf16*)(a.ws + WS_WIN), DM, DM, 128, 256, (long)128 * DM * 2, (long)256 * DM * 2}; pg8::StaticOrder S; S.init(M, NPAD_IN, G, (int)blockIdx.x);
      pg8::EpiRowScale<0> E{P, PP, nullptr};
      pg8::gemm_phase<pg8::EpiRowScale<0>, pg8::StaticOrder, true, true>(lds, g, S, E); }
    xcd_barrier(bar);
    if (G >= 64 && blockIdx.x < 32) {
        for (int kv = 0; kv < 2; ++kv) {
            pg8::Gemm g{P + (kv ? PC_VCR : PC_KCR), (const bf16*)(a.ws + (kv ? WS_WC1V : WS_WC1K)), 16 * PP, CBLK * NDK, PP * 2, 2 * PP * 2, (long)NDK * 2, (long)SEQ * PP * 2};
            pg8::FewUnits S{NBATCH, (int)blockIdx.x - 16 * kv};
            pg8::EpiCompress E{(const float*)(a.ws + WS_CBIAS) + kv * CHID, (const bf16*)(a.ws + WS_W2T) + kv * (NDK * CHID), (bf16*)(a.ws + (kv ? WS_VCMP : WS_KCMP))};
            pg8::gemm_phase<pg8::EpiCompress, pg8::FewUnits, false, true>(lds, g, S, E);
        }
    } else if (G >= 64) {
        attn_phase<1>(a, P, NSA, lds, G - 32, (int)blockIdx.x - 32);
        ret_kv_phase(P, KVS, lds, G - 32, (int)blockIdx.x - 32);
    } else {
        n_compress(a, P, lds, G);
        attn_phase<1>(a, P, NSA, lds, G, (int)blockIdx.x);
        ret_kv_phase(P, KVS, lds, G, (int)blockIdx.x);
    }
    xcd_barrier(bar);
    cmp_phase(a, P, NSA, lds, G);
    ret_scan_phase(KVS, G);
    xcd_barrier(bar);
    attn_phase<0>(a, P, NSA, lds, G, (int)blockIdx.x);
    ret_out_phase(P, KVS, a.in[3], lds, G);
    xcd_barrier(bar);
    { pg8::Gemm g{P + PC_RG, (const bf16*)(a.ws + WS_WRO), PP, 1024, 128, 256, (long)128 * PP * 2, (long)256 * PP * 2}; pg8::StaticOrder S; S.init(M, DM, G, (int)blockIdx.x);
      pg8::EpiMerge<true> E{P + PC_MERGED, P + PC_GA, PP};
      pg8::gemm_phase<pg8::EpiMerge<true>, pg8::StaticOrder, true, true>(lds, g, S, E); }
    { pg8::Gemm g{NSA, (const bf16*)(a.ws + WS_WNO), 512, 512, 128, 256, (long)128 * 512 * 2, (long)256 * 512 * 2}; pg8::StaticOrder S; S.init(M, DM, G, (int)blockIdx.x);
      pg8::EpiMerge<false> E{P + PC_MERGED, P + PC_GB, PP};
      pg8::gemm_phase<pg8::EpiMerge<false>, pg8::StaticOrder, true, true>(lds, g, S, E); }
    xcd_barrier(bar);
    { pg8::Gemm g{P + PC_MERGED, (const bf16*)(a.ws + WS_WOUT), PP, DM, 128, 256, (long)128 * PP * 2, (long)256 * PP * 2}; pg8::StaticOrder S; S.init(M, DM, G, (int)blockIdx.x);
      pg8::EpiResid<true> E{a.in[0], a.out, P + PC_X1B, PP, rs2};
      pg8::gemm_phase<pg8::EpiResid<true>, pg8::StaticOrder, true, true>(lds, g, S, E); }
    xcd_barrier(bar);
    { pg8::Gemm g{P + PC_X1B, (const bf16*)(a.ws + WS_WUP), PP, DM, 128, 256, (long)128 * PP * 2, (long)256 * PP * 2}; pg8::StaticOrder S; S.init(M, NUP, G, (int)blockIdx.x);
      pg8::EpiRowScale<1> E{P + PC_UP, PP, rs2};
      pg8::gemm_phase<pg8::EpiRowScale<1>, pg8::StaticOrder, true, true>(lds, g, S, E); }
    xcd_barrier(bar);
    n_conv(a, P, G);
    xcd_barrier(bar);
    { pg8::Gemm g{P + PC_UP + 128, (const bf16*)(a.ws + WS_WDN), PP, DFF, 128, 512, (long)128 * PP * 2, (long)256 * PP * 2}; pg8::StaticOrder S; S.init(M, DM, G, (int)blockIdx.x);
      pg8::EpiResid<false> E{a.out, a.out, nullptr, 0, rs3};
      pg8::gemm_phase<pg8::EpiResid<false>, pg8::StaticOrder, true, true>(lds, g, S, E); }
    xcd_barrier(bar);
    n_final(a, G);
}

extern "C" void kernel_launch(void* const* d_in, const int* in_sizes, int n_in, void* d_out, int out_size, void* d_ws, size_t ws_size, hipStream_t stream) {
    static int grid = 0;
    if (grid == 0) {
        if (n_in != 21 || out_size != M * DM || ws_size < WS_END) { fprintf(stderr, "kernel_launch: unexpected sizes n_in %d out %d ws %zu (need %zu)\n", n_in, out_size, ws_size, (size_t)WS_END); grid = -1; return; }
        int dev = 0, cus = 0;
        if (hipGetDevice(&dev) != hipSuccess || hipDeviceGetAttribute(&cus, hipDeviceAttributeMultiprocessorCount, dev) != hipSuccess) { grid = -1; return; }
        if (hipFuncSetAttribute((const void*)mega_fwd, hipFuncAttributeMaxDynamicSharedMemorySize, LDS_BYTES) != hipSuccess) { fprintf(stderr, "kernel_launch: hipFuncSetAttribute failed\n"); grid = -1; return; }
        grid = cus;
    }
    if (grid < 0) return;
    (void)hipMemsetAsync((char*)d_ws + WS_CTL, 0, CTL_ZERO_BYTES, stream);
    Args a{};
    for (int i = 0; i < 21; ++i) a.in[i] = (const float*)d_in[i];
    a.out = (float*)d_out; a.ws = (unsigned char*)d_ws;
    hipLaunchKernelGGL(mega_fwd, dim3(grid), dim3(512), LDS_BYTES, stream, a);
}
```

```cpp
#include <hip/hip_runtime.h>
#include <cstdio>
#include <cstdint>
namespace pg8 {
#define PG8_LAS __attribute__((address_space(3)))
typedef unsigned short bf16_t;
typedef short bf16x8 __attribute__((ext_vector_type(8)));
typedef float f32x4 __attribute__((ext_vector_type(4)));
typedef unsigned u32x4 __attribute__((ext_vector_type(4)));
constexpr int BM = 256, BK = 64, HALF = 128, HTB = HALF * BK * 2  , STAGE_BYTES = 8 * HTB, NXCD = 8, WGM = 8;

__host__ __device__ __forceinline__ int lds_byte(int r, int c) { const int st = (r >> 4) * 2 + (c >> 5), rr = r & 15, cc = c & 31, ob = rr * 64 + cc * 2; return st * 1024 + (ob ^ (((ob >> 9) & 1) << 5)); }
__host__ __device__ __forceinline__ void stage_rc(int b, int& R, int& C) { const int st = b / 1024, sb = b % 1024, swz = sb ^ (((sb >> 9) & 1) << 5); R = (st >> 1) * 16 + swz / 64; C = (st & 1) * 32 + (swz % 64) / 2; }
__host__ __device__ __forceinline__ int perm32(int rho) { const int n = rho >> 4, i = rho & 15; return 8 * (i >> 2) + 4 * n + (i & 3); }

struct Unit { int pm, pn; };
struct Gemm { const bf16_t* A; const bf16_t* Bt; int lda, K, ks1, ks2; long hsA, tsA; };

struct StaticOrder {
    int nM, nN, nwg, G, c;
    __host__ __device__ void init(int M, int N, int G_, int c_) { nM = M / BM; nN = N / BM; nwg = nM * nN; G = G_; c = c_; }
    __host__ __device__ bool next(int i, Unit& u) const {
        const long L = (long)i * G + c; if (L >= nwg) return false;
        int wgid = (int)L; { const int q = nwg / NXCD, r = nwg % NXCD, xcd = wgid % NXCD, off = wgid / NXCD; wgid = (xcd < r ? xcd * (q + 1) : r * (q + 1) + (xcd - r) * q) + off; }
        const int nig = WGM * nN, gid = wgid / nig, fm = gid * WGM, gsz = (nM - fm) < WGM ? (nM - fm) : WGM;
        u.pm = fm + ((wgid % nig) % gsz); u.pn = (wgid % nig) / gsz; return true;
    }
    __device__ __forceinline__ void a_ready(const Unit&) const {}
    __device__ __forceinline__ void done(const Unit&) const {}
};

__device__ __forceinline__ unsigned cvt_pk_bf16(float lo, float hi) { unsigned r; asm volatile("v_cvt_pk_bf16_f32 %0, %1, %2" : "=v"(r) : "v"(lo), "v"(hi)); return r; }
__device__ __forceinline__ float bf_lo(unsigned u) { return __builtin_bit_cast(float, u << 16); }
__device__ __forceinline__ float bf_hi(unsigned u) { return __builtin_bit_cast(float, u & 0xffff0000u); }
__device__ __forceinline__ float fsig(float x) { return __builtin_amdgcn_rcpf(1.f + __builtin_amdgcn_exp2f(-1.4426950408889634f * x)); }

template <int MODE> struct EpiRowScale {
    static constexpr bool PERM = true, AFTER_DRAIN = false;
    bf16_t* O; int ldc; const float* rs;
    __device__ __forceinline__ void operator()(const f32x4 (&acc)[2][2][4][2], const Unit& u, int wr, int wc, int fr, int fq) const {
        const int row0 = u.pm * BM + wr * 64 + fr, col0 = u.pn * BM + wc * 32 + 8 * fq;
#pragma unroll
        for (int ai = 0; ai < 2; ++ai)
#pragma unroll
            for (int m = 0; m < 4; ++m) { const int row = row0 + ai * HALF + m * 16; float s = 1.f;
                if (MODE == 1) s = __builtin_amdgcn_rsqf(rs[row] * (1.0f / 1024.0f) + 1e-6f);
                bf16_t* rowp = O + (size_t)row * ldc + col0;
#pragma unroll
                for (int bj = 0; bj < 2; ++bj) { const f32x4 v0 = acc[ai][bj][m][0] * s, v1 = acc[ai][bj][m][1] * s;
                    u32x4 w; w.x = cvt_pk_bf16(v0[0], v0[1]); w.y = cvt_pk_bf16(v0[2], v0[3]); w.z = cvt_pk_bf16(v1[0], v1[1]); w.w = cvt_pk_bf16(v1[2], v1[3]);
                    *(u32x4*)(rowp + bj * HALF) = w; } }
    }
};
template <bool FIRST> struct EpiMerge {
    static constexpr bool PERM = true, AFTER_DRAIN = false;
    bf16_t* O; const bf16_t* G; int ldc;
    __device__ __forceinline__ void operator()(const f32x4 (&acc)[2][2][4][2], const Unit& u, int wr, int wc, int fr, int fq) const {
        const int row0 = u.pm * BM + wr * 64 + fr, col0 = u.pn * BM + wc * 32 + 8 * fq;
#pragma unroll
        for (int ai = 0; ai < 2; ++ai)
#pragma unroll
            for (int m = 0; m < 4; ++m) { const size_t off = (size_t)(row0 + ai * HALF + m * 16) * ldc + col0;
#pragma unroll
                for (int bj = 0; bj < 2; ++bj) { const u32x4 gv = *(const u32x4*)(G + off + bj * HALF);
                    const f32x4 v0 = acc[ai][bj][m][0], v1 = acc[ai][bj][m][1];
                    float r[8];
                    r[0] = fsig(bf_lo(gv.x)) * v0[0]; r[1] = fsig(bf_hi(gv.x)) * v0[1]; r[2] = fsig(bf_lo(gv.y)) * v0[2]; r[3] = fsig(bf_hi(gv.y)) * v0[3];
                    r[4] = fsig(bf_lo(gv.z)) * v1[0]; r[5] = fsig(bf_hi(gv.z)) * v1[1]; r[6] = fsig(bf_lo(gv.w)) * v1[2]; r[7] = fsig(bf_hi(gv.w)) * v1[3];
                    if (!FIRST) { const u32x4 pv = *(const u32x4*)(O + off + bj * HALF);
                        r[0] += bf_lo(pv.x); r[1] += bf_hi(pv.x); r[2] += bf_lo(pv.y); r[3] += bf_hi(pv.y); r[4] += bf_lo(pv.z); r[5] += bf_hi(pv.z); r[6] += bf_lo(pv.w); r[7] += bf_hi(pv.w); }
                    u32x4 w; w.x = cvt_pk_bf16(r[0], r[1]); w.y = cvt_pk_bf16(r[2], r[3]); w.z = cvt_pk_bf16(r[4], r[5]); w.w = cvt_pk_bf16(r[6], r[7]);
                    *(u32x4*)(O + off + bj * HALF) = w; } }
    }
};
template <bool WB16> struct EpiResid {
    static constexpr bool PERM = false, AFTER_DRAIN = false;
    const float* X; float* X1; bf16_t* Xb; int ldb; float* sumsq;
    __device__ __forceinline__ void operator()(const f32x4 (&acc)[2][2][4][2], const Unit& u, int wr, int wc, int fr, int fq) const {
        const int row0 = u.pm * BM + wr * 64 + fr, col0 = u.pn * BM + wc * 32 + 4 * fq;
#pragma unroll
        for (int ai = 0; ai < 2; ++ai)
#pragma unroll
            for (int m = 0; m < 4; ++m) { const int row = row0 + ai * HALF + m * 16; float ss = 0.f;
#pragma unroll
                for (int bj = 0; bj < 2; ++bj)
#pragma unroll
                    for (int n = 0; n < 2; ++n) { const int c = col0 + bj * HALF + n * 16;
                        const f32x4 x = *(const f32x4*)(X + (size_t)row * 1024 + c) + acc[ai][bj][m][n];
                        *(f32x4*)(X1 + (size_t)row * 1024 + c) = x;
                        ss += (x[0] * x[0] + x[1] * x[1]) + (x[2] * x[2] + x[3] * x[3]);
                        if (WB16) { unsigned long long w = (unsigned long long)cvt_pk_bf16(x[0], x[1]) | ((unsigned long long)cvt_pk_bf16(x[2], x[3]) << 32);
                            *(unsigned long long*)(Xb + (size_t)row * ldb + c) = w; } }
                ss += __shfl_xor(ss, 16); ss += __shfl_xor(ss, 32);
                if (fq == 0) atomicAdd(sumsq + row, ss); }
    }
};

__device__ __forceinline__ float gelu_fast(float x) { return x * fsig(1.5957691216057308f * (x + 0.044715f * x * x * x)); }
typedef float f32x16 __attribute__((ext_vector_type(16)));
struct EpiCompress {
    static constexpr bool PERM = false, AFTER_DRAIN = true;
    const float* bias; const bf16_t* w2t; bf16_t* out;
    __device__ __forceinline__ void fused(f32x4 (&acc)[2][2][4][2], const Unit& u, int wr, int wc, int fr, int fq, PG8_LAS unsigned char* lds, int wid, int lane) const {
        const int col0 = wc * 32 + 4 * fq;
#pragma unroll
        for (int bj = 0; bj < 2; ++bj)
#pragma unroll
            for (int n = 0; n < 2; ++n) { const int c = col0 + bj * HALF + n * 16; const f32x4 bv = *(const f32x4*)(bias + c);
#pragma unroll
                for (int ai = 0; ai < 2; ++ai)
#pragma unroll
                    for (int m = 0; m < 4; ++m) { const int r = ai * HALF + wr * 64 + m * 16 + fr; const f32x4 v = acc[ai][bj][m][n] + bv;
                        const unsigned long long w = (unsigned long long)cvt_pk_bf16(gelu_fast(v[0]), gelu_fast(v[1])) | ((unsigned long long)cvt_pk_bf16(gelu_fast(v[2]), gelu_fast(v[3])) << 32);
                        *(PG8_LAS unsigned long long*)(lds + r * 528 + c * 2) = w; asm volatile("" ::: "memory"); } }
        asm volatile("s_waitcnt lgkmcnt(0)" ::: "memory"); __builtin_amdgcn_s_barrier(); asm volatile("" ::: "memory");
        const int q = lane & 31, h = lane >> 5;
        f32x16 o0, o1;
#pragma unroll
        for (int i = 0; i < 16; ++i) { o0[i] = 0.f; o1[i] = 0.f; }
#pragma unroll 4
        for (int ks = 0; ks < 16; ++ks) {
            const bf16x8 a = *(const PG8_LAS bf16x8*)(lds + (32 * wid + q) * 528 + ks * 32 + h * 16);
            const bf16x8 b0 = *(const bf16x8*)(w2t + q * 256 + 16 * ks + 8 * h), b1 = *(const bf16x8*)(w2t + (q + 32) * 256 + 16 * ks + 8 * h);
            o0 = __builtin_amdgcn_mfma_f32_32x32x16_bf16(a, b0, o0, 0, 0, 0); o1 = __builtin_amdgcn_mfma_f32_32x32x16_bf16(a, b1, o1, 0, 0, 0);
        }
#pragma unroll
        for (int i = 0; i < 16; ++i) { const int r = 32 * wid + (i & 3) + 8 * (i >> 2) + 4 * h, gg = r >> 7, c = r & 127;
            if (c < 127) { bf16_t* op = out + ((size_t)(u.pm * 2 + gg) * 128 + c) * 64 + q;
                op[0] = (bf16_t)(cvt_pk_bf16(o0[i], 0.f) & 0xffffu); op[32] = (bf16_t)(cvt_pk_bf16(o1[i], 0.f) & 0xffffu); } }
    }
};
struct FewUnits {
    int n, c;
    __device__ __forceinline__ bool next(int i, Unit& u) const { if (i != 0 || c >= n || c < 0) return false; u.pm = c; u.pn = 0; return true; }
    __device__ __forceinline__ void a_ready(const Unit&) const {}
    __device__ __forceinline__ void done(const Unit&) const {}
};

template <class Epi, class Sched, bool ALIGN_EPI = false, bool SP2 = false>
__device__ __forceinline__ void gemm_phase(PG8_LAS unsigned char* lds, const Gemm g, const Sched& S, const Epi& E) {
    int tid_ = threadIdx.x; asm volatile("" : "+v"(tid_));
    const int tid = tid_, wid = __builtin_amdgcn_readfirstlane(tid >> 6), lane = tid & 63, wr = wid >> 2, wc = wid & 3, fr = lane & 15, fq = lane >> 4;
    const int K = g.K, nt = K / BK;
    unsigned voffA[2], voffB[2];
#pragma unroll
    for (int i = 0; i < 2; ++i) { int R, C; stage_rc(tid * 16 + i * 8192, R, C); const int Rb = Epi::PERM ? ((R & ~31) + perm32(R & 31)) : R;
        voffA[i] = (unsigned)(R * g.lda + C) * 2u; voffB[i] = (unsigned)(Rb * K + C) * 2u; }
    const size_t kstep = (size_t)(BK * 2);
    const size_t hstepB = (size_t)HALF * K * 2, hstepA = (size_t)g.hsA, ks1 = (size_t)g.ks1, ks2 = (size_t)g.ks2;
    const size_t tstepA = (size_t)g.tsA, tstepB = 2 * hstepB;
    const unsigned ldsw = (unsigned)wid * 1024u;
    const int aoff = lds_byte(wr * 64 + fr, fq * 8), boff = lds_byte(wc * 32 + fr, fq * 8);
#define PG8_SA(b, h) (((b) * 2 + (h)) * HTB)
#define PG8_SB(b, h) ((4 + (b) * 2 + (h)) * HTB)
#define PG8_STAGE(bufoff, gbase, voff) do { _Pragma("unroll") for (int _i = 0; _i < 2; ++_i) \
        __builtin_amdgcn_global_load_lds((const unsigned*)((const char*)(gbase) + (voff)[_i]), (PG8_LAS unsigned*)(lds + (bufoff) + ldsw + _i * 8192), 16, 0, 0); } while (0)
#define PG8_LDA(dst, b, h) do { _Pragma("unroll") for (int m = 0; m < 4; ++m) _Pragma("unroll") for (int k = 0; k < 2; ++k) dst[m][k] = *(const PG8_LAS bf16x8*)(lds + PG8_SA(b, h) + aoff + m * 2048 + k * 1024); } while (0)
#define PG8_LDB(dst, b, h) do { _Pragma("unroll") for (int n = 0; n < 2; ++n) _Pragma("unroll") for (int k = 0; k < 2; ++k) dst[n][k] = *(const PG8_LAS bf16x8*)(lds + PG8_SB(b, h) + boff + n * 2048 + k * 1024); } while (0)
#define PG8_MMA(ai, bj, At, Bt) do { __builtin_amdgcn_s_setprio(1); _Pragma("unroll") for (int m = 0; m < 4; ++m) _Pragma("unroll") for (int n = 0; n < 2; ++n) _Pragma("unroll") for (int k = 0; k < 2; ++k) \
        acc[ai][bj][m][n] = __builtin_amdgcn_mfma_f32_16x16x32_bf16(Bt[n][k], At[m][k], acc[ai][bj][m][n], 0, 0, 0); __builtin_amdgcn_s_setprio(0); } while (0)
#define PG8_WAIT_V(n) asm volatile("s_waitcnt vmcnt(" #n ")" ::: "memory")
#define PG8_WAIT_L(n) asm volatile("s_waitcnt lgkmcnt(" #n ")" ::: "memory")
#define PG8_BAR __builtin_amdgcn_s_barrier()
#define PG8_SCHED __builtin_amdgcn_sched_barrier(0)
    Unit cur, nxt; int ui = 0;
    if (!S.next(0, cur)) return;
    f32x4 acc[2][2][4][2];
#pragma unroll
    for (int a = 0; a < 2; ++a)
#pragma unroll
        for (int b = 0; b < 2; ++b)
#pragma unroll
            for (int m = 0; m < 4; ++m)
#pragma unroll
                for (int n = 0; n < 2; ++n) acc[a][b][m][n] = (f32x4){0.f, 0.f, 0.f, 0.f};
    bf16x8 At[4][2], B0[2][2], B1[2][2];
    const char* cA = (const char*)g.A + (size_t)cur.pm * tstepA; const char* cB = (const char*)g.Bt + (size_t)cur.pn * tstepB;
    S.a_ready(cur);
    if constexpr (SP2) {
        PG8_STAGE(PG8_SB(0, 0), cB, voffB); PG8_STAGE(PG8_SB(0, 1), cB + hstepB, voffB); PG8_STAGE(PG8_SA(0, 0), cA, voffA); PG8_STAGE(PG8_SA(0, 1), cA + hstepA, voffA);
        if (wr == 1) PG8_BAR;
        PG8_WAIT_V(2); PG8_BAR;
        PG8_STAGE(PG8_SB(1, 0), cB + kstep, voffB); PG8_STAGE(PG8_SA(1, 0), cA + ks1, voffA); PG8_STAGE(PG8_SB(1, 1), cB + hstepB + kstep, voffB);
        PG8_WAIT_V(6); PG8_BAR;
    } else {
        PG8_STAGE(PG8_SB(0, 0), cB, voffB); PG8_STAGE(PG8_SA(0, 0), cA, voffA); PG8_STAGE(PG8_SB(0, 1), cB + hstepB, voffB); PG8_STAGE(PG8_SA(0, 1), cA + hstepA, voffA);
        if (wr == 1) PG8_BAR;
        PG8_WAIT_V(4); PG8_BAR;
        PG8_STAGE(PG8_SB(1, 0), cB + kstep, voffB); PG8_STAGE(PG8_SA(1, 0), cA + ks1, voffA); PG8_STAGE(PG8_SB(1, 1), cB + hstepB + kstep, voffB);
        PG8_WAIT_V(6); PG8_BAR;
    }
    for (;;) {
        const bool has_next = S.next(ui + 1, nxt);
        const char* nA = has_next ? (const char*)g.A + (size_t)nxt.pm * tstepA : cA; const char* nB = has_next ? (const char*)g.Bt + (size_t)nxt.pn * tstepB : cB;
        for (int t = 0; t < nt; t += 2) {
            const bool last = (t == nt - 2);
            const char* a1 = cA + (size_t)(t >> 1) * ks2 + ks1;
            const char* a2 = last ? nA : cA + (size_t)((t + 2) >> 1) * ks2; const char* b2 = last ? nB : cB + (size_t)(t + 2) * kstep;
            const char* a3 = a2 + ks1; const char* b3 = b2 + kstep;
            if (last && has_next) S.a_ready(nxt);
            if constexpr (SP2) {
            PG8_LDB(B0, 0, 0); PG8_LDB(B1, 0, 1); PG8_SCHED; PG8_LDA(At, 0, 0); PG8_STAGE(PG8_SA(1, 1), a1 + hstepA, voffA);
            PG8_WAIT_V(8); PG8_WAIT_L(0); PG8_BAR; PG8_MMA(0, 0, At, B0); PG8_MMA(0, 1, At, B1); PG8_BAR; PG8_SCHED;
            PG8_LDA(At, 0, 1); PG8_STAGE(PG8_SB(0, 0), b2, voffB); PG8_STAGE(PG8_SB(0, 1), b2 + hstepB, voffB); PG8_STAGE(PG8_SA(0, 0), a2, voffA);
            PG8_WAIT_V(8); PG8_WAIT_L(0); PG8_BAR; PG8_MMA(1, 0, At, B0); PG8_MMA(1, 1, At, B1); PG8_BAR; PG8_SCHED;
            PG8_LDB(B0, 1, 0); PG8_LDB(B1, 1, 1); PG8_SCHED; PG8_LDA(At, 1, 0); PG8_STAGE(PG8_SA(0, 1), a2 + hstepA, voffA);
            PG8_WAIT_V(8); PG8_WAIT_L(0); PG8_BAR; PG8_MMA(0, 0, At, B0); PG8_MMA(0, 1, At, B1); PG8_BAR; PG8_SCHED;
            PG8_LDA(At, 1, 1); PG8_STAGE(PG8_SB(1, 0), b3, voffB); PG8_STAGE(PG8_SB(1, 1), b3 + hstepB, voffB); PG8_STAGE(PG8_SA(1, 0), a3, voffA);
            PG8_WAIT_V(8); PG8_WAIT_L(0); PG8_BAR; PG8_MMA(1, 0, At, B0); PG8_MMA(1, 1, At, B1); PG8_BAR; PG8_SCHED;
            } else {
            PG8_LDB(B0, 0, 0); PG8_SCHED; PG8_LDA(At, 0, 0); PG8_STAGE(PG8_SA(1, 1), a1 + hstepA, voffA);
            PG8_WAIT_L(8); PG8_BAR; PG8_WAIT_L(0); PG8_MMA(0, 0, At, B0); PG8_BAR; PG8_SCHED;
            PG8_LDB(B1, 0, 1); PG8_STAGE(PG8_SB(0, 0), b2, voffB);
            PG8_BAR; PG8_WAIT_L(0); PG8_MMA(0, 1, At, B1); PG8_BAR;
            PG8_LDA(At, 0, 1); PG8_STAGE(PG8_SA(0, 0), a2, voffA);
            PG8_BAR; PG8_WAIT_L(0); PG8_MMA(1, 0, At, B0); PG8_BAR; PG8_SCHED;
            PG8_STAGE(PG8_SB(0, 1), b2 + hstepB, voffB);
            PG8_WAIT_V(6); PG8_BAR; PG8_MMA(1, 1, At, B1); PG8_BAR;
            PG8_LDB(B0, 1, 0); PG8_SCHED; PG8_LDA(At, 1, 0); PG8_STAGE(PG8_SA(0, 1), a2 + hstepA, voffA);
            PG8_WAIT_L(8); PG8_BAR; PG8_WAIT_L(0); PG8_MMA(0, 0, At, B0); PG8_BAR; PG8_SCHED;
            PG8_LDB(B1, 1, 1); PG8_STAGE(PG8_SB(1, 0), b3, voffB);
            PG8_BAR; PG8_WAIT_L(0); PG8_MMA(0, 1, At, B1); PG8_BAR;
            PG8_LDA(At, 1, 1); PG8_STAGE(PG8_SA(1, 0), a3, voffA);
            PG8_BAR; PG8_WAIT_L(0); PG8_MMA(1, 0, At, B0); PG8_BAR; PG8_SCHED;
            PG8_STAGE(PG8_SB(1, 1), b3 + hstepB, voffB);
            PG8_WAIT_V(6); PG8_BAR; PG8_MMA(1, 1, At, B1); PG8_BAR;
            }
        }
        if constexpr (ALIGN_EPI) { if (wr == 0) PG8_BAR; }
        if constexpr (!Epi::AFTER_DRAIN) { E(acc, cur, wr, wc, fr, fq); S.done(cur); }
        if (!has_next) break;
#pragma unroll
        for (int a = 0; a < 2; ++a)
#pragma unroll
            for (int b = 0; b < 2; ++b)
#pragma unroll
                for (int m = 0; m < 4; ++m)
#pragma unroll
                    for (int n = 0; n < 2; ++n) acc[a][b][m][n] = (f32x4){0.f, 0.f, 0.f, 0.f};
        cur = nxt; cA = nA; cB = nB; ++ui;
        if constexpr (ALIGN_EPI) { if (wr == 1) PG8_BAR; }
    }
    PG8_WAIT_V(0);
    if constexpr (!ALIGN_EPI) { if (wr == 0) PG8_BAR; }
    PG8_BAR;
    if constexpr (Epi::AFTER_DRAIN) { E.fused(acc, cur, wr, wc, fr, fq, lds, wid, lane); S.done(cur); }
#undef PG8_SA
#undef PG8_SB
#undef PG8_STAGE
#undef PG8_LDA
#undef PG8_LDB
#undef PG8_MMA
#undef PG8_WAIT_V
#undef PG8_WAIT_L
#undef PG8_BAR
#undef PG8_SCHED
}
}
constexpr int M = 32768, DM = 1024, SEQ = 2048, NBATCH = 16;
constexpr int RH = 4, RDK = 128, RDV = 256;
constexpr int NG = 2, NR = 4, NDK = 64, CBLK = 32, CSTR = 16, CHID = 256, TOPK = 8, WIN = 512;
constexpr int DFF = 2816, NIN = 6424;
constexpr int NC = SEQ / CSTR - 1;
constexpr int NS = SEQ / 64;
constexpr float EPS = 1e-6f;
constexpr int C_GATE = 4352, C_GA = 4376, C_GB = 5400;
constexpr int PP = 6656;
constexpr int PC_RQ = 0, PC_RK = 512, PC_RV = 1024, PC_RG = 2048, PC_NQ = 3072, PC_KCR = 3584, PC_VCR = 3712, PC_KS = 3840, PC_VS = 3968,
              PC_KW = 4096, PC_VW = 4224, PC_GA = 4352, PC_GB = 5376, PC_GATE = 6400;
constexpr int PC_MERGED = 1024, PC_X1B = 0, PC_UP = 1024;
constexpr int NPAD_IN = 6656, NUP = 2 * DFF;
constexpr size_t MiB = 1u << 20;
constexpr size_t WS_CTL = 0, CTL_ZERO_BYTES = 1 * MiB;
constexpr size_t WS_RS2 = 256 * 1024, WS_RS3 = 512 * 1024;
constexpr size_t WS_WIN = 1 * MiB, WS_WUP = 14 * MiB, WS_WDN = 25 * MiB, WS_WRO = 31 * MiB, WS_WNO = 33 * MiB, WS_WOUT = 34 * MiB;
constexpr size_t WS_KCMP = 39 * MiB, WS_VCMP = 41 * MiB, WS_SEL = 43 * MiB;
constexpr size_t WS_WC1K = 36 * MiB, WS_WC1V = 37 * MiB, WS_W2T = 38 * MiB, WS_CBIAS = 38 * MiB + 128 * 1024;
constexpr size_t WS_PROJ = 48 * MiB;
constexpr size_t WS_END = WS_PROJ + (size_t)(M + 32) * PP * 2;
static_assert(WS_END <= 512 * MiB, "d_ws map");
constexpr int CW_BAR = 4096;
constexpr size_t DO_XB = 0, DO_NSA = 64 * MiB;

constexpr int LDS_BYTES = 163840;
constexpr int MISC_OFF = 163840 - 512;

typedef unsigned short bf16;
typedef unsigned v4u __attribute__((ext_vector_type(4)));
typedef float f32x4 __attribute__((ext_vector_type(4)));
#define GAS __attribute__((address_space(1)))
#define LDS_WAIT() asm volatile("s_waitcnt lgkmcnt(0)" ::: "memory")
__device__ __forceinline__ unsigned f2bf(float f) { unsigned u = __builtin_bit_cast(unsigned, f); return (u + 0x7fffu + ((u >> 16) & 1u)) >> 16; }
__device__ __forceinline__ unsigned pk2(float lo, float hi) { return f2bf(lo) | (f2bf(hi) << 16); }
__device__ __forceinline__ float bf2f(bf16 v) { return __builtin_bit_cast(float, (unsigned)v << 16); }
__device__ __forceinline__ float wave_sum(float v) {
#pragma unroll
    for (int o = 1; o < 64; o <<= 1) v += __shfl_xor(v, o);
    return v;
}
__device__ __forceinline__ float wave_max(float v) {
#pragma unroll
    for (int o = 1; o < 64; o <<= 1) v = fmaxf(v, __shfl_xor(v, o));
    return v;
}
__device__ __forceinline__ float gelu_tanh(float x) { const float c = 0.7978845608028654f; return 0.5f * x * (1.f + tanhf(c * (x + 0.044715f * x * x * x))); }
__device__ __forceinline__ float sigmoidf_(float x) { return 1.f / (1.f + expf(-x)); }

__device__ __forceinline__ int tid_opaque() { int t = threadIdx.x; asm volatile("" : "+v"(t)); return t; }
#define XB_TMO      128
#define XB_XCNT(j)  (256  + 64 * (j))
#define XB_XSUB(j)  (1280 + 64 * (j))
#define XB_XGEN(j)  (2304 + 64 * (j))
#define XB_TOP      3328
#define XB_TOPGEN   3392
#define XCD_BAR_WORDS 3456
#define XB_SPIN_CAP (1u << 21)
#define LAS __attribute__((address_space(3)))

__device__ __forceinline__ unsigned xb_ld(unsigned* p)              { return __hip_atomic_load(p, __ATOMIC_RELAXED, __HIP_MEMORY_SCOPE_AGENT); }
__device__ __forceinline__ unsigned xb_add(unsigned* p, unsigned v) { return __hip_atomic_fetch_add(p, v, __ATOMIC_RELAXED, __HIP_MEMORY_SCOPE_AGENT); }
__device__ __forceinline__ unsigned xb_xcc_id() { return (unsigned)__builtin_amdgcn_s_getreg((3 << 11) | 20) & 0xFu; }
#define XB_SPIN(cond, bar) do { unsigned _sp = 0; while (cond) { __builtin_amdgcn_s_sleep(1); \
    if ((++_sp & 255u) == 0u) { if (xb_ld(&(bar)[XB_TMO])) break; if (_sp > XB_SPIN_CAP) { atomicAdd(&(bar)[XB_TMO], 1u); break; } } } } while (0)

struct XcdBarrier {
    unsigned* bar; unsigned x;
    volatile LAS unsigned* st;
};

__device__ __forceinline__ XcdBarrier xcd_barrier_post(unsigned* bar, volatile LAS unsigned* st) {
    XcdBarrier b; b.bar = bar; b.x = xb_xcc_id(); b.st = st;
    if (threadIdx.x == 0) (void)xb_add(&bar[XB_XCNT(b.x)], 1u);
    return b;
}
__device__ __forceinline__ void xcd_barrier_complete(unsigned* bar, unsigned x, unsigned& nloc, unsigned& nx) {
    const unsigned G = gridDim.x * gridDim.y * gridDim.z;
    unsigned sum, cnt, mine, sp = 0u;
    for (;;) {
        sum = 0u; cnt = 0u; mine = 0u;
#pragma unroll
        for (unsigned j = 0; j < 16; ++j) { const unsigned c = xb_ld(&bar[XB_XCNT(j)]); sum += c; cnt += (c > 0u) ? 1u : 0u; mine = (j == x) ? c : mine; }
        if (sum == G) break;
        __builtin_amdgcn_s_sleep(1);
        if ((++sp & 255u) == 0u) { if (xb_ld(&bar[XB_TMO])) break; if (sp > XB_SPIN_CAP) { atomicAdd(&bar[XB_TMO], 1u); break; } }
    }
    nloc = mine > 0u ? mine : 1u; nx = cnt > 0u ? cnt : 1u;
}

__device__ __forceinline__ void xcd_barrier(const XcdBarrier& b) {
    asm volatile("s_waitcnt vmcnt(0)" ::: "memory");
    __syncthreads();
    if (threadIdx.x == 0) {
        unsigned* bar = b.bar;
        __builtin_amdgcn_s_waitcnt(0);
        unsigned nloc = b.st[0], nx = b.st[1];
        if (nloc == 0u) { xcd_barrier_complete(bar, b.x, nloc, nx); b.st[0] = nloc; b.st[1] = nx; }
        const unsigned old = xb_add(&bar[XB_XSUB(b.x)], 1u);
        const unsigned gen = old / nloc;
        if (old + 1u == (gen + 1u) * nloc) {
            __builtin_amdgcn_fence(__ATOMIC_RELEASE, "agent");
            asm volatile("s_waitcnt vmcnt(0)" ::: "memory");
            const unsigned og = xb_add(&bar[XB_TOP], 1u);
            const unsigned tg = og / nx;
            if (og + 1u == (tg + 1u) * nx) xb_add(&bar[XB_TOPGEN], 1u);
            else XB_SPIN(xb_ld(&bar[XB_TOPGEN]) == tg, bar);
            __builtin_amdgcn_fence(__ATOMIC_ACQUIRE, "agent");
            xb_add(&bar[XB_XGEN(b.x)], 1u);
            asm volatile("s_waitcnt vmcnt(0)" ::: "memory");
        } else {
            XB_SPIN(xb_ld(&bar[XB_XGEN(b.x)]) == gen, bar);
            __builtin_amdgcn_fence(__ATOMIC_ACQUIRE, "agent");
            asm volatile("s_waitcnt vmcnt(0)" ::: "memory");
        }
    }
    __syncthreads();
}

struct Args { const float* in[21]; float* out; unsigned char* ws; };
__device__ __forceinline__ unsigned cvtpk(float lo, float hi);

struct MapIn { __device__ __forceinline__ int operator()(int n) const { return n < 4352 ? n : (n < 6400 ? n + 24 : (n < 6424 ? n - 2048 : -1)); } };
struct MapUp { __device__ __forceinline__ int operator()(int n) const { const int pn = n >> 8, j = n & 255; return j < 128 ? 128 * pn + j : DFF + 128 * pn + (j - 128); } };
struct MapId { __device__ __forceinline__ int operator()(int n) const { return n; } };
template <class MAP>
__device__ __forceinline__ void p0_transpose_item(const float* W, int K, int Nsrc, int nblk, bf16* WT, const float* ksc, LAS float* scr, int item, int lane, MAP map) {
    const int kb = item / nblk, nb = item % nblk, k0 = 64 * kb, n0 = 32 * nb;
    const int sc = map(n0 + (lane & 31));
#pragma unroll 8
    for (int i = 0; i < 32; ++i) { const int kk = 2 * i + (lane >> 5); float v = 0.f; if (sc >= 0) { v = W[(size_t)(k0 + kk) * Nsrc + sc]; if (ksc) v *= ksc[k0 + kk]; } scr[kk * 33 + (lane & 31)] = v; }
    LDS_WAIT(); asm volatile("" ::: "memory");
    const int c = lane & 7;
#pragma unroll
    for (int j = 0; j < 4; ++j) { const int n = (lane >> 3) + 8 * j; const LAS float* s = scr + (8 * c) * 33 + n;
        v4u o; o.x = pk2(s[0 * 33], s[1 * 33]); o.y = pk2(s[2 * 33], s[3 * 33]); o.z = pk2(s[4 * 33], s[5 * 33]); o.w = pk2(s[6 * 33], s[7 * 33]);
        *(GAS v4u*)(WT + (size_t)(n0 + n) * K + k0 + 8 * c) = o; }
    LDS_WAIT(); asm volatile("" ::: "memory");
}
__device__ __forceinline__ void p0_prologue(const Args& a, LAS unsigned char* lds, int G) {
    const int tid = tid_opaque(), lane = tid & 63, wave = tid >> 6;
    LAS float* scr = (LAS float*)(lds + wave * 16384);
    const int gw = blockIdx.x * 8 + wave, NGW = G * 8;
    unsigned char* ws = a.ws;
    constexpr int I_IN = 16 * (NPAD_IN / 32), I_UP = 16 * (NUP / 32), I_DN = (DFF / 64) * 32, I_RO = 16 * 32, I_NO = 8 * 32, I_OUT = 16 * 32;
    constexpr int NITEMS = I_IN + I_UP + I_DN + I_RO + I_NO + I_OUT;
    for (int it = gw; it < NITEMS; it += NGW) {
        int r = it;
        if (r < I_IN) { p0_transpose_item(a.in[2], DM, NIN, NPAD_IN / 32, (bf16*)(ws + WS_WIN), a.in[1], scr, r, lane, MapIn()); continue; } r -= I_IN;
        if (r < I_UP) { p0_transpose_item(a.in[16], DM, NUP, NUP / 32, (bf16*)(ws + WS_WUP), a.in[15], scr, r, lane, MapUp()); continue; } r -= I_UP;
        if (r < I_DN) { p0_transpose_item(a.in[19], DFF, DM, 32, (bf16*)(ws + WS_WDN), nullptr, scr, r, lane, MapId()); continue; } r -= I_DN;
        if (r < I_RO) { p0_transpose_item(a.in[12], 1024, DM, 32, (bf16*)(ws + WS_WRO), nullptr, scr, r, lane, MapId()); continue; } r -= I_RO;
        if (r < I_NO) { p0_transpose_item(a.in[13], 512, DM, 32, (bf16*)(ws + WS_WNO), nullptr, scr, r, lane, MapId()); continue; } r -= I_NO;
        p0_transpose_item(a.in[14], DM, DM, 32, (bf16*)(ws + WS_WOUT), nullptr, scr, r, lane, MapId());
    }
    for (int it = gw; it < 2 * 256; it += NGW) { const int kv = it >> 8, r = it & 255;
        p0_transpose_item(a.in[kv ? 9 : 5], 2048, CHID, CHID / 32, (bf16*)(ws + (kv ? WS_WC1V : WS_WC1K)), nullptr, scr, r, lane, MapId()); }
    for (int it = gw; it < 2 * 8; it += NGW) { const int kv = it >> 3, r = it & 7;
        p0_transpose_item(a.in[kv ? 11 : 7], CHID, NDK, 2, (bf16*)(ws + WS_W2T) + kv * (NDK * CHID), nullptr, scr, r, lane, MapId()); }
    for (int it = gw; it < 2 * 4; it += NGW) { const int kv = it >> 2, j = (it & 3) * 64 + lane;
        const float* pos = a.in[kv ? 8 : 4]; const float* w1 = a.in[kv ? 9 : 5]; const float* b1 = a.in[kv ? 10 : 6];
        float acc = b1[j];
        for (int k = 0; k < CBLK * NDK; ++k) acc += pos[k] * w1[(size_t)k * CHID + j];
        ((float*)(ws + WS_CBIAS))[kv * CHID + j] = acc; }
    bf16* XB = (bf16*)((unsigned char*)a.out + DO_XB);
    for (int m0 = gw * 4; m0 < M; m0 += NGW * 4) {
        f32x4 v[4][4];
#pragma unroll
        for (int r = 0; r < 4; ++r) { const GAS f32x4* xr = (const GAS f32x4*)(a.in[0] + (size_t)(m0 + r) * DM) + lane;
#pragma unroll
            for (int j = 0; j < 4; ++j) v[r][j] = xr[64 * j]; }
#pragma unroll
        for (int r = 0; r < 4; ++r) { float s = 0.f;
#pragma unroll
            for (int j = 0; j < 4; ++j) s += (v[r][j].x * v[r][j].x + v[r][j].y * v[r][j].y) + (v[r][j].z * v[r][j].z + v[r][j].w * v[r][j].w);
            const float rstd = rsqrtf(wave_sum(s) * (1.f / DM) + EPS);
            GAS unsigned long long* o8 = (GAS unsigned long long*)(XB + (size_t)(m0 + r) * DM) + lane;
#pragma unroll
            for (int j = 0; j < 4; ++j) o8[64 * j] = (unsigned long long)pk2(v[r][j].x * rstd, v[r][j].y * rstd) | ((unsigned long long)pk2(v[r][j].z * rstd, v[r][j].w * rstd) << 32); }
    }
}

__device__ __forceinline__ float ldp(const bf16* P, size_t row, int col) { return bf2f(P[row * PP + col]); }

__device__ __forceinline__ void n_compress(const Args& a, const bf16* P, LAS unsigned char* lds, int G) {
    const int tid = tid_opaque(), sub = tid >> 8, lt = tid & 255;
    LAS float* bv = (LAS float*)(lds + sub * 16384); LAS float* hid = bv + CBLK * NDK;
    for (int it = blockIdx.x; it < NBATCH * NC * 2; it += G) {
        const int u = it * 2 + sub, kv = u & 1, g = (u >> 1) & 1, c = (u >> 2) % NC, b = (u >> 2) / NC;
        const float* pos = a.in[kv ? 8 : 4]; const float* w1 = a.in[kv ? 9 : 5]; const float* b1 = a.in[kv ? 10 : 6]; const float* w2 = a.in[kv ? 11 : 7];
        bf16* out = (bf16*)(a.ws + (kv ? WS_VCMP : WS_KCMP));
        const int colbase = (kv ? PC_VCR : PC_KCR) + g * NDK;
        __syncthreads();
        for (int i = lt; i < CBLK * NDK; i += 256) { const int ii = i >> 6, d = i & 63; bv[i] = ldp(P, (size_t)b * SEQ + c * CSTR + ii, colbase + d) + pos[i]; }
        __syncthreads();
        float acc = b1[lt];
        for (int k = 0; k < CBLK * NDK; ++k) acc += bv[k] * w1[(size_t)k * CHID + lt];
        hid[lt] = gelu_tanh(acc);
        __syncthreads();
        if (lt < NDK) { float o = 0.f; for (int j = 0; j < CHID; ++j) o += hid[j] * w2[j * NDK + lt]; out[(((size_t)b * NG + g) * 128 + c) * NDK + lt] = (bf16)f2bf(o); }
    }
}

template <int MODE>
__device__ __forceinline__ void n_attn(const Args& a, const bf16* P, bf16* NSA, LAS unsigned char* lds, int G) {
    const int tid = tid_opaque(), sub = tid >> 8, r = (tid >> 6) & 3, lane = tid & 63;
    LAS float* qs = (LAS float*)(lds + sub * 16384) + r * 64;
    LAS float* scs = (LAS float*)(lds + sub * 16384 + 1024) + r * 576;
    LAS int* blks = (LAS int*)(lds + sub * 16384 + 1024 + 9216) + r * 12;
    const unsigned* selmask = (const unsigned*)(a.ws + WS_SEL);
    const int kcol = MODE ? PC_KW : PC_KS, vcol = MODE ? PC_VW : PC_VS;
    for (int it = blockIdx.x; it < M; it += G) {
        const int u = it * 2 + sub, g = u & 1, t = u >> 1, tl = t & (SEQ - 1), h = g * NR + r, cur = tl >> 6;
        const size_t rb = (size_t)(t - tl);
        const float slope = exp2f(-(float)(h + 1));
        __syncthreads();
        qs[lane] = ldp(P, t, PC_NQ + h * NDK + lane);
        unsigned mask;
        if (MODE) { const int lo = (tl - (WIN - 1)) > 0 ? ((tl - (WIN - 1)) >> 6) : 0; mask = 0u; for (int j = lo; j <= cur; ++j) mask |= 1u << j; }
        else mask = selmask[t * NG + g];
        int nb = 0;
        for (int j = 0; j < NS; ++j) if ((mask >> j) & 1u) { if (lane == 0) blks[nb] = j; ++nb; }
        __syncthreads();
        float m = -1e30f;
        for (int b = 0; b < nb; ++b) {
            const int s = blks[b] * 64 + lane; const int d = tl - s;
            const bool valid = d >= 0 && (!MODE || d < WIN);
            float sc = -1e30f;
            if (valid) { float dot = 0.f; const bf16* kr = P + (rb + s) * PP + kcol + g * NDK; for (int x = 0; x < NDK; ++x) dot += qs[x] * bf2f(kr[x]); sc = dot * 0.125f - slope * (float)d; }
            scs[b * 64 + lane] = sc; m = fmaxf(m, sc);
        }
        m = wave_max(m);
        float sum = 0.f;
        for (int b = 0; b < nb; ++b) { const float sc = scs[b * 64 + lane]; const float p = sc > -1e29f ? expf(sc - m) : 0.f; scs[b * 64 + lane] = p; sum += p; }
        sum = wave_sum(sum);
        __syncthreads();
        float o = 0.f;
        for (int b = 0; b < nb; ++b) {
            const int s0 = blks[b] * 64;
            for (int i = 0; i < 64; ++i) { const float p = scs[b * 64 + i]; if (p != 0.f) o += p * ldp(P, rb + s0 + i, vcol + g * NDK + lane); }
        }
        const float gate = sigmoidf_(ldp(P, t, PC_GATE + (MODE ? 16 : 8) + h));
        const size_t oi = (size_t)t * 512 + h * NDK + lane;
        float res = gate * o / sum;
        if (!MODE) res += bf2f(NSA[oi]);
        NSA[oi] = (bf16)f2bf(res);
    }
}

__device__ __forceinline__ void n_cmp(const Args& a, const bf16* P, bf16* NSA, LAS unsigned char* lds, int G) {
    const int tid = tid_opaque(), w = tid >> 6, lane = tid & 63;
    LAS float* qs = (LAS float*)(lds + w * 4096);
    LAS float* ps = qs + 256;
    const float* kcmp = (const float*)(a.ws + WS_KCMP); const float* vcmp = (const float*)(a.ws + WS_VCMP);
    unsigned* selmask = (unsigned*)(a.ws + WS_SEL);
    for (int it = blockIdx.x; it < M * NG / 8; it += G) {
        const int u = it * 8 + w, g = u & 1, t = u >> 1, tl = t & (SEQ - 1), b = t >> 11;
        const float* kc = kcmp + ((size_t)b * NG + g) * NC * NDK; const float* vc = vcmp + ((size_t)b * NG + g) * NC * NDK;
        __syncthreads();
        for (int r = 0; r < NR; ++r) qs[r * 64 + lane] = ldp(P, t, PC_NQ + (g * NR + r) * NDK + lane);
        __syncthreads();
        for (int r = 0; r < NR; ++r) {
            const int h = g * NR + r; const float slope = exp2f(-(float)(h + 1));
            float sc[2]; bool val[2];
#pragma unroll
            for (int q = 0; q < 2; ++q) {
                const int c = lane + 64 * q; sc[q] = -1e30f; val[q] = false;
                if (c < NC) {
                    float d = 0.f; const float* kr = kc + (size_t)c * NDK;
                    for (int x = 0; x < NDK; ++x) d += qs[r * 64 + x] * kr[x];
                    const int dc = tl - (c * CSTR + CBLK - 1);
                    if (dc >= 0) { val[q] = true; sc[q] = d * 0.125f - slope * (float)dc; }
                }
            }
            const float mx = wave_max(fmaxf(sc[0], sc[1]));
            float p0 = val[0] ? expf(sc[0] - mx) : 0.f, p1 = val[1] ? expf(sc[1] - mx) : 0.f;
            const float sum = wave_sum(p0 + p1);
            const float inv = sum > 0.f ? 1.f / sum : 0.f;
            ps[r * 128 + lane] = p0 * inv; ps[r * 128 + 64 + lane] = p1 * inv;
        }
        __syncthreads();
        for (int r = 0; r < NR; ++r) {
            const int h = g * NR + r;
            float o = 0.f;
            for (int c = 0; c < NC; ++c) o += ps[r * 128 + c] * vc[(size_t)c * NDK + lane];
            const float gate = sigmoidf_(ldp(P, t, PC_GATE + h));
            const size_t oi = (size_t)t * 512 + h * NDK + lane;
            NSA[oi] = (bf16)f2bf(bf2f(NSA[oi]) + gate * o);
        }
        float imp = 0.f; const int j = lane & 31;
        for (int r = 0; r < NR; ++r)
            for (int c = 4 * j - 1; c <= 4 * j + 3; ++c) if (c >= 0 && c < NC) imp += ps[r * 128 + c];
        const int cur = tl >> 6;
        if (j == 0 || j == cur || j == cur - 1) imp = 1e9f;
        if (j > cur) imp = -1e9f;
        int rank = 0;
        for (int i = 0; i < NS; ++i) { const float o = __shfl(imp, i); rank += (o > imp || (o == imp && i < j)) ? 1 : 0; }
        const unsigned long long bal = __ballot(rank < TOPK && lane < 32 && j <= cur);
        if (lane == 0) selmask[t * NG + g] = (unsigned)bal;
    }
}

__device__ __forceinline__ void n_retention(const Args& a, bf16* P, LAS unsigned char* lds, int G) {
    const int tid = tid_opaque(), sub = tid >> 8, lt = tid & 255;
    LAS float* Qs = (LAS float*)(lds + sub * 49152);
    LAS float* Ks = Qs + 32 * 129;
    LAS float* Vs = Ks + 16 * 129;
    LAS float* Ps = Vs + 16 * 256;
    const float* gn_g = a.in[3];
    for (int p = blockIdx.x; p < NBATCH * 2 * 64; p += G) {
        const int k_ = p >> 8, qt0 = p & 63, qt = (k_ & 1) ? 63 - qt0 : qt0, idx = p >> 6, hp = idx & 1, b = idx >> 1, h = hp * 2 + sub;
        const size_t rb = (size_t)b * SEQ;
        const float lg = log1pf(-exp2f(-5.0f - (float)h));
        const float scale = 0.08838834764831845f;
        __syncthreads();
        for (int i = lt; i < 32 * 128; i += 256) { const int r = i >> 7, c = i & 127; Qs[r * 129 + c] = ldp(P, rb + qt * 32 + r, PC_RQ + h * RDK + c); }
        float acc[32];
#pragma unroll
        for (int e = 0; e < 32; ++e) acc[e] = 0.f;
        const int pi = lt >> 3, pj0 = (lt & 7) * 2;
        for (int kt = 0; kt <= 2 * qt + 1; ++kt) {
            __syncthreads();
            for (int i = lt; i < 16 * 128; i += 256) { const int r = i >> 7, c = i & 127; Ks[r * 129 + c] = ldp(P, rb + kt * 16 + r, PC_RK + h * RDK + c); }
            for (int i = lt; i < 16 * 256; i += 256) { const int r = i >> 8, c = i & 255; Vs[r * 256 + c] = ldp(P, rb + kt * 16 + r, PC_RV + h * RDV + c); }
            __syncthreads();
#pragma unroll
            for (int jj = 0; jj < 2; ++jj) {
                const int j = pj0 + jj; float d = 0.f;
                for (int c = 0; c < 128; ++c) d += Qs[pi * 129 + c] * Ks[j * 129 + c];
                const int diff = (qt * 32 + pi) - (kt * 16 + j);
                Ps[pi * 17 + j] = diff >= 0 ? d * scale * expf(lg * (float)diff) : 0.f;
            }
            __syncthreads();
            for (int j = 0; j < 16; ++j) {
                const float pv = Ps[pi * 17 + j];
#pragma unroll
                for (int e = 0; e < 32; ++e) acc[e] += pv * Vs[j * 256 + (lt & 7) + 8 * e];
            }
        }
        float s = 0.f;
#pragma unroll
        for (int e = 0; e < 32; ++e) s += acc[e];
        s += __shfl_xor(s, 1); s += __shfl_xor(s, 2); s += __shfl_xor(s, 4);
        const float mu = s / 256.f;
        float q = 0.f;
#pragma unroll
        for (int e = 0; e < 32; ++e) { const float d = acc[e] - mu; q += d * d; }
        q += __shfl_xor(q, 1); q += __shfl_xor(q, 2); q += __shfl_xor(q, 4);
        const float rstd = rsqrtf(q / 256.f + EPS);
        const size_t t = rb + qt * 32 + pi;
#pragma unroll
        for (int e = 0; e < 32; ++e) {
            const int col = h * RDV + (lt & 7) + 8 * e;
            const float on = (acc[e] - mu) * rstd * gn_g[col];
            const float gg = ldp(P, t, PC_RG + col);
            P[t * PP + PC_RG + col] = (bf16)f2bf(gg * sigmoidf_(gg) * on);
        }
    }
}

__device__ __forceinline__ void n_conv(const Args& a, bf16* P, int G) {
    const float* cw = a.in[17]; const float* cb = a.in[18];
    constexpr int NF8 = DFF / 8, NITEM = (M / 16) * NF8;
    for (int it = blockIdx.x * 512 + tid_opaque(); it < NITEM; it += G * 512) {
        const int rblk = it / NF8, f8 = (it - rblk * NF8) * 8, pn = f8 >> 7, j = f8 & 127, t0 = rblk * 16, tl0 = t0 & (SEQ - 1);
        bf16* pa = P + (size_t)t0 * PP + PC_UP + 256 * pn + j;
        float w0[8], w1[8], w2[8], bb[8];
#pragma unroll
        for (int q = 0; q < 2; ++q) { const f32x4 c0 = *(const f32x4*)(cw + f8 + 4 * q), c1 = *(const f32x4*)(cw + DFF + f8 + 4 * q), c2 = *(const f32x4*)(cw + 2 * DFF + f8 + 4 * q), cc = *(const f32x4*)(cb + f8 + 4 * q);
#pragma unroll
            for (int e = 0; e < 4; ++e) { w0[4 * q + e] = c0[e]; w1[4 * q + e] = c1[e]; w2[4 * q + e] = c2[e]; bb[4 * q + e] = cc[e]; } }
        v4u p1 = (v4u){0u, 0u, 0u, 0u}, p2 = p1;
        if (tl0 != 0) { p1 = *(const v4u*)(pa - PP); p2 = *(const v4u*)(pa - 2 * PP); }
#pragma unroll 1
        for (int r0 = 0; r0 < 16; r0 += 4) {
            v4u av[4], bv[4];
#pragma unroll
            for (int r = 0; r < 4; ++r) { av[r] = *(const v4u*)(pa + (size_t)(r0 + r) * PP); bv[r] = *(const v4u*)(pa + (size_t)(r0 + r) * PP + 128); }
#pragma unroll
            for (int r = 0; r < 4; ++r) {
                unsigned o[4];
#pragma unroll
                for (int q = 0; q < 4; ++q) {
                    const float ac0 = bb[2 * q] + w2[2 * q] * pg8::bf_lo(av[r][q]) + w1[2 * q] * pg8::bf_lo(p1[q]) + w0[2 * q] * pg8::bf_lo(p2[q]);
                    const float ac1 = bb[2 * q + 1] + w2[2 * q + 1] * pg8::bf_hi(av[r][q]) + w1[2 * q + 1] * pg8::bf_hi(p1[q]) + w0[2 * q + 1] * pg8::bf_hi(p2[q]);
                    o[q] = cvtpk(pg8::gelu_fast(ac0) * pg8::bf_lo(bv[r][q]), pg8::gelu_fast(ac1) * pg8::bf_hi(bv[r][q]));
                }
                *(v4u*)(pa + (size_t)(r0 + r) * PP + 128) = (v4u){o[0], o[1], o[2], o[3]};
                p2 = p1; p1 = av[r];
            }
        }
    }
}

__device__ __forceinline__ void n_final(const Args& a, int G) {
    const int tid_ = tid_opaque(), lane = tid_ & 63, gw = blockIdx.x * 8 + (tid_ >> 6), NGW = G * 8;
    const float* rs3 = (const float*)(a.ws + WS_RS3); const float* gf = a.in[20];
    f32x4 gv[4];
#pragma unroll
    for (int j = 0; j < 4; ++j) gv[j] = *((const f32x4*)gf + lane + 64 * j);
    for (int m0 = gw * 4; m0 < M; m0 += NGW * 4) {
        f32x4 v[4][4]; float rstd[4];
#pragma unroll
        for (int r = 0; r < 4; ++r) { const f32x4* xr = (const f32x4*)(a.out + (size_t)(m0 + r) * DM) + lane;
#pragma unroll
            for (int j = 0; j < 4; ++j) v[r][j] = xr[64 * j];
            rstd[r] = rsqrtf(rs3[m0 + r] * (1.f / DM) + EPS); }
#pragma unroll
        for (int r = 0; r < 4; ++r) { f32x4* xr = (f32x4*)(a.out + (size_t)(m0 + r) * DM) + lane;
#pragma unroll
            for (int j = 0; j < 4; ++j) xr[64 * j] = v[r][j] * rstd[r] * gv[j]; }
    }
}

typedef short bf16x8 __attribute__((ext_vector_type(8)));
typedef float f32x16 __attribute__((ext_vector_type(16)));
typedef float f32x2_t __attribute__((ext_vector_type(2))); typedef __bf16 bf16x2_t __attribute__((ext_vector_type(2)));
typedef unsigned v2u __attribute__((ext_vector_type(2)));
#define MFMA32(a, b, c) __builtin_amdgcn_mfma_f32_32x32x16_bf16((a), (b), (c), 0, 0, 0)
__device__ __forceinline__ unsigned cvtpk(float lo, float hi) { f32x2_t v = {lo, hi}; bf16x2_t b = __builtin_convertvector(v, bf16x2_t); return __builtin_bit_cast(unsigned, b); }
__device__ __forceinline__ float xhalf_max(float m) { auto rr = __builtin_amdgcn_permlane32_swap(__float_as_uint(m), __float_as_uint(m), false, false); return fmaxf(__uint_as_float(rr[0]), __uint_as_float(rr[1])); }
__device__ __forceinline__ float xhalf_sum(float m) { auto rr = __builtin_amdgcn_permlane32_swap(__float_as_uint(m), __float_as_uint(m), false, false); return __uint_as_float(rr[0]) + __uint_as_float(rr[1]); }
__device__ __forceinline__ bf16x8 pack8(const f32x16& x, int s) {
    v4u p; p.x = cvtpk(x[8 * s], x[8 * s + 1]); p.y = cvtpk(x[8 * s + 2], x[8 * s + 3]); p.z = cvtpk(x[8 * s + 4], x[8 * s + 5]); p.w = cvtpk(x[8 * s + 6], x[8 * s + 7]);
    return __builtin_bit_cast(bf16x8, p);
}
constexpr float LOG2E = 1.4426950408889634f;
constexpr int AT_KSTR = 144, AT_VSTR = 136, AT_VOFF = 64 * AT_KSTR, AT_BUF = AT_VOFF + 64 * AT_VSTR;

template <int MODE>
__device__ __forceinline__ void attn_unit(const bf16* P, bf16* NSA, const unsigned* selmask, LAS unsigned char* lds, int b, int g, int n) {
    const int tid = tid_opaque(), lane = tid & 63, wid = tid >> 6, q = lane & 31, h = lane >> 5;
    const int r = wid >> 1, th = wid & 1, head = g * NR + r;
    const int tl = 64 * n + 32 * th + q;
    const size_t rb = (size_t)b * SEQ, trow = rb + tl;
    bf16x8 qf[4];
    { const bf16* qp = P + trow * PP + PC_NQ + head * NDK + 8 * h;
#pragma unroll
      for (int ks = 0; ks < 4; ++ks) qf[ks] = *(const bf16x8*)(qp + 16 * ks); }
    const float slope2 = exp2f(-(float)(head + 1)) * LOG2E, c1 = 0.125f * LOG2E;
    const unsigned smask = MODE == 0 ? selmask[trow * NG + g] : 0u;
    const int j0 = MODE == 1 ? (n > 8 ? n - 8 : 0) : 0, j1 = n;
    f32x16 o0, o1;
#pragma unroll
    for (int i = 0; i < 16; ++i) { o0[i] = 0.f; o1[i] = 0.f; }
    float m = -1e30f, l = 0.f;
    const int skey = tid >> 3, sch = tid & 7;
    const bf16* kg = P + (rb + skey) * PP + (MODE ? PC_KW : PC_KS) + g * NDK + 8 * sch;
    const bf16* vg = P + (rb + skey) * PP + (MODE ? PC_VW : PC_VS) + g * NDK + 8 * sch;
    v4u kreg = *(const v4u*)(kg + (size_t)(64 * j0) * PP), vreg = *(const v4u*)(vg + (size_t)(64 * j0) * PP);
#define AT_WRITE(bufi) do { LAS unsigned char* kb_ = lds + (bufi) * AT_BUF; *(LAS v4u*)(kb_ + skey * AT_KSTR + sch * 16) = kreg; \
        LAS bf16* vb_ = (LAS bf16*)(kb_ + AT_VOFF) + skey; \
        _Pragma("unroll") for (int i_ = 0; i_ < 4; ++i_) { vb_[(8 * sch + 2 * i_) * (AT_VSTR / 2)] = (bf16)(vreg[i_] & 0xffffu); vb_[(8 * sch + 2 * i_ + 1) * (AT_VSTR / 2)] = (bf16)(vreg[i_] >> 16); } } while (0)
    AT_WRITE(0);
    __syncthreads();
    for (int j = j0; j <= j1; ++j) {
        const int cur = (j - j0) & 1;
        if (j < j1) { kreg = *(const v4u*)(kg + (size_t)(64 * (j + 1)) * PP); vreg = *(const v4u*)(vg + (size_t)(64 * (j + 1)) * PP); }
        LAS unsigned char* kb = lds + cur * AT_BUF;
        f32x16 s0, s1;
#pragma unroll
        for (int i = 0; i < 16; ++i) { s0[i] = 0.f; s1[i] = 0.f; }
#pragma unroll
        for (int ks = 0; ks < 4; ++ks) {
            const bf16x8 a0 = *(const LAS bf16x8*)(kb + q * AT_KSTR + ks * 32 + h * 16);
            const bf16x8 a1 = *(const LAS bf16x8*)(kb + (q + 32) * AT_KSTR + ks * 32 + h * 16);
            s0 = MFMA32(a0, qf[ks], s0); s1 = MFMA32(a1, qf[ks], s1);
        }
        const float lt = slope2 * (float)(64 * j + 4 * h - tl);
        const bool need_mask = (j == n) || (MODE == 1 && j == n - 8);
        const bool lane_ok = MODE == 0 ? ((smask >> j) & 1u) != 0u : true;
        const int dbase = tl - 64 * j - 4 * h;
        float mx = -INFINITY;
#pragma unroll
        for (int i = 0; i < 16; ++i) {
            const int kk = (i & 3) + 8 * (i >> 2);
            float z0 = fmaf(s0[i], c1, lt + slope2 * (float)kk), z1 = fmaf(s1[i], c1, lt + slope2 * (float)(kk + 32));
            if (need_mask) { const int d0 = dbase - kk, d1 = d0 - 32;
                if (!(d0 >= 0 && (MODE == 0 || d0 < WIN))) z0 = -INFINITY;
                if (!(d1 >= 0 && (MODE == 0 || d1 < WIN))) z1 = -INFINITY; }
            if (!lane_ok) { z0 = -INFINITY; z1 = -INFINITY; }
            s0[i] = z0; s1[i] = z1; mx = fmaxf(mx, fmaxf(z0, z1));
        }
        mx = xhalf_max(mx);
        const float mn = fmaxf(m, mx), alpha = __builtin_amdgcn_exp2f(m - mn);
        m = mn;
        float ps = 0.f;
#pragma unroll
        for (int i = 0; i < 16; ++i) { s0[i] = __builtin_amdgcn_exp2f(s0[i] - mn); s1[i] = __builtin_amdgcn_exp2f(s1[i] - mn); ps += s0[i] + s1[i]; }
        l = l * alpha + ps;
#pragma unroll
        for (int i = 0; i < 16; ++i) { o0[i] *= alpha; o1[i] *= alpha; }
        bf16x8 pf[4];
        pf[0] = pack8(s0, 0); pf[1] = pack8(s0, 1); pf[2] = pack8(s1, 0); pf[3] = pack8(s1, 1);
        const LAS unsigned char* vb = kb + AT_VOFF + q * AT_VSTR + 8 * h;
#pragma unroll
        for (int ks = 0; ks < 4; ++ks) {
            { const v2u lo = *(const LAS v2u*)(vb + ks * 32), hi = *(const LAS v2u*)(vb + ks * 32 + 16);
              const v4u av = (v4u){lo.x, lo.y, hi.x, hi.y}; o0 = MFMA32(__builtin_bit_cast(bf16x8, av), pf[ks], o0); }
            { const v2u lo = *(const LAS v2u*)(vb + 32 * AT_VSTR + ks * 32), hi = *(const LAS v2u*)(vb + 32 * AT_VSTR + ks * 32 + 16);
              const v4u av = (v4u){lo.x, lo.y, hi.x, hi.y}; o1 = MFMA32(__builtin_bit_cast(bf16x8, av), pf[ks], o1); }
        }
        if (j < j1) AT_WRITE(cur ^ 1);
        __syncthreads();
    }
#undef AT_WRITE
    l = xhalf_sum(l);
    const float gate = pg8::fsig(bf2f(P[trow * PP + PC_GATE + (MODE ? 16 : 8) + head]));
    const float f = gate / l;
    bf16* op = NSA + trow * 512 + head * NDK + 4 * h;
#pragma unroll
    for (int dt = 0; dt < 2; ++dt)
#pragma unroll
        for (int rg = 0; rg < 4; ++rg) {
            const f32x16& o = dt ? o1 : o0;
            float v0 = o[4 * rg] * f, v1 = o[4 * rg + 1] * f, v2 = o[4 * rg + 2] * f, v3 = o[4 * rg + 3] * f;
            v2u* dst = (v2u*)(op + 32 * dt + 8 * rg);
            if (MODE == 0) { const v2u pv = *dst; v0 += pg8::bf_lo(pv.x); v1 += pg8::bf_hi(pv.x); v2 += pg8::bf_lo(pv.y); v3 += pg8::bf_hi(pv.y); }
            *dst = (v2u){cvtpk(v0, v1), cvtpk(v2, v3)};
        }
}
template <int MODE>
__device__ __forceinline__ void attn_phase(const Args& a, const bf16* P, bf16* NSA, LAS unsigned char* lds, int G, int id) {
    const unsigned* selmask = (const unsigned*)(a.ws + WS_SEL);
    __syncthreads();
    for (int u = id; u < NBATCH * NG * NS; u += G) {
        const int n = 31 - (u >> 5), bg = u & 31;
        attn_unit<MODE>(P, NSA, selmask, lds, bg >> 1, bg & 1, n);
    }
}


typedef short v4i16_t __attribute__((ext_vector_type(4)));
__device__ __forceinline__ v4i16_t ds_tr(const LAS unsigned char* p) { return __builtin_amdgcn_ds_read_tr16_b64_v4i16((LAS v4i16_t*)p); }
__device__ __forceinline__ bf16x8 tr_frag(const LAS unsigned char* base, int R, int k0, int n0, int lane) {
    const int grp = lane >> 4, li = lane & 15, qq = li >> 2, pp = li & 3, ngrp = grp & 1, hh = grp >> 1;
    const LAS unsigned char* a = base + (k0 + 8 * hh + qq) * R + (n0 + 16 * ngrp + 4 * pp) * 2;
    const v4i16_t lo = ds_tr(a), hi = ds_tr(a + 4 * R);
    return (bf16x8){lo[0], lo[1], lo[2], lo[3], hi[0], hi[1], hi[2], hi[3]};
}
__device__ __forceinline__ bf16x8 tr_frag_perm(const LAS unsigned char* base, int R, int k0, int n0, int lane) {
    const int grp = lane >> 4, li = lane & 15, qq = li >> 2, pp = li & 3, ngrp = grp & 1, hh = grp >> 1;
    const LAS unsigned char* a = base + (k0 + 4 * hh + qq) * R + (n0 + 16 * ngrp + 4 * pp) * 2;
    const v4i16_t lo = ds_tr(a), hi = ds_tr(a + 8 * R);
    return (bf16x8){lo[0], lo[1], lo[2], lo[3], hi[0], hi[1], hi[2], hi[3]};
}
__device__ __forceinline__ v4u scale8(v4u v, float sc) {
    v4u o;
#pragma unroll
    for (int i = 0; i < 4; ++i) o[i] = cvtpk(pg8::bf_lo(v[i]) * sc, pg8::bf_hi(v[i]) * sc);
    return o;
}
__device__ __forceinline__ float ret_lg2(int hd) { return log2f(1.0f - exp2f(-5.0f - (float)hd)); }

constexpr int RT_VSTR = 576, RT_KSTR = 320, RO_STR = 272;
constexpr size_t KV_UNIT = 256 * 128;
__device__ __forceinline__ void ret_kv_unit(const bf16* P, bf16* KVS, LAS unsigned char* lds, int b, int hd, int n) {
    const int tid = tid_opaque(), lane = tid & 63, wid = tid >> 6, h = lane >> 5;
    const float lg2 = ret_lg2(hd);
    LAS unsigned char* Vs = lds; LAS unsigned char* Ks = lds + 128 * RT_VSTR;
    const size_t rowbase = (size_t)b * SEQ + 128 * n;
    __syncthreads();
#pragma unroll
    for (int i = 0; i < 8; ++i) { const int idx = tid + 512 * i, row = idx >> 5, ch = idx & 31;
        *(LAS v4u*)(Vs + row * RT_VSTR + ch * 16) = *(const v4u*)(P + (rowbase + row) * PP + PC_RV + hd * RDV + 8 * ch); }
#pragma unroll
    for (int i = 0; i < 4; ++i) { const int idx = tid + 512 * i, row = idx >> 4, ch = idx & 15;
        const float sc = 0.08838834764831845f * exp2f(lg2 * (float)(127 - row));
        *(LAS v4u*)(Ks + row * RT_KSTR + ch * 16) = scale8(*(const v4u*)(P + (rowbase + row) * PP + PC_RK + hd * RDK + 8 * ch), sc); }
    __syncthreads();
    f32x16 acc[4];
#pragma unroll
    for (int d = 0; d < 4; ++d)
#pragma unroll
        for (int i = 0; i < 16; ++i) acc[d][i] = 0.f;
#pragma unroll 2
    for (int ks = 0; ks < 8; ++ks) {
        const bf16x8 A = tr_frag(Vs, RT_VSTR, 16 * ks, 32 * wid, lane);
#pragma unroll
        for (int dt = 0; dt < 4; ++dt) { const bf16x8 B = tr_frag(Ks, RT_KSTR, 16 * ks, 32 * dt, lane); acc[dt] = MFMA32(A, B, acc[dt]); }
    }
    bf16* ob = KVS + (size_t)(((b * RH + hd) * 16 + n)) * KV_UNIT;
#pragma unroll
    for (int dt = 0; dt < 4; ++dt)
#pragma unroll
        for (int i = 0; i < 16; ++i) { const int e = 32 * wid + (i & 3) + 8 * (i >> 2) + 4 * h, d = 32 * dt + (lane & 31); ob[e * 128 + d] = (bf16)f2bf(acc[dt][i]); }
}
__device__ __forceinline__ void ret_kv_phase(const bf16* P, bf16* KVS, LAS unsigned char* lds, int G, int id) {
    for (int u = id; u < NBATCH * RH * 16; u += G) ret_kv_unit(P, KVS, lds, u >> 6, (u >> 4) & 3, u & 15);
}
__device__ __forceinline__ void ret_scan_phase(bf16* KVS, int G) {
    for (int it = blockIdx.x * 512 + tid_opaque(); it < NBATCH * RH * 4096; it += G * 512) {
        const int bh = it >> 12, off = (it & 4095) * 8, hd = bh & 3;
        const float decay = exp2f(128.0f * ret_lg2(hd));
        float st[8];
#pragma unroll
        for (int i = 0; i < 8; ++i) st[i] = 0.f;
        bf16* p = KVS + (size_t)bh * 16 * KV_UNIT + off;
        for (int n = 0; n < 16; ++n, p += KV_UNIT) {
            const v4u v = *(const v4u*)p;
            *(v4u*)p = (v4u){cvtpk(st[0], st[1]), cvtpk(st[2], st[3]), cvtpk(st[4], st[5]), cvtpk(st[6], st[7])};
#pragma unroll
            for (int i = 0; i < 4; ++i) { st[2 * i] = st[2 * i] * decay + pg8::bf_lo(v[i]); st[2 * i + 1] = st[2 * i + 1] * decay + pg8::bf_hi(v[i]); }
        }
    }
}
constexpr int RO_QS = 0, RO_SB = 128 * RO_STR, RO_X = 2 * 128 * RO_STR, RO_STATS = RO_X + 128 * RT_VSTR;
static_assert(RO_STATS + 2048 <= 147456 && 256 * RO_STR <= 128 * RT_VSTR, "retention LDS map");
__device__ __forceinline__ void ret_out_unit(bf16* P, const bf16* KVS, const float* gn_g, LAS unsigned char* lds, int b, int hd, int n) {
    const int tid = tid_opaque(), lane = tid & 63, wid = tid >> 6, q = lane & 31, h = lane >> 5;
    const float lg2 = ret_lg2(hd);
    LAS unsigned char* Qs = lds + RO_QS; LAS unsigned char* Sb = lds + RO_SB; LAS unsigned char* X = lds + RO_X;
    const size_t rowbase = (size_t)b * SEQ + 128 * n;
    __syncthreads();
#pragma unroll
    for (int i = 0; i < 4; ++i) { const int idx = tid + 512 * i, row = idx >> 4, ch = idx & 15;
        const float e1 = exp2f(lg2 * (float)(row + 1));
        *(LAS v4u*)(Qs + row * RO_STR + ch * 16) = scale8(*(const v4u*)(P + (rowbase + row) * PP + PC_RQ + hd * RDK + 8 * ch), e1);
        *(LAS v4u*)(X + row * RO_STR + ch * 16) = scale8(*(const v4u*)(P + (rowbase + row) * PP + PC_RK + hd * RDK + 8 * ch), 0.08838834764831845f / e1); }
    __syncthreads();
    const int tt = wid & 3, sh = wid >> 2, trl = 32 * tt + q;
#pragma unroll
    for (int si = 0; si < 2; ++si) {
        const int st = 2 * sh + si;
        if (st > tt) {
#pragma unroll
            for (int rg = 0; rg < 4; ++rg) *(LAS v2u*)(Sb + trl * RO_STR + (32 * st + 8 * rg + 4 * h) * 2) = (v2u){0u, 0u};
        } else {
            f32x16 s;
#pragma unroll
            for (int i = 0; i < 16; ++i) s[i] = 0.f;
#pragma unroll
            for (int ks = 0; ks < 8; ++ks) {
                const bf16x8 a = *(const LAS bf16x8*)(X + (32 * st + q) * RO_STR + ks * 32 + h * 16);
                const bf16x8 bq = *(const LAS bf16x8*)(Qs + trl * RO_STR + ks * 32 + h * 16);
                s = MFMA32(a, bq, s);
            }
#pragma unroll
            for (int rg = 0; rg < 4; ++rg) { const int s0 = 32 * st + 8 * rg + 4 * h;
                const float v0 = (s0 <= trl) ? s[4 * rg] : 0.f, v1 = (s0 + 1 <= trl) ? s[4 * rg + 1] : 0.f, v2 = (s0 + 2 <= trl) ? s[4 * rg + 2] : 0.f, v3 = (s0 + 3 <= trl) ? s[4 * rg + 3] : 0.f;
                *(LAS v2u*)(Sb + trl * RO_STR + s0 * 2) = (v2u){cvtpk(v0, v1), cvtpk(v2, v3)}; }
        }
    }
    __syncthreads();
#pragma unroll
    for (int i = 0; i < 8; ++i) { const int idx = tid + 512 * i, row = idx >> 5, ch = idx & 31;
        *(LAS v4u*)(X + row * RT_VSTR + ch * 16) = *(const v4u*)(P + (rowbase + row) * PP + PC_RV + hd * RDV + 8 * ch); }
    __syncthreads();
    const int eh = wid >> 2;
    f32x16 acc[4];
#pragma unroll
    for (int d = 0; d < 4; ++d)
#pragma unroll
        for (int i = 0; i < 16; ++i) acc[d][i] = 0.f;
    for (int ks = 0; ks < 2 * (tt + 1); ++ks) {
        const bf16x8 bS = *(const LAS bf16x8*)(Sb + trl * RO_STR + ks * 32 + h * 16);
#pragma unroll
        for (int et = 0; et < 4; ++et) { const bf16x8 A = tr_frag(X, RT_VSTR, 16 * ks, 32 * (4 * eh + et), lane); acc[et] = MFMA32(A, bS, acc[et]); }
    }
    __syncthreads();
    { const bf16* rt = KVS + (size_t)(((b * RH + hd) * 16 + n)) * KV_UNIT;
#pragma unroll
      for (int i = 0; i < 8; ++i) { const int idx = tid + 512 * i, row = idx >> 4, ch = idx & 15;
          *(LAS v4u*)(X + row * RO_STR + ch * 16) = *(const v4u*)(rt + row * 128 + 8 * ch); } }
    __syncthreads();
#pragma unroll 2
    for (int ks = 0; ks < 8; ++ks) {
        const bf16x8 bQ = *(const LAS bf16x8*)(Qs + trl * RO_STR + ks * 32 + h * 16);
#pragma unroll
        for (int et = 0; et < 4; ++et) { const bf16x8 A = *(const LAS bf16x8*)(X + (32 * (4 * eh + et) + q) * RO_STR + ks * 32 + h * 16); acc[et] = MFMA32(A, bQ, acc[et]); }
    }
    float s1 = 0.f, s2 = 0.f;
#pragma unroll
    for (int et = 0; et < 4; ++et)
#pragma unroll
        for (int i = 0; i < 16; ++i) { s1 += acc[et][i]; s2 += acc[et][i] * acc[et][i]; }
    s1 = xhalf_sum(s1); s2 = xhalf_sum(s2);
    LAS float* stats = (LAS float*)(lds + RO_STATS);
    if (h == 0) { stats[(eh * 128 + trl) * 2] = s1; stats[(eh * 128 + trl) * 2 + 1] = s2; }
    __syncthreads();
    s1 = stats[trl * 2] + stats[(128 + trl) * 2]; s2 = stats[trl * 2 + 1] + stats[(128 + trl) * 2 + 1];
    const float mu = s1 * (1.f / 256.f), rstd = rsqrtf(fmaxf(s2 * (1.f / 256.f) - mu * mu, 0.f) + EPS);
    bf16* gp = P + (rowbase + trl) * PP + PC_RG + hd * RDV;
    const float* gg = gn_g + hd * RDV;
#pragma unroll
    for (int et = 0; et < 4; ++et)
#pragma unroll
        for (int rg = 0; rg < 4; ++rg) {
            const int e0 = 32 * (4 * eh + et) + 8 * rg + 4 * h;
            const v2u gv = *(const v2u*)(gp + e0); const f32x4 gn = *(const f32x4*)(gg + e0);
            const float g0 = pg8::bf_lo(gv.x), g1 = pg8::bf_hi(gv.x), g2 = pg8::bf_lo(gv.y), g3 = pg8::bf_hi(gv.y);
            const float o0 = (acc[et][4 * rg] - mu) * rstd * gn[0] * g0 * pg8::fsig(g0), o1 = (acc[et][4 * rg + 1] - mu) * rstd * gn[1] * g1 * pg8::fsig(g1);
            const float o2 = (acc[et][4 * rg + 2] - mu) * rstd * gn[2] * g2 * pg8::fsig(g2), o3 = (acc[et][4 * rg + 3] - mu) * rstd * gn[3] * g3 * pg8::fsig(g3);
            *(v2u*)(gp + e0) = (v2u){cvtpk(o0, o1), cvtpk(o2, o3)};
        }
}
__device__ __forceinline__ void ret_out_phase(bf16* P, const bf16* KVS, const float* gn_g, LAS unsigned char* lds, int G) {
    for (int u = blockIdx.x; u < NBATCH * RH * 16; u += G) ret_out_unit(P, KVS, gn_g, lds, u >> 6, (u >> 4) & 3, u & 15);
}

constexpr int CM_KSTR = 144, CM_VSTR = 192;
constexpr int CM_K = 0, CM_V = 128 * CM_KSTR, CM_GW = CM_V + 128 * CM_VSTR, CM_TW = CM_GW + 32768, CM_IMP = CM_TW + 32768;
__device__ __forceinline__ void cmp_unit(const bf16* P, bf16* NSA, const bf16* KC, const bf16* VC, unsigned* selmask, LAS unsigned char* lds, int b, int g, int n) {
    const int tid = tid_opaque(), lane = tid & 63, wid = tid >> 6, q = lane & 31, h = lane >> 5;
    const int r = wid >> 1, th = wid & 1, head = g * NR + r;
    const int tok = 32 * th + q, tl = 64 * n + tok;
    const size_t rb = (size_t)b * SEQ, trow = rb + tl;
    bf16x8 qf[4];
    { const bf16* qp = P + trow * PP + PC_NQ + head * NDK + 8 * h;
#pragma unroll
      for (int ks = 0; ks < 4; ++ks) qf[ks] = *(const bf16x8*)(qp + 16 * ks); }
    const float slope2 = exp2f(-(float)(head + 1)) * LOG2E, c1 = 0.125f * LOG2E;
    __syncthreads();
#pragma unroll
    for (int i = 0; i < 2; ++i) { const int idx = tid + 512 * i, row = idx >> 3, ch = idx & 7;
        v4u kv = (v4u){0u, 0u, 0u, 0u}, vv = kv;
        if (row < NC) { kv = *(const v4u*)(KC + ((size_t)(b * NG + g) * 128 + row) * NDK + 8 * ch); vv = *(const v4u*)(VC + ((size_t)(b * NG + g) * 128 + row) * NDK + 8 * ch); }
        *(LAS v4u*)(lds + CM_K + row * CM_KSTR + ch * 16) = kv; *(LAS v4u*)(lds + CM_V + row * CM_VSTR + ch * 16) = vv; }
    __syncthreads();
    const int ktmax = (4 * n + 2) >> 5;
    f32x16 s[4];
#pragma unroll
    for (int kt = 0; kt < 4; ++kt) {
#pragma unroll
        for (int i = 0; i < 16; ++i) s[kt][i] = 0.f;
        if (kt <= ktmax) {
#pragma unroll
            for (int ks = 0; ks < 4; ++ks) { const bf16x8 a = *(const LAS bf16x8*)(lds + CM_K + (32 * kt + q) * CM_KSTR + ks * 32 + h * 16); s[kt] = MFMA32(a, qf[ks], s[kt]); }
        }
    }
    float mx = -INFINITY;
#pragma unroll
    for (int kt = 0; kt < 4; ++kt)
#pragma unroll
        for (int i = 0; i < 16; ++i) { const int c = 32 * kt + (i & 3) + 8 * (i >> 2) + 4 * h, dc = tl - (c * CSTR + CBLK - 1);
            const float z = (dc >= 0 && kt <= ktmax) ? fmaf(s[kt][i], c1, -slope2 * (float)dc) : -INFINITY;
            s[kt][i] = z; mx = fmaxf(mx, z); }
    mx = xhalf_max(mx);
    const float mref = (mx == -INFINITY) ? 0.f : mx;
    float sum = 0.f;
#pragma unroll
    for (int kt = 0; kt < 4; ++kt)
#pragma unroll
        for (int i = 0; i < 16; ++i) { s[kt][i] = __builtin_amdgcn_exp2f(s[kt][i] - mref); sum += s[kt][i]; }
    sum = xhalf_sum(sum);
    const float inv = sum > 0.f ? 1.f / sum : 0.f;
    LAS float* GW = (LAS float*)(lds + CM_GW); LAS float* TW = (LAS float*)(lds + CM_TW);
#pragma unroll
    for (int kt = 0; kt < 4; ++kt) {
#pragma unroll
        for (int i = 0; i < 16; ++i) s[kt][i] *= inv;
#pragma unroll
        for (int rg = 0; rg < 4; ++rg) { const int j = 8 * kt + 2 * rg + h;
            GW[(r * 64 + tok) * 32 + j] = (s[kt][4 * rg] + s[kt][4 * rg + 1]) + (s[kt][4 * rg + 2] + s[kt][4 * rg + 3]);
            TW[(r * 64 + tok) * 32 + j] = s[kt][4 * rg + 3]; }
    }
    f32x16 o0, o1;
#pragma unroll
    for (int i = 0; i < 16; ++i) { o0[i] = 0.f; o1[i] = 0.f; }
#pragma unroll
    for (int kt = 0; kt < 4; ++kt) {
        if (kt <= ktmax) {
#pragma unroll
            for (int sp = 0; sp < 2; ++sp) { const bf16x8 pf = pack8(s[kt], sp);
                const bf16x8 A0 = tr_frag_perm(lds + CM_V, CM_VSTR, 32 * kt + 16 * sp, 0, lane), A1 = tr_frag_perm(lds + CM_V, CM_VSTR, 32 * kt + 16 * sp, 32, lane);
                o0 = MFMA32(A0, pf, o0); o1 = MFMA32(A1, pf, o1); }
        }
    }
    { const float gate = pg8::fsig(bf2f(P[trow * PP + PC_GATE + head]));
      bf16* op = NSA + trow * 512 + head * NDK + 4 * h;
#pragma unroll
      for (int dt = 0; dt < 2; ++dt)
#pragma unroll
          for (int rg = 0; rg < 4; ++rg) {
              const f32x16& o = dt ? o1 : o0;
              v2u* dst = (v2u*)(op + 32 * dt + 8 * rg); const v2u pv = *dst;
              const float v0 = o[4 * rg] * gate + pg8::bf_lo(pv.x), v1 = o[4 * rg + 1] * gate + pg8::bf_hi(pv.x), v2 = o[4 * rg + 2] * gate + pg8::bf_lo(pv.y), v3 = o[4 * rg + 3] * gate + pg8::bf_hi(pv.y);
              *dst = (v2u){cvtpk(v0, v1), cvtpk(v2, v3)};
          } }
    __syncthreads();
    LAS float* IMP = (LAS float*)(lds + CM_IMP);
    const int j = tid & 31;
#pragma unroll
    for (int pass = 0; pass < 4; ++pass) { const int tk = (tid >> 5) + 16 * pass;
        float imp = 0.f;
#pragma unroll
        for (int rr = 0; rr < 4; ++rr) { imp += GW[(rr * 64 + tk) * 32 + j]; if (j > 0) imp += TW[(rr * 64 + tk) * 32 + j - 1]; }
        if (j == 0 || j == n || j == n - 1) imp = 1e9f;
        if (j > n) imp = -1e9f;
        IMP[tk * 32 + j] = imp; }
    __syncthreads();
#pragma unroll
    for (int pass = 0; pass < 4; ++pass) { const int tk = (tid >> 5) + 16 * pass;
        const float mine = IMP[tk * 32 + j]; int rank = 0;
        for (int i = 0; i < 32; ++i) { const float o = IMP[tk * 32 + i]; rank += (o > mine || (o == mine && i < j)) ? 1 : 0; }
        const unsigned long long bal = __ballot(rank < TOPK && j <= n);
        if ((lane & 31) == 0) selmask[(rb + 64 * n + tk) * NG + g] = (unsigned)(bal >> (lane & 32)); }
}
__device__ __forceinline__ void cmp_phase(const Args& a, const bf16* P, bf16* NSA, LAS unsigned char* lds, int G) {
    const bf16* KC = (const bf16*)(a.ws + WS_KCMP); const bf16* VC = (const bf16*)(a.ws + WS_VCMP);
    unsigned* selmask = (unsigned*)(a.ws + WS_SEL);
    for (int u = blockIdx.x; u < NBATCH * NG * NS; u += G) {
        const int i = u & 255, k = u >> 8, aa = i & 15, hi = i >> 4;
        const int nn = (k & 2) ? ((aa + 8) & 15) : aa, n = (k & 1) ? 31 - nn : nn, bg = hi + 16 * (k >> 1);
        cmp_unit(P, NSA, KC, VC, selmask, lds, bg >> 1, bg & 1, n);
    }
}

__device__ __forceinline__ const Args* args_opaque() { auto p = __builtin_amdgcn_kernarg_segment_ptr(); asm volatile("" : "+s"(p)); return (const Args*)p; }
__global__ void __launch_bounds__(512, 2) mega_fwd(Args kernel_args) {
    extern __shared__ __attribute__((aligned(16))) unsigned char lds_raw[];
    LAS unsigned char* lds = (LAS unsigned char*)lds_raw;
    volatile LAS unsigned* MISC = (volatile LAS unsigned*)(lds + MISC_OFF);
    const int tid = tid_opaque(), G = gridDim.x;
    for (int u = tid; u < (LDS_BYTES - 131072) / 4; u += 512) ((LAS unsigned*)(lds + 131072))[u] = 0u;
    __syncthreads();
    XcdBarrier bar;
    { const Args& a = *args_opaque(); bar = xcd_barrier_post((unsigned*)(a.ws + WS_CTL) + CW_BAR, MISC + 8); }
#define PH_PRELUDE const Args& a = *args_opaque(); bf16* P = (bf16*)(a.ws + WS_PROJ); bf16* XB = (bf16*)((unsigned char*)a.out + DO_XB); bf16* NSA = (bf16*)((unsigned char*)a.out + DO_NSA); \
    bf16* KVS = (bf16*)((unsigned char*)a.out + DO_XB); float* rs2 = (float*)(a.ws + WS_RS2); float* rs3 = (float*)(a.ws + WS_RS3); float* rsdummy = (float*)(a.ws + 44 * MiB); \
    bf16* NSAdummy = (bf16*)((unsigned char*)a.out + 96 * MiB); (void)P; (void)XB; (void)NSA; (void)KVS; (void)rs2; (void)rs3; (void)rsdummy; (void)NSAdummy
#ifndef PROBE_REP
#define PROBE_REP 0
#endif
#define REPS(k) ((PROBE_REP == (k)) ? 2 : 1)
    for (int rep_ = 0; rep_ < REPS(1); ++rep_) { PH_PRELUDE;
    p0_prologue(a, lds, G);
    xcd_barrier(bar);
    }
    for (int rep_ = 0; rep_ < REPS(2); ++rep_) { PH_PRELUDE;
    { pg8::Gemm g{XB, (const bf16*)(a.ws + WS_WIN), DM, DM, 128, 256, (long)128 * DM * 2, (long)256 * DM * 2}; pg8::StaticOrder S; S.init(M, NPAD_IN, G, (int)blockIdx.x);
      pg8::EpiRowScale<0> E{P, PP, nullptr};
      pg8::gemm_phase<pg8::EpiRowScale<0>, pg8::StaticOrder, true, true>(lds, g, S, E); }
    xcd_barrier(bar);
    }
    for (int rep3_ = 0; rep3_ < REPS(3); ++rep3_) {
    for (int rep_ = 0; rep_ < REPS(4); ++rep_) { PH_PRELUDE;
    if (G >= 64 && blockIdx.x < 32) {
        for (int kv = 0; kv < 2; ++kv) {
            pg8::Gemm g{P + (kv ? PC_VCR : PC_KCR), (const bf16*)(a.ws + (kv ? WS_WC1V : WS_WC1K)), 16 * PP, CBLK * NDK, PP * 2, 2 * PP * 2, (long)NDK * 2, (long)SEQ * PP * 2};
            pg8::FewUnits S{NBATCH, (int)blockIdx.x - 16 * kv};
            pg8::EpiCompress E{(const float*)(a.ws + WS_CBIAS) + kv * CHID, (const bf16*)(a.ws + WS_W2T) + kv * (NDK * CHID), (bf16*)(a.ws + (kv ? WS_VCMP : WS_KCMP))};
            pg8::gemm_phase<pg8::EpiCompress, pg8::FewUnits, false, true>(lds, g, S, E);
        }
    } else if (G >= 64) {
        attn_phase<1>(a, P, NSA, lds, G - 32, (int)blockIdx.x - 32);
        ret_kv_phase(P, KVS, lds, G - 32, (int)blockIdx.x - 32);
    } else {
        n_compress(a, P, lds, G);
        attn_phase<1>(a, P, NSA, lds, G, (int)blockIdx.x);
        ret_kv_phase(P, KVS, lds, G, (int)blockIdx.x);
    }
    xcd_barrier(bar);
    }
    { PH_PRELUDE;
    cmp_phase(a, P, NSA, lds, G);
    ret_scan_phase(KVS, G);
    xcd_barrier(bar); }
    }
    { PH_PRELUDE;
    if (PROBE_REP == 9) attn_phase<0>(a, P, NSAdummy, lds, G, (int)blockIdx.x);
    attn_phase<0>(a, P, NSA, lds, G, (int)blockIdx.x);
    ret_out_phase(P, KVS, a.in[3], lds, G);
    xcd_barrier(bar); }
    for (int rep_ = 0; rep_ < REPS(5); ++rep_) { PH_PRELUDE;
    { pg8::Gemm g{P + PC_RG, (const bf16*)(a.ws + WS_WRO), PP, 1024, 128, 256, (long)128 * PP * 2, (long)256 * PP * 2}; pg8::StaticOrder S; S.init(M, DM, G, (int)blockIdx.x);
      pg8::EpiMerge<true> E{P + PC_MERGED, P + PC_GA, PP};
      pg8::gemm_phase<pg8::EpiMerge<true>, pg8::StaticOrder, true, true>(lds, g, S, E); }
    { pg8::Gemm g{NSA, (const bf16*)(a.ws + WS_WNO), 512, 512, 128, 256, (long)128 * 512 * 2, (long)256 * 512 * 2}; pg8::StaticOrder S; S.init(M, DM, G, (int)blockIdx.x);
      pg8::EpiMerge<false> E{P + PC_MERGED, P + PC_GB, PP};
      pg8::gemm_phase<pg8::EpiMerge<false>, pg8::StaticOrder, true, true>(lds, g, S, E); }
    xcd_barrier(bar);
    }
    for (int rep_ = 0; rep_ < REPS(6); ++rep_) { PH_PRELUDE;
    { pg8::Gemm g{P + PC_MERGED, (const bf16*)(a.ws + WS_WOUT), PP, DM, 128, 256, (long)128 * PP * 2, (long)256 * PP * 2}; pg8::StaticOrder S; S.init(M, DM, G, (int)blockIdx.x);
      pg8::EpiResid<true> E{a.in[0], a.out, P + PC_X1B, PP, (rep_ + 1 < REPS(6)) ? rsdummy : rs2};
      pg8::gemm_phase<pg8::EpiResid<true>, pg8::StaticOrder, true, true>(lds, g, S, E); }
    xcd_barrier(bar);
    }
    for (int rep8_ = 0; rep8_ < REPS(8); ++rep8_) {
    for (int rep_ = 0; rep_ < REPS(7); ++rep_) { PH_PRELUDE;
    { pg8::Gemm g{P + PC_X1B, (const bf16*)(a.ws + WS_WUP), PP, DM, 128, 256, (long)128 * PP * 2, (long)256 * PP * 2}; pg8::StaticOrder S; S.init(M, NUP, G, (int)blockIdx.x);
      pg8::EpiRowScale<1> E{P + PC_UP, PP, rs2};
      pg8::gemm_phase<pg8::EpiRowScale<1>, pg8::StaticOrder, true, true>(lds, g, S, E); }
    xcd_barrier(bar);
    }
    { PH_PRELUDE; n_conv(a, P, G); }
    xcd_barrier(bar);
    }
    { PH_PRELUDE;
    { pg8::Gemm g{P + PC_UP + 128, (const bf16*)(a.ws + WS_WDN), PP, DFF, 128, 512, (long)128 * PP * 2, (long)256 * PP * 2}; pg8::StaticOrder S; S.init(M, DM, G, (int)blockIdx.x);
      pg8::EpiResid<false> E{a.out, a.out, nullptr, 0, rs3};
      pg8::gemm_phase<pg8::EpiResid<false>, pg8::StaticOrder, true, true>(lds, g, S, E); }
    xcd_barrier(bar); }
    { const Args& a = *args_opaque(); n_final(a, G); }
}

extern "C" void kernel_launch(void* const* d_in, const int* in_sizes, int n_in, void* d_out, int out_size, void* d_ws, size_t ws_size, hipStream_t stream) {
    static int grid = 0;
    if (grid == 0) {
        if (n_in != 21 || out_size != M * DM || ws_size < WS_END) { fprintf(stderr, "kernel_launch: unexpected sizes n_in %d out %d ws %zu (need %zu)\n", n_in, out_size, ws_size, (size_t)WS_END); grid = -1; return; }
        int dev = 0, cus = 0;
        if (hipGetDevice(&dev) != hipSuccess || hipDeviceGetAttribute(&cus, hipDeviceAttributeMultiprocessorCount, dev) != hipSuccess) { grid = -1; return; }
        if (hipFuncSetAttribute((const void*)mega_fwd, hipFuncAttributeMaxDynamicSharedMemorySize, LDS_BYTES) != hipSuccess) { fprintf(stderr, "kernel_launch: hipFuncSetAttribute failed\n"); grid = -1; return; }
        grid = cus;
    }
    if (grid < 0) return;
    (void)hipMemsetAsync((char*)d_ws + WS_CTL, 0, CTL_ZERO_BYTES, stream);
    Args a{};
    for (int i = 0; i < 21; ++i) a.in[i] = (const float*)d_in[i];
    a.out = (float*)d_out; a.ws = (unsigned char*)d_ws;
    hipLaunchKernelGGL(mega_fwd, dim3(grid), dim3(512), LDS_BYTES, stream, a);
}
```

```cpp
#include <hip/hip_runtime.h>
#include <cstdio>
#include <cstdint>
namespace pg8 {
#define PG8_LAS __attribute__((address_space(3)))
typedef unsigned short bf16_t;
typedef short bf16x8 __attribute__((ext_vector_type(8)));
typedef float f32x4 __attribute__((ext_vector_type(4)));
typedef unsigned u32x4 __attribute__((ext_vector_type(4)));
constexpr int BM = 256, BK = 64, HALF = 128, HTB = HALF * BK * 2  , STAGE_BYTES = 8 * HTB, NXCD = 8, WGM = 8;

__host__ __device__ __forceinline__ int lds_byte(int r, int c) { const int st = (r >> 4) * 2 + (c >> 5), rr = r & 15, cc = c & 31, ob = rr * 64 + cc * 2; return st * 1024 + (ob ^ (((ob >> 9) & 1) << 5)); }
__host__ __device__ __forceinline__ void stage_rc(int b, int& R, int& C) { const int st = b / 1024, sb = b % 1024, swz = sb ^ (((sb >> 9) & 1) << 5); R = (st >> 1) * 16 + swz / 64; C = (st & 1) * 32 + (swz % 64) / 2; }
__host__ __device__ __forceinline__ int perm32(int rho) { const int n = rho >> 4, i = rho & 15; return 8 * (i >> 2) + 4 * n + (i & 3); }

struct Unit { int pm, pn; };
struct Gemm { const bf16_t* A; const bf16_t* Bt; int lda, K, ks1, ks2; long hsA, tsA; };

struct StaticOrder {
    int nM, nN, nwg, G, c;
    __host__ __device__ void init(int M, int N, int G_, int c_) { nM = M / BM; nN = N / BM; nwg = nM * nN; G = G_; c = c_; }
    __host__ __device__ bool next(int i, Unit& u) const {
        const long L = (long)i * G + c; if (L >= nwg) return false;
        int wgid = (int)L; { const int q = nwg / NXCD, r = nwg % NXCD, xcd = wgid % NXCD, off = wgid / NXCD; wgid = (xcd < r ? xcd * (q + 1) : r * (q + 1) + (xcd - r) * q) + off; }
        const int nig = WGM * nN, gid = wgid / nig, fm = gid * WGM, gsz = (nM - fm) < WGM ? (nM - fm) : WGM;
        u.pm = fm + ((wgid % nig) % gsz); u.pn = (wgid % nig) / gsz; return true;
    }
    __device__ __forceinline__ void a_ready(const Unit&) const {}
    __device__ __forceinline__ void done(const Unit&) const {}
};

__device__ __forceinline__ unsigned cvt_pk_bf16(float lo, float hi) { unsigned r; asm volatile("v_cvt_pk_bf16_f32 %0, %1, %2" : "=v"(r) : "v"(lo), "v"(hi)); return r; }
__device__ __forceinline__ float bf_lo(unsigned u) { return __builtin_bit_cast(float, u << 16); }
__device__ __forceinline__ float bf_hi(unsigned u) { return __builtin_bit_cast(float, u & 0xffff0000u); }
__device__ __forceinline__ float fsig(float x) { return __builtin_amdgcn_rcpf(1.f + __builtin_amdgcn_exp2f(-1.4426950408889634f * x)); }

template <int MODE> struct EpiRowScale {
    static constexpr bool PERM = true, AFTER_DRAIN = false;
    bf16_t* O; int ldc; const float* rs;
    __device__ __forceinline__ void operator()(const f32x4 (&acc)[2][2][4][2], const Unit& u, int wr, int wc, int fr, int fq) const {
        const int row0 = u.pm * BM + wr * 64 + fr, col0 = u.pn * BM + wc * 32 + 8 * fq;
#pragma unroll
        for (int ai = 0; ai < 2; ++ai)
#pragma unroll
            for (int m = 0; m < 4; ++m) { const int row = row0 + ai * HALF + m * 16; float s = 1.f;
                if (MODE == 1) s = __builtin_amdgcn_rsqf(rs[row] * (1.0f / 1024.0f) + 1e-6f);
                bf16_t* rowp = O + (size_t)row * ldc + col0;
#pragma unroll
                for (int bj = 0; bj < 2; ++bj) { const f32x4 v0 = acc[ai][bj][m][0] * s, v1 = acc[ai][bj][m][1] * s;
                    u32x4 w; w.x = cvt_pk_bf16(v0[0], v0[1]); w.y = cvt_pk_bf16(v0[2], v0[3]); w.z = cvt_pk_bf16(v1[0], v1[1]); w.w = cvt_pk_bf16(v1[2], v1[3]);
                    *(u32x4*)(rowp + bj * HALF) = w; } }
    }
};
template <bool FIRST> struct EpiMerge {
    static constexpr bool PERM = true, AFTER_DRAIN = false;
    bf16_t* O; const bf16_t* G; int ldc;
    __device__ __forceinline__ void operator()(const f32x4 (&acc)[2][2][4][2], const Unit& u, int wr, int wc, int fr, int fq) const {
        const int row0 = u.pm * BM + wr * 64 + fr, col0 = u.pn * BM + wc * 32 + 8 * fq;
#pragma unroll
        for (int ai = 0; ai < 2; ++ai)
#pragma unroll
            for (int m = 0; m < 4; ++m) { const size_t off = (size_t)(row0 + ai * HALF + m * 16) * ldc + col0;
#pragma unroll
                for (int bj = 0; bj < 2; ++bj) { const u32x4 gv = *(const u32x4*)(G + off + bj * HALF);
                    const f32x4 v0 = acc[ai][bj][m][0], v1 = acc[ai][bj][m][1];
                    float r[8];
                    r[0] = fsig(bf_lo(gv.x)) * v0[0]; r[1] = fsig(bf_hi(gv.x)) * v0[1]; r[2] = fsig(bf_lo(gv.y)) * v0[2]; r[3] = fsig(bf_hi(gv.y)) * v0[3];
                    r[4] = fsig(bf_lo(gv.z)) * v1[0]; r[5] = fsig(bf_hi(gv.z)) * v1[1]; r[6] = fsig(bf_lo(gv.w)) * v1[2]; r[7] = fsig(bf_hi(gv.w)) * v1[3];
                    if (!FIRST) { const u32x4 pv = *(const u32x4*)(O + off + bj * HALF);
                        r[0] += bf_lo(pv.x); r[1] += bf_hi(pv.x); r[2] += bf_lo(pv.y); r[3] += bf_hi(pv.y); r[4] += bf_lo(pv.z); r[5] += bf_hi(pv.z); r[6] += bf_lo(pv.w); r[7] += bf_hi(pv.w); }
                    u32x4 w; w.x = cvt_pk_bf16(r[0], r[1]); w.y = cvt_pk_bf16(r[2], r[3]); w.z = cvt_pk_bf16(r[4], r[5]); w.w = cvt_pk_bf16(r[6], r[7]);
                    *(u32x4*)(O + off + bj * HALF) = w; } }
    }
};
template <bool WB16> struct EpiResid {
    static constexpr bool PERM = false, AFTER_DRAIN = false;
    const float* X; float* X1; bf16_t* Xb; int ldb; float* sumsq;
    __device__ __forceinline__ void operator()(const f32x4 (&acc)[2][2][4][2], const Unit& u, int wr, int wc, int fr, int fq) const {
        const int row0 = u.pm * BM + wr * 64 + fr, col0 = u.pn * BM + wc * 32 + 4 * fq;
#pragma unroll
        for (int ai = 0; ai < 2; ++ai)
#pragma unroll
            for (int m = 0; m < 4; ++m) { const int row = row0 + ai * HALF + m * 16; float ss = 0.f;
#pragma unroll
                for (int bj = 0; bj < 2; ++bj)
#pragma unroll
                    for (int n = 0; n < 2; ++n) { const int c = col0 + bj * HALF + n * 16;
                        const f32x4 x = *(const f32x4*)(X + (size_t)row * 1024 + c) + acc[ai][bj][m][n];
                        *(f32x4*)(X1 + (size_t)row * 1024 + c) = x;
                        ss += (x[0] * x[0] + x[1] * x[1]) + (x[2] * x[2] + x[3] * x[3]);
                        if (WB16) { unsigned long long w = (unsigned long long)cvt_pk_bf16(x[0], x[1]) | ((unsigned long long)cvt_pk_bf16(x[2], x[3]) << 32);
                            *(unsigned long long*)(Xb + (size_t)row * ldb + c) = w; } }
                ss += __shfl_xor(ss, 16); ss += __shfl_xor(ss, 32);
                if (fq == 0) atomicAdd(sumsq + row, ss); }
    }
};

__device__ __forceinline__ float gelu_fast(float x) { return x * fsig(1.5957691216057308f * (x + 0.044715f * x * x * x)); }
typedef float f32x16 __attribute__((ext_vector_type(16)));
struct EpiCompress {
    static constexpr bool PERM = false, AFTER_DRAIN = true;
    const float* bias; const bf16_t* w2t; bf16_t* out;
    __device__ __forceinline__ void fused(f32x4 (&acc)[2][2][4][2], const Unit& u, int wr, int wc, int fr, int fq, PG8_LAS unsigned char* lds, int wid, int lane) const {
        const int col0 = wc * 32 + 4 * fq;
#pragma unroll
        for (int bj = 0; bj < 2; ++bj)
#pragma unroll
            for (int n = 0; n < 2; ++n) { const int c = col0 + bj * HALF + n * 16; const f32x4 bv = *(const f32x4*)(bias + c);
#pragma unroll
                for (int ai = 0; ai < 2; ++ai)
#pragma unroll
                    for (int m = 0; m < 4; ++m) { const int r = ai * HALF + wr * 64 + m * 16 + fr; const f32x4 v = acc[ai][bj][m][n] + bv;
                        const unsigned long long w = (unsigned long long)cvt_pk_bf16(gelu_fast(v[0]), gelu_fast(v[1])) | ((unsigned long long)cvt_pk_bf16(gelu_fast(v[2]), gelu_fast(v[3])) << 32);
                        *(PG8_LAS unsigned long long*)(lds + r * 528 + c * 2) = w; asm volatile("" ::: "memory"); } }
        asm volatile("s_waitcnt lgkmcnt(0)" ::: "memory"); __builtin_amdgcn_s_barrier(); asm volatile("" ::: "memory");
        const int q = lane & 31, h = lane >> 5;
        f32x16 o0, o1;
#pragma unroll
        for (int i = 0; i < 16; ++i) { o0[i] = 0.f; o1[i] = 0.f; }
#pragma unroll 4
        for (int ks = 0; ks < 16; ++ks) {
            const bf16x8 a = *(const PG8_LAS bf16x8*)(lds + (32 * wid + q) * 528 + ks * 32 + h * 16);
            const bf16x8 b0 = *(const bf16x8*)(w2t + q * 256 + 16 * ks + 8 * h), b1 = *(const bf16x8*)(w2t + (q + 32) * 256 + 16 * ks + 8 * h);
            o0 = __builtin_amdgcn_mfma_f32_32x32x16_bf16(a, b0, o0, 0, 0, 0); o1 = __builtin_amdgcn_mfma_f32_32x32x16_bf16(a, b1, o1, 0, 0, 0);
        }
#pragma unroll
        for (int i = 0; i < 16; ++i) { const int r = 32 * wid + (i & 3) + 8 * (i >> 2) + 4 * h, gg = r >> 7, c = r & 127;
            if (c < 127) { bf16_t* op = out + ((size_t)(u.pm * 2 + gg) * 128 + c) * 64 + q;
                op[0] = (bf16_t)(cvt_pk_bf16(o0[i], 0.f) & 0xffffu); op[32] = (bf16_t)(cvt_pk_bf16(o1[i], 0.f) & 0xffffu); } }
    }
};
struct FewUnits {
    int n, c;
    __device__ __forceinline__ bool next(int i, Unit& u) const { if (i != 0 || c >= n || c < 0) return false; u.pm = c; u.pn = 0; return true; }
    __device__ __forceinline__ void a_ready(const Unit&) const {}
    __device__ __forceinline__ void done(const Unit&) const {}
};

template <class Epi, class Sched, bool ALIGN_EPI = false, bool SP2 = false>
__device__ __forceinline__ void gemm_phase(PG8_LAS unsigned char* lds, const Gemm g, const Sched& S, const Epi& E) {
    int tid_ = threadIdx.x; asm volatile("" : "+v"(tid_));
    const int tid = tid_, wid = __builtin_amdgcn_readfirstlane(tid >> 6), lane = tid & 63, wr = wid >> 2, wc = wid & 3, fr = lane & 15, fq = lane >> 4;
    const int K = g.K, nt = K / BK;
    unsigned voffA[2], voffB[2];
#pragma unroll
    for (int i = 0; i < 2; ++i) { int R, C; stage_rc(tid * 16 + i * 8192, R, C); const int Rb = Epi::PERM ? ((R & ~31) + perm32(R & 31)) : R;
        voffA[i] = (unsigned)(R * g.lda + C) * 2u; voffB[i] = (unsigned)(Rb * K + C) * 2u; }
    const size_t kstep = (size_t)(BK * 2);
    const size_t hstepB = (size_t)HALF * K * 2, hstepA = (size_t)g.hsA, ks1 = (size_t)g.ks1, ks2 = (size_t)g.ks2;
    const size_t tstepA = (size_t)g.tsA, tstepB = 2 * hstepB;
    const unsigned ldsw = (unsigned)wid * 1024u;
    const int aoff = lds_byte(wr * 64 + fr, fq * 8), boff = lds_byte(wc * 32 + fr, fq * 8);
#define PG8_SA(b, h) (((b) * 2 + (h)) * HTB)
#define PG8_SB(b, h) ((4 + (b) * 2 + (h)) * HTB)
#define PG8_STAGE(bufoff, gbase, voff) do { _Pragma("unroll") for (int _i = 0; _i < 2; ++_i) \
        __builtin_amdgcn_global_load_lds((const unsigned*)((const char*)(gbase) + (voff)[_i]), (PG8_LAS unsigned*)(lds + (bufoff) + ldsw + _i * 8192), 16, 0, 0); } while (0)
#define PG8_LDA(dst, b, h) do { _Pragma("unroll") for (int m = 0; m < 4; ++m) _Pragma("unroll") for (int k = 0; k < 2; ++k) dst[m][k] = *(const PG8_LAS bf16x8*)(lds + PG8_SA(b, h) + aoff + m * 2048 + k * 1024); } while (0)
#define PG8_LDB(dst, b, h) do { _Pragma("unroll") for (int n = 0; n < 2; ++n) _Pragma("unroll") for (int k = 0; k < 2; ++k) dst[n][k] = *(const PG8_LAS bf16x8*)(lds + PG8_SB(b, h) + boff + n * 2048 + k * 1024); } while (0)
#define PG8_MMA(ai, bj, At, Bt) do { __builtin_amdgcn_s_setprio(1); _Pragma("unroll") for (int m = 0; m < 4; ++m) _Pragma("unroll") for (int n = 0; n < 2; ++n) _Pragma("unroll") for (int k = 0; k < 2; ++k) \
        acc[ai][bj][m][n] = __builtin_amdgcn_mfma_f32_16x16x32_bf16(Bt[n][k], At[m][k], acc[ai][bj][m][n], 0, 0, 0); __builtin_amdgcn_s_setprio(0); } while (0)
#define PG8_WAIT_V(n) asm volatile("s_waitcnt vmcnt(" #n ")" ::: "memory")
#define PG8_WAIT_L(n) asm volatile("s_waitcnt lgkmcnt(" #n ")" ::: "memory")
#define PG8_BAR __builtin_amdgcn_s_barrier()
#define PG8_SCHED __builtin_amdgcn_sched_barrier(0)
    Unit cur, nxt; int ui = 0;
    if (!S.next(0, cur)) return;
    f32x4 acc[2][2][4][2];
#pragma unroll
    for (int a = 0; a < 2; ++a)
#pragma unroll
        for (int b = 0; b < 2; ++b)
#pragma unroll
            for (int m = 0; m < 4; ++m)
#pragma unroll
                for (int n = 0; n < 2; ++n) acc[a][b][m][n] = (f32x4){0.f, 0.f, 0.f, 0.f};
    bf16x8 At[4][2], B0[2][2], B1[2][2];
    const char* cA = (const char*)g.A + (size_t)cur.pm * tstepA; const char* cB = (const char*)g.Bt + (size_t)cur.pn * tstepB;
    S.a_ready(cur);
    if constexpr (SP2) {
        PG8_STAGE(PG8_SB(0, 0), cB, voffB); PG8_STAGE(PG8_SB(0, 1), cB + hstepB, voffB); PG8_STAGE(PG8_SA(0, 0), cA, voffA); PG8_STAGE(PG8_SA(0, 1), cA + hstepA, voffA);
        if (wr == 1) PG8_BAR;
        PG8_WAIT_V(2); PG8_BAR;
        PG8_STAGE(PG8_SB(1, 0), cB + kstep, voffB); PG8_STAGE(PG8_SA(1, 0), cA + ks1, voffA); PG8_STAGE(PG8_SB(1, 1), cB + hstepB + kstep, voffB);
        PG8_WAIT_V(6); PG8_BAR;
    } else {
        PG8_STAGE(PG8_SB(0, 0), cB, voffB); PG8_STAGE(PG8_SA(0, 0), cA, voffA); PG8_STAGE(PG8_SB(0, 1), cB + hstepB, voffB); PG8_STAGE(PG8_SA(0, 1), cA + hstepA, voffA);
        if (wr == 1) PG8_BAR;
        PG8_WAIT_V(4); PG8_BAR;
        PG8_STAGE(PG8_SB(1, 0), cB + kstep, voffB); PG8_STAGE(PG8_SA(1, 0), cA + ks1, voffA); PG8_STAGE(PG8_SB(1, 1), cB + hstepB + kstep, voffB);
        PG8_WAIT_V(6); PG8_BAR;
    }
    for (;;) {
        const bool has_next = S.next(ui + 1, nxt);
        const char* nA = has_next ? (const char*)g.A + (size_t)nxt.pm * tstepA : cA; const char* nB = has_next ? (const char*)g.Bt + (size_t)nxt.pn * tstepB : cB;
        for (int t = 0; t < nt; t += 2) {
            const bool last = (t == nt - 2);
            const char* a1 = cA + (size_t)(t >> 1) * ks2 + ks1;
            const char* a2 = last ? nA : cA + (size_t)((t + 2) >> 1) * ks2; const char* b2 = last ? nB : cB + (size_t)(t + 2) * kstep;
            const char* a3 = a2 + ks1; const char* b3 = b2 + kstep;
            if (last && has_next) S.a_ready(nxt);
            if constexpr (SP2) {
            PG8_LDB(B0, 0, 0); PG8_LDB(B1, 0, 1); PG8_SCHED; PG8_LDA(At, 0, 0); PG8_STAGE(PG8_SA(1, 1), a1 + hstepA, voffA);
            PG8_WAIT_V(8); PG8_WAIT_L(0); PG8_BAR; PG8_MMA(0, 0, At, B0); PG8_MMA(0, 1, At, B1); PG8_BAR; PG8_SCHED;
            PG8_LDA(At, 0, 1); PG8_STAGE(PG8_SB(0, 0), b2, voffB); PG8_STAGE(PG8_SB(0, 1), b2 + hstepB, voffB); PG8_STAGE(PG8_SA(0, 0), a2, voffA);
            PG8_WAIT_V(8); PG8_WAIT_L(0); PG8_BAR; PG8_MMA(1, 0, At, B0); PG8_MMA(1, 1, At, B1); PG8_BAR; PG8_SCHED;
            PG8_LDB(B0, 1, 0); PG8_LDB(B1, 1, 1); PG8_SCHED; PG8_LDA(At, 1, 0); PG8_STAGE(PG8_SA(0, 1), a2 + hstepA, voffA);
            PG8_WAIT_V(8); PG8_WAIT_L(0); PG8_BAR; PG8_MMA(0, 0, At, B0); PG8_MMA(0, 1, At, B1); PG8_BAR; PG8_SCHED;
            PG8_LDA(At, 1, 1); PG8_STAGE(PG8_SB(1, 0), b3, voffB); PG8_STAGE(PG8_SB(1, 1), b3 + hstepB, voffB); PG8_STAGE(PG8_SA(1, 0), a3, voffA);
            PG8_WAIT_V(8); PG8_WAIT_L(0); PG8_BAR; PG8_MMA(1, 0, At, B0); PG8_MMA(1, 1, At, B1); PG8_BAR; PG8_SCHED;
            } else {
            PG8_LDB(B0, 0, 0); PG8_SCHED; PG8_LDA(At, 0, 0); PG8_STAGE(PG8_SA(1, 1), a1 + hstepA, voffA);
            PG8_WAIT_L(8); PG8_BAR; PG8_WAIT_L(0); PG8_MMA(0, 0, At, B0); PG8_BAR; PG8_SCHED;
            PG8_LDB(B1, 0, 1); PG8_STAGE(PG8_SB(0, 0), b2, voffB);
            PG8_BAR; PG8_WAIT_L(0); PG8_MMA(0, 1, At, B1); PG8_BAR;
            PG8_LDA(At, 0, 1); PG8_STAGE(PG8_SA(0, 0), a2, voffA);
            PG8_BAR; PG8_WAIT_L(0); PG8_MMA(1, 0, At, B0); PG8_BAR; PG8_SCHED;
            PG8_STAGE(PG8_SB(0, 1), b2 + hstepB, voffB);
            PG8_WAIT_V(6); PG8_BAR; PG8_MMA(1, 1, At, B1); PG8_BAR;
            PG8_LDB(B0, 1, 0); PG8_SCHED; PG8_LDA(At, 1, 0); PG8_STAGE(PG8_SA(0, 1), a2 + hstepA, voffA);
            PG8_WAIT_L(8); PG8_BAR; PG8_WAIT_L(0); PG8_MMA(0, 0, At, B0); PG8_BAR; PG8_SCHED;
            PG8_LDB(B1, 1, 1); PG8_STAGE(PG8_SB(1, 0), b3, voffB);
            PG8_BAR; PG8_WAIT_L(0); PG8_MMA(0, 1, At, B1); PG8_BAR;
            PG8_LDA(At, 1, 1); PG8_STAGE(PG8_SA(1, 0), a3, voffA);
            PG8_BAR; PG8_WAIT_L(0); PG8_MMA(1, 0, At, B0); PG8_BAR; PG8_SCHED;
            PG8_STAGE(PG8_SB(1, 1), b3 + hstepB, voffB);
            PG8_WAIT_V(6); PG8_BAR; PG8_MMA(1, 1, At, B1); PG8_BAR;
            }
        }
        if constexpr (ALIGN_EPI) { if (wr == 0) PG8_BAR; }
        if constexpr (!Epi::AFTER_DRAIN) { E(acc, cur, wr, wc, fr, fq); S.done(cur); }
        if (!has_next) break;
#pragma unroll
        for (int a = 0; a < 2; ++a)
#pragma unroll
            for (int b = 0; b < 2; ++b)
#pragma unroll
                for (int m = 0; m < 4; ++m)
#pragma unroll
                    for (int n = 0; n < 2; ++n) acc[a][b][m][n] = (f32x4){0.f, 0.f, 0.f, 0.f};
        cur = nxt; cA = nA; cB = nB; ++ui;
        if constexpr (ALIGN_EPI) { if (wr == 1) PG8_BAR; }
    }
    PG8_WAIT_V(0);
    if constexpr (!ALIGN_EPI) { if (wr == 0) PG8_BAR; }
    PG8_BAR;
    if constexpr (Epi::AFTER_DRAIN) { E.fused(acc, cur, wr, wc, fr, fq, lds, wid, lane); S.done(cur); }
#undef PG8_SA
#undef PG8_SB
#undef PG8_STAGE
#undef PG8_LDA
#undef PG8_LDB
#undef PG8_MMA
#undef PG8_WAIT_V
#undef PG8_WAIT_L
#undef PG8_BAR
#undef PG8_SCHED
}
}
constexpr int M = 32768, DM = 1024, SEQ = 2048, NBATCH = 16;
constexpr int RH = 4, RDK = 128, RDV = 256;
constexpr int NG = 2, NR = 4, NDK = 64, CBLK = 32, CSTR = 16, CHID = 256, TOPK = 8, WIN = 512;
constexpr int DFF = 2816, NIN = 6424;
constexpr int NC = SEQ / CSTR - 1;
constexpr int NS = SEQ / 64;
constexpr float EPS = 1e-6f;
constexpr int C_GATE = 4352, C_GA = 4376, C_GB = 5400;
constexpr int PP = 6656;
constexpr int PC_RQ = 0, PC_RK = 512, PC_RV = 1024, PC_RG = 2048, PC_NQ = 3072, PC_KCR = 3584, PC_VCR = 3712, PC_KS = 3840, PC_VS = 3968,
              PC_KW = 4096, PC_VW = 4224, PC_GA = 4352, PC_GB = 5376, PC_GATE = 6400;
constexpr int PC_MERGED = 1024, PC_X1B = 0, PC_UP = 1024;
constexpr int NPAD_IN = 6656, NUP = 2 * DFF;
constexpr size_t MiB = 1u << 20;
constexpr size_t WS_CTL = 0, CTL_ZERO_BYTES = 1 * MiB;
constexpr size_t WS_RS2 = 256 * 1024, WS_RS3 = 512 * 1024;
constexpr size_t WS_WIN = 1 * MiB, WS_WUP = 14 * MiB, WS_WDN = 25 * MiB, WS_WRO = 31 * MiB, WS_WNO = 33 * MiB, WS_WOUT = 34 * MiB;
constexpr size_t WS_KCMP = 39 * MiB, WS_VCMP = 41 * MiB, WS_SEL = 43 * MiB;
constexpr size_t WS_WC1K = 36 * MiB, WS_WC1V = 37 * MiB, WS_W2T = 38 * MiB, WS_CBIAS = 38 * MiB + 128 * 1024;
constexpr size_t WS_PROJ = 48 * MiB;
constexpr size_t WS_END = WS_PROJ + (size_t)(M + 32) * PP * 2;
static_assert(WS_END <= 512 * MiB, "d_ws map");
constexpr int CW_BAR = 4096;
constexpr size_t DO_XB = 0, DO_NSA = 64 * MiB;

constexpr int LDS_BYTES = 163840;
constexpr int MISC_OFF = 163840 - 512;

typedef unsigned short bf16;
typedef unsigned v4u __attribute__((ext_vector_type(4)));
typedef float f32x4 __attribute__((ext_vector_type(4)));
#define GAS __attribute__((address_space(1)))
#define LDS_WAIT() asm volatile("s_waitcnt lgkmcnt(0)" ::: "memory")
__device__ __forceinline__ unsigned f2bf(float f) { unsigned u = __builtin_bit_cast(unsigned, f); return (u + 0x7fffu + ((u >> 16) & 1u)) >> 16; }
__device__ __forceinline__ unsigned pk2(float lo, float hi) { return f2bf(lo) | (f2bf(hi) << 16); }
__device__ __forceinline__ float bf2f(bf16 v) { return __builtin_bit_cast(float, (unsigned)v << 16); }
__device__ __forceinline__ float wave_sum(float v) {
#pragma unroll
    for (int o = 1; o < 64; o <<= 1) v += __shfl_xor(v, o);
    return v;
}
__device__ __forceinline__ float wave_max(float v) {
#pragma unroll
    for (int o = 1; o < 64; o <<= 1) v = fmaxf(v, __shfl_xor(v, o));
    return v;
}
__device__ __forceinline__ float gelu_tanh(float x) { const float c = 0.7978845608028654f; return 0.5f * x * (1.f + tanhf(c * (x + 0.044715f * x * x * x))); }
__device__ __forceinline__ float sigmoidf_(float x) { return 1.f / (1.f + expf(-x)); }

__device__ __forceinline__ int tid_opaque() { int t = threadIdx.x; asm volatile("" : "+v"(t)); return t; }
#define XB_TMO      128
#define XB_XCNT(j)  (256  + 64 * (j))
#define XB_XSUB(j)  (1280 + 64 * (j))
#define XB_XGEN(j)  (2304 + 64 * (j))
#define XB_TOP      3328
#define XB_TOPGEN   3392
#define XCD_BAR_WORDS 3456
#define XB_SPIN_CAP (1u << 21)
#define LAS __attribute__((address_space(3)))

__device__ __forceinline__ unsigned xb_ld(unsigned* p)              { return __hip_atomic_load(p, __ATOMIC_RELAXED, __HIP_MEMORY_SCOPE_AGENT); }
__device__ __forceinline__ unsigned xb_add(unsigned* p, unsigned v) { return __hip_atomic_fetch_add(p, v, __ATOMIC_RELAXED, __HIP_MEMORY_SCOPE_AGENT); }
__device__ __forceinline__ unsigned xb_xcc_id() { return (unsigned)__builtin_amdgcn_s_getreg((3 << 11) | 20) & 0xFu; }
#define XB_SPIN(cond, bar) do { unsigned _sp = 0; while (cond) { __builtin_amdgcn_s_sleep(1); \
    if ((++_sp & 255u) == 0u) { if (xb_ld(&(bar)[XB_TMO])) break; if (_sp > XB_SPIN_CAP) { atomicAdd(&(bar)[XB_TMO], 1u); break; } } } } while (0)

struct XcdBarrier {
    unsigned* bar; unsigned x;
    volatile LAS unsigned* st;
};

__device__ __forceinline__ XcdBarrier xcd_barrier_post(unsigned* bar, volatile LAS unsigned* st) {
    XcdBarrier b; b.bar = bar; b.x = xb_xcc_id(); b.st = st;
    if (threadIdx.x == 0) (void)xb_add(&bar[XB_XCNT(b.x)], 1u);
    return b;
}
__device__ __forceinline__ void xcd_barrier_complete(unsigned* bar, unsigned x, unsigned& nloc, unsigned& nx) {
    const unsigned G = gridDim.x * gridDim.y * gridDim.z;
    unsigned sum, cnt, mine, sp = 0u;
    for (;;) {
        sum = 0u; cnt = 0u; mine = 0u;
#pragma unroll
        for (unsigned j = 0; j < 16; ++j) { const unsigned c = xb_ld(&bar[XB_XCNT(j)]); sum += c; cnt += (c > 0u) ? 1u : 0u; mine = (j == x) ? c : mine; }
        if (sum == G) break;
        __builtin_amdgcn_s_sleep(1);
        if ((++sp & 255u) == 0u) { if (xb_ld(&bar[XB_TMO])) break; if (sp > XB_SPIN_CAP) { atomicAdd(&bar[XB_TMO], 1u); break; } }
    }
    nloc = mine > 0u ? mine : 1u; nx = cnt > 0u ? cnt : 1u;
}

__device__ __forceinline__ void xcd_barrier(const XcdBarrier& b) {
    asm volatile("s_waitcnt vmcnt(0)" ::: "memory");
    __syncthreads();
    if (threadIdx.x == 0) {
        unsigned* bar = b.bar;
        __builtin_amdgcn_s_waitcnt(0);
        unsigned nloc = b.st[0], nx = b.st[1];
        if (nloc == 0u) { xcd_barrier_complete(bar, b.x, nloc, nx); b.st[0] = nloc; b.st[1] = nx; }
        const unsigned old = xb_add(&bar[XB_XSUB(b.x)], 1u);
        const unsigned gen = old / nloc;
        if (old + 1u == (gen + 1u) * nloc) {
            __builtin_amdgcn_fence(__ATOMIC_RELEASE, "agent");
            asm volatile("s_waitcnt vmcnt(0)" ::: "memory");
            const unsigned og = xb_add(&bar[XB_TOP], 1u);
            const unsigned tg = og / nx;
            if (og + 1u == (tg + 1u) * nx) xb_add(&bar[XB_TOPGEN], 1u);
            else XB_SPIN(xb_ld(&bar[XB_TOPGEN]) == tg, bar);
            __builtin_amdgcn_fence(__ATOMIC_ACQUIRE, "agent");
            xb_add(&bar[XB_XGEN(b.x)], 1u);
            asm volatile("s_waitcnt vmcnt(0)" ::: "memory");
        } else {
            XB_SPIN(xb_ld(&bar[XB_XGEN(b.x)]) == gen, bar);
            __builtin_amdgcn_fence(__ATOMIC_ACQUIRE, "agent");
            asm volatile("s_waitcnt vmcnt(0)" ::: "memory");
        }
    }
    __syncthreads();
}

struct Args { const float* in[21]; float* out; unsigned char* ws; };
__device__ __forceinline__ unsigned cvtpk(float lo, float hi);
typedef short v4i16_t __attribute__((ext_vector_type(4)));
__device__ __forceinline__ v4u scale8(v4u v, float sc);

struct MapIn { __device__ __forceinline__ int operator()(int n) const { return n < 4352 ? n : (n < 6400 ? n + 24 : (n < 6424 ? n - 2048 : -1)); } };
struct MapUp { __device__ __forceinline__ int operator()(int n) const { const int pn = n >> 8, j = n & 255; return j < 128 ? 128 * pn + j : DFF + 128 * pn + (j - 128); } };
struct MapId { __device__ __forceinline__ int operator()(int n) const { return n; } };
template <class MAP>
__device__ __forceinline__ void p0_transpose_item(const float* W, int K, int Nsrc, int nblk, bf16* WT, const float* ksc, LAS float* scr, int item, int lane, MAP map) {
    const int kb = item / nblk, nb = item % nblk, k0 = 64 * kb, n0 = 32 * nb;
    const int sc = map(n0 + (lane & 31));
#pragma unroll 8
    for (int i = 0; i < 32; ++i) { const int kk = 2 * i + (lane >> 5); float v = 0.f; if (sc >= 0) { v = W[(size_t)(k0 + kk) * Nsrc + sc]; if (ksc) v *= ksc[k0 + kk]; } scr[kk * 33 + (lane & 31)] = v; }
    LDS_WAIT(); asm volatile("" ::: "memory");
    const int c = lane & 7;
#pragma unroll
    for (int j = 0; j < 4; ++j) { const int n = (lane >> 3) + 8 * j; const LAS float* s = scr + (8 * c) * 33 + n;
        v4u o; o.x = pk2(s[0 * 33], s[1 * 33]); o.y = pk2(s[2 * 33], s[3 * 33]); o.z = pk2(s[4 * 33], s[5 * 33]); o.w = pk2(s[6 * 33], s[7 * 33]);
        *(GAS v4u*)(WT + (size_t)(n0 + n) * K + k0 + 8 * c) = o; }
    LDS_WAIT(); asm volatile("" ::: "memory");
}
__device__ __forceinline__ void p0_prologue(const Args& a, LAS unsigned char* lds, int G) {
    const int tid = tid_opaque(), lane = tid & 63, wave = tid >> 6;
    LAS float* scr = (LAS float*)(lds + wave * 16384);
    const int gw = blockIdx.x * 8 + wave, NGW = G * 8;
    unsigned char* ws = a.ws;
    constexpr int I_IN = 16 * (NPAD_IN / 32), I_UP = 16 * (NUP / 32), I_DN = (DFF / 64) * 32, I_RO = 16 * 32, I_NO = 8 * 32, I_OUT = 16 * 32;
    constexpr int NITEMS = I_IN + I_UP + I_DN + I_RO + I_NO + I_OUT;
    for (int it = gw; it < NITEMS; it += NGW) {
        int r = it;
        if (r < I_IN) { p0_transpose_item(a.in[2], DM, NIN, NPAD_IN / 32, (bf16*)(ws + WS_WIN), a.in[1], scr, r, lane, MapIn()); continue; } r -= I_IN;
        if (r < I_UP) { p0_transpose_item(a.in[16], DM, NUP, NUP / 32, (bf16*)(ws + WS_WUP), a.in[15], scr, r, lane, MapUp()); continue; } r -= I_UP;
        if (r < I_DN) { p0_transpose_item(a.in[19], DFF, DM, 32, (bf16*)(ws + WS_WDN), nullptr, scr, r, lane, MapId()); continue; } r -= I_DN;
        if (r < I_RO) { p0_transpose_item(a.in[12], 1024, DM, 32, (bf16*)(ws + WS_WRO), nullptr, scr, r, lane, MapId()); continue; } r -= I_RO;
        if (r < I_NO) { p0_transpose_item(a.in[13], 512, DM, 32, (bf16*)(ws + WS_WNO), nullptr, scr, r, lane, MapId()); continue; } r -= I_NO;
        p0_transpose_item(a.in[14], DM, DM, 32, (bf16*)(ws + WS_WOUT), nullptr, scr, r, lane, MapId());
    }
    for (int it = gw; it < 2 * 256; it += NGW) { const int kv = it >> 8, r = it & 255;
        p0_transpose_item(a.in[kv ? 9 : 5], 2048, CHID, CHID / 32, (bf16*)(ws + (kv ? WS_WC1V : WS_WC1K)), nullptr, scr, r, lane, MapId()); }
    for (int it = gw; it < 2 * 8; it += NGW) { const int kv = it >> 3, r = it & 7;
        p0_transpose_item(a.in[kv ? 11 : 7], CHID, NDK, 2, (bf16*)(ws + WS_W2T) + kv * (NDK * CHID), nullptr, scr, r, lane, MapId()); }
    for (int it = gw; it < 2 * 4; it += NGW) { const int kv = it >> 2, j = (it & 3) * 64 + lane;
        const float* pos = a.in[kv ? 8 : 4]; const float* w1 = a.in[kv ? 9 : 5]; const float* b1 = a.in[kv ? 10 : 6];
        float acc = b1[j];
        for (int k = 0; k < CBLK * NDK; ++k) acc += pos[k] * w1[(size_t)k * CHID + j];
        ((float*)(ws + WS_CBIAS))[kv * CHID + j] = acc; }
    bf16* XB = (bf16*)((unsigned char*)a.out + DO_XB);
    for (int m0 = gw * 4; m0 < M; m0 += NGW * 4) {
        f32x4 v[4][4];
#pragma unroll
        for (int r = 0; r < 4; ++r) { const GAS f32x4* xr = (const GAS f32x4*)(a.in[0] + (size_t)(m0 + r) * DM) + lane;
#pragma unroll
            for (int j = 0; j < 4; ++j) v[r][j] = xr[64 * j]; }
#pragma unroll
        for (int r = 0; r < 4; ++r) { float s = 0.f;
#pragma unroll
            for (int j = 0; j < 4; ++j) s += (v[r][j].x * v[r][j].x + v[r][j].y * v[r][j].y) + (v[r][j].z * v[r][j].z + v[r][j].w * v[r][j].w);
            const float rstd = rsqrtf(wave_sum(s) * (1.f / DM) + EPS);
            GAS unsigned long long* o8 = (GAS unsigned long long*)(XB + (size_t)(m0 + r) * DM) + lane;
#pragma unroll
            for (int j = 0; j < 4; ++j) o8[64 * j] = (unsigned long long)pk2(v[r][j].x * rstd, v[r][j].y * rstd) | ((unsigned long long)pk2(v[r][j].z * rstd, v[r][j].w * rstd) << 32); }
    }
}

__device__ __forceinline__ float ldp(const bf16* P, size_t row, int col) { return bf2f(P[row * PP + col]); }

__device__ __forceinline__ void n_compress(const Args& a, const bf16* P, LAS unsigned char* lds, int G) {
    const int tid = tid_opaque(), sub = tid >> 8, lt = tid & 255;
    LAS float* bv = (LAS float*)(lds + sub * 16384); LAS float* hid = bv + CBLK * NDK;
    for (int it = blockIdx.x; it < NBATCH * NC * 2; it += G) {
        const int u = it * 2 + sub, kv = u & 1, g = (u >> 1) & 1, c = (u >> 2) % NC, b = (u >> 2) / NC;
        const float* pos = a.in[kv ? 8 : 4]; const float* w1 = a.in[kv ? 9 : 5]; const float* b1 = a.in[kv ? 10 : 6]; const float* w2 = a.in[kv ? 11 : 7];
        bf16* out = (bf16*)(a.ws + (kv ? WS_VCMP : WS_KCMP));
        const int colbase = (kv ? PC_VCR : PC_KCR) + g * NDK;
        __syncthreads();
        for (int i = lt; i < CBLK * NDK; i += 256) { const int ii = i >> 6, d = i & 63; bv[i] = ldp(P, (size_t)b * SEQ + c * CSTR + ii, colbase + d) + pos[i]; }
        __syncthreads();
        float acc = b1[lt];
        for (int k = 0; k < CBLK * NDK; ++k) acc += bv[k] * w1[(size_t)k * CHID + lt];
        hid[lt] = gelu_tanh(acc);
        __syncthreads();
        if (lt < NDK) { float o = 0.f; for (int j = 0; j < CHID; ++j) o += hid[j] * w2[j * NDK + lt]; out[(((size_t)b * NG + g) * 128 + c) * NDK + lt] = (bf16)f2bf(o); }
    }
}

template <int MODE>
__device__ __forceinline__ void n_attn(const Args& a, const bf16* P, bf16* NSA, LAS unsigned char* lds, int G) {
    const int tid = tid_opaque(), sub = tid >> 8, r = (tid >> 6) & 3, lane = tid & 63;
    LAS float* qs = (LAS float*)(lds + sub * 16384) + r * 64;
    LAS float* scs = (LAS float*)(lds + sub * 16384 + 1024) + r * 576;
    LAS int* blks = (LAS int*)(lds + sub * 16384 + 1024 + 9216) + r * 12;
    const unsigned* selmask = (const unsigned*)(a.ws + WS_SEL);
    const int kcol = MODE ? PC_KW : PC_KS, vcol = MODE ? PC_VW : PC_VS;
    for (int it = blockIdx.x; it < M; it += G) {
        const int u = it * 2 + sub, g = u & 1, t = u >> 1, tl = t & (SEQ - 1), h = g * NR + r, cur = tl >> 6;
        const size_t rb = (size_t)(t - tl);
        const float slope = exp2f(-(float)(h + 1));
        __syncthreads();
        qs[lane] = ldp(P, t, PC_NQ + h * NDK + lane);
        unsigned mask;
        if (MODE) { const int lo = (tl - (WIN - 1)) > 0 ? ((tl - (WIN - 1)) >> 6) : 0; mask = 0u; for (int j = lo; j <= cur; ++j) mask |= 1u << j; }
        else mask = selmask[t * NG + g];
        int nb = 0;
        for (int j = 0; j < NS; ++j) if ((mask >> j) & 1u) { if (lane == 0) blks[nb] = j; ++nb; }
        __syncthreads();
        float m = -1e30f;
        for (int b = 0; b < nb; ++b) {
            const int s = blks[b] * 64 + lane; const int d = tl - s;
            const bool valid = d >= 0 && (!MODE || d < WIN);
            float sc = -1e30f;
            if (valid) { float dot = 0.f; const bf16* kr = P + (rb + s) * PP + kcol + g * NDK; for (int x = 0; x < NDK; ++x) dot += qs[x] * bf2f(kr[x]); sc = dot * 0.125f - slope * (float)d; }
            scs[b * 64 + lane] = sc; m = fmaxf(m, sc);
        }
        m = wave_max(m);
        float sum = 0.f;
        for (int b = 0; b < nb; ++b) { const float sc = scs[b * 64 + lane]; const float p = sc > -1e29f ? expf(sc - m) : 0.f; scs[b * 64 + lane] = p; sum += p; }
        sum = wave_sum(sum);
        __syncthreads();
        float o = 0.f;
        for (int b = 0; b < nb; ++b) {
            const int s0 = blks[b] * 64;
            for (int i = 0; i < 64; ++i) { const float p = scs[b * 64 + i]; if (p != 0.f) o += p * ldp(P, rb + s0 + i, vcol + g * NDK + lane); }
        }
        const float gate = sigmoidf_(ldp(P, t, PC_GATE + (MODE ? 16 : 8) + h));
        const size_t oi = (size_t)t * 512 + h * NDK + lane;
        float res = gate * o / sum;
        if (!MODE) res += bf2f(NSA[oi]);
        NSA[oi] = (bf16)f2bf(res);
    }
}

__device__ __forceinline__ void n_cmp(const Args& a, const bf16* P, bf16* NSA, LAS unsigned char* lds, int G) {
    const int tid = tid_opaque(), w = tid >> 6, lane = tid & 63;
    LAS float* qs = (LAS float*)(lds + w * 4096);
    LAS float* ps = qs + 256;
    const float* kcmp = (const float*)(a.ws + WS_KCMP); const float* vcmp = (const float*)(a.ws + WS_VCMP);
    unsigned* selmask = (unsigned*)(a.ws + WS_SEL);
    for (int it = blockIdx.x; it < M * NG / 8; it += G) {
        const int u = it * 8 + w, g = u & 1, t = u >> 1, tl = t & (SEQ - 1), b = t >> 11;
        const float* kc = kcmp + ((size_t)b * NG + g) * NC * NDK; const float* vc = vcmp + ((size_t)b * NG + g) * NC * NDK;
        __syncthreads();
        for (int r = 0; r < NR; ++r) qs[r * 64 + lane] = ldp(P, t, PC_NQ + (g * NR + r) * NDK + lane);
        __syncthreads();
        for (int r = 0; r < NR; ++r) {
            const int h = g * NR + r; const float slope = exp2f(-(float)(h + 1));
            float sc[2]; bool val[2];
#pragma unroll
            for (int q = 0; q < 2; ++q) {
                const int c = lane + 64 * q; sc[q] = -1e30f; val[q] = false;
                if (c < NC) {
                    float d = 0.f; const float* kr = kc + (size_t)c * NDK;
                    for (int x = 0; x < NDK; ++x) d += qs[r * 64 + x] * kr[x];
                    const int dc = tl - (c * CSTR + CBLK - 1);
                    if (dc >= 0) { val[q] = true; sc[q] = d * 0.125f - slope * (float)dc; }
                }
            }
            const float mx = wave_max(fmaxf(sc[0], sc[1]));
            float p0 = val[0] ? expf(sc[0] - mx) : 0.f, p1 = val[1] ? expf(sc[1] - mx) : 0.f;
            const float sum = wave_sum(p0 + p1);
            const float inv = sum > 0.f ? 1.f / sum : 0.f;
            ps[r * 128 + lane] = p0 * inv; ps[r * 128 + 64 + lane] = p1 * inv;
        }
        __syncthreads();
        for (int r = 0; r < NR; ++r) {
            const int h = g * NR + r;
            float o = 0.f;
            for (int c = 0; c < NC; ++c) o += ps[r * 128 + c] * vc[(size_t)c * NDK + lane];
            const float gate = sigmoidf_(ldp(P, t, PC_GATE + h));
            const size_t oi = (size_t)t * 512 + h * NDK + lane;
            NSA[oi] = (bf16)f2bf(bf2f(NSA[oi]) + gate * o);
        }
        float imp = 0.f; const int j = lane & 31;
        for (int r = 0; r < NR; ++r)
            for (int c = 4 * j - 1; c <= 4 * j + 3; ++c) if (c >= 0 && c < NC) imp += ps[r * 128 + c];
        const int cur = tl >> 6;
        if (j == 0 || j == cur || j == cur - 1) imp = 1e9f;
        if (j > cur) imp = -1e9f;
        int rank = 0;
        for (int i = 0; i < NS; ++i) { const float o = __shfl(imp, i); rank += (o > imp || (o == imp && i < j)) ? 1 : 0; }
        const unsigned long long bal = __ballot(rank < TOPK && lane < 32 && j <= cur);
        if (lane == 0) selmask[t * NG + g] = (unsigned)bal;
    }
}

__device__ __forceinline__ void n_retention(const Args& a, bf16* P, LAS unsigned char* lds, int G) {
    const int tid = tid_opaque(), sub = tid >> 8, lt = tid & 255;
    LAS float* Qs = (LAS float*)(lds + sub * 49152);
    LAS float* Ks = Qs + 32 * 129;
    LAS float* Vs = Ks + 16 * 129;
    LAS float* Ps = Vs + 16 * 256;
    const float* gn_g = a.in[3];
    for (int p = blockIdx.x; p < NBATCH * 2 * 64; p += G) {
        const int k_ = p >> 8, qt0 = p & 63, qt = (k_ & 1) ? 63 - qt0 : qt0, idx = p >> 6, hp = idx & 1, b = idx >> 1, h = hp * 2 + sub;
        const size_t rb = (size_t)b * SEQ;
        const float lg = log1pf(-exp2f(-5.0f - (float)h));
        const float scale = 0.08838834764831845f;
        __syncthreads();
        for (int i = lt; i < 32 * 128; i += 256) { const int r = i >> 7, c = i & 127; Qs[r * 129 + c] = ldp(P, rb + qt * 32 + r, PC_RQ + h * RDK + c); }
        float acc[32];
#pragma unroll
        for (int e = 0; e < 32; ++e) acc[e] = 0.f;
        const int pi = lt >> 3, pj0 = (lt & 7) * 2;
        for (int kt = 0; kt <= 2 * qt + 1; ++kt) {
            __syncthreads();
            for (int i = lt; i < 16 * 128; i += 256) { const int r = i >> 7, c = i & 127; Ks[r * 129 + c] = ldp(P, rb + kt * 16 + r, PC_RK + h * RDK + c); }
            for (int i = lt; i < 16 * 256; i += 256) { const int r = i >> 8, c = i & 255; Vs[r * 256 + c] = ldp(P, rb + kt * 16 + r, PC_RV + h * RDV + c); }
            __syncthreads();
#pragma unroll
            for (int jj = 0; jj < 2; ++jj) {
                const int j = pj0 + jj; float d = 0.f;
                for (int c = 0; c < 128; ++c) d += Qs[pi * 129 + c] * Ks[j * 129 + c];
                const int diff = (qt * 32 + pi) - (kt * 16 + j);
                Ps[pi * 17 + j] = diff >= 0 ? d * scale * expf(lg * (float)diff) : 0.f;
            }
            __syncthreads();
            for (int j = 0; j < 16; ++j) {
                const float pv = Ps[pi * 17 + j];
#pragma unroll
                for (int e = 0; e < 32; ++e) acc[e] += pv * Vs[j * 256 + (lt & 7) + 8 * e];
            }
        }
        float s = 0.f;
#pragma unroll
        for (int e = 0; e < 32; ++e) s += acc[e];
        s += __shfl_xor(s, 1); s += __shfl_xor(s, 2); s += __shfl_xor(s, 4);
        const float mu = s / 256.f;
        float q = 0.f;
#pragma unroll
        for (int e = 0; e < 32; ++e) { const float d = acc[e] - mu; q += d * d; }
        q += __shfl_xor(q, 1); q += __shfl_xor(q, 2); q += __shfl_xor(q, 4);
        const float rstd = rsqrtf(q / 256.f + EPS);
        const size_t t = rb + qt * 32 + pi;
#pragma unroll
        for (int e = 0; e < 32; ++e) {
            const int col = h * RDV + (lt & 7) + 8 * e;
            const float on = (acc[e] - mu) * rstd * gn_g[col];
            const float gg = ldp(P, t, PC_RG + col);
            P[t * PP + PC_RG + col] = (bf16)f2bf(gg * sigmoidf_(gg) * on);
        }
    }
}

__device__ __forceinline__ void n_conv(const Args& a, bf16* P, int G) {
    const float* cw = a.in[17]; const float* cb = a.in[18];
    constexpr int NF8 = DFF / 8, NITEM = (M / 16) * NF8;
    for (int it = blockIdx.x * 512 + tid_opaque(); it < NITEM; it += G * 512) {
        const int rblk = it / NF8, f8 = (it - rblk * NF8) * 8, pn = f8 >> 7, j = f8 & 127, t0 = rblk * 16, tl0 = t0 & (SEQ - 1);
        bf16* pa = P + (size_t)t0 * PP + PC_UP + 256 * pn + j;
        float w0[8], w1[8], w2[8], bb[8];
#pragma unroll
        for (int q = 0; q < 2; ++q) { const f32x4 c0 = *(const f32x4*)(cw + f8 + 4 * q), c1 = *(const f32x4*)(cw + DFF + f8 + 4 * q), c2 = *(const f32x4*)(cw + 2 * DFF + f8 + 4 * q), cc = *(const f32x4*)(cb + f8 + 4 * q);
#pragma unroll
            for (int e = 0; e < 4; ++e) { w0[4 * q + e] = c0[e]; w1[4 * q + e] = c1[e]; w2[4 * q + e] = c2[e]; bb[4 * q + e] = cc[e]; } }
        v4u p1 = (v4u){0u, 0u, 0u, 0u}, p2 = p1;
        if (tl0 != 0) { p1 = *(const v4u*)(pa - PP); p2 = *(const v4u*)(pa - 2 * PP); }
#pragma unroll 1
        for (int r0 = 0; r0 < 16; r0 += 4) {
            v4u av[4], bv[4];
#pragma unroll
            for (int r = 0; r < 4; ++r) { av[r] = *(const v4u*)(pa + (size_t)(r0 + r) * PP); bv[r] = *(const v4u*)(pa + (size_t)(r0 + r) * PP + 128); }
#pragma unroll
            for (int r = 0; r < 4; ++r) {
                unsigned o[4];
#pragma unroll
                for (int q = 0; q < 4; ++q) {
                    const float ac0 = bb[2 * q] + w2[2 * q] * pg8::bf_lo(av[r][q]) + w1[2 * q] * pg8::bf_lo(p1[q]) + w0[2 * q] * pg8::bf_lo(p2[q]);
                    const float ac1 = bb[2 * q + 1] + w2[2 * q + 1] * pg8::bf_hi(av[r][q]) + w1[2 * q + 1] * pg8::bf_hi(p1[q]) + w0[2 * q + 1] * pg8::bf_hi(p2[q]);
                    o[q] = cvtpk(pg8::gelu_fast(ac0) * pg8::bf_lo(bv[r][q]), pg8::gelu_fast(ac1) * pg8::bf_hi(bv[r][q]));
                }
                *(v4u*)(pa + (size_t)(r0 + r) * PP + 128) = (v4u){o[0], o[1], o[2], o[3]};
                p2 = p1; p1 = av[r];
            }
        }
    }
}

__device__ __forceinline__ void n_final(const Args& a, int G) {
    const int tid_ = tid_opaque(), lane = tid_ & 63, gw = blockIdx.x * 8 + (tid_ >> 6), NGW = G * 8;
    const float* rs3 = (const float*)(a.ws + WS_RS3); const float* gf = a.in[20];
    f32x4 gv[4];
#pragma unroll
    for (int j = 0; j < 4; ++j) gv[j] = *((const f32x4*)gf + lane + 64 * j);
    for (int m0 = gw * 4; m0 < M; m0 += NGW * 4) {
        f32x4 v[4][4]; float rstd[4];
#pragma unroll
        for (int r = 0; r < 4; ++r) { const f32x4* xr = (const f32x4*)(a.out + (size_t)(m0 + r) * DM) + lane;
#pragma unroll
            for (int j = 0; j < 4; ++j) v[r][j] = xr[64 * j];
            rstd[r] = rsqrtf(rs3[m0 + r] * (1.f / DM) + EPS); }
#pragma unroll
        for (int r = 0; r < 4; ++r) { f32x4* xr = (f32x4*)(a.out + (size_t)(m0 + r) * DM) + lane;
#pragma unroll
            for (int j = 0; j < 4; ++j) xr[64 * j] = v[r][j] * rstd[r] * gv[j]; }
    }
}

typedef short bf16x8 __attribute__((ext_vector_type(8)));
typedef float f32x16 __attribute__((ext_vector_type(16)));
typedef float f32x2_t __attribute__((ext_vector_type(2))); typedef __bf16 bf16x2_t __attribute__((ext_vector_type(2)));
typedef unsigned v2u __attribute__((ext_vector_type(2)));
#define MFMA32(a, b, c) __builtin_amdgcn_mfma_f32_32x32x16_bf16((a), (b), (c), 0, 0, 0)
__device__ __forceinline__ unsigned cvtpk(float lo, float hi) { f32x2_t v = {lo, hi}; bf16x2_t b = __builtin_convertvector(v, bf16x2_t); return __builtin_bit_cast(unsigned, b); }
__device__ __forceinline__ float xhalf_max(float m) { auto rr = __builtin_amdgcn_permlane32_swap(__float_as_uint(m), __float_as_uint(m), false, false); return fmaxf(__uint_as_float(rr[0]), __uint_as_float(rr[1])); }
__device__ __forceinline__ float xhalf_sum(float m) { auto rr = __builtin_amdgcn_permlane32_swap(__float_as_uint(m), __float_as_uint(m), false, false); return __uint_as_float(rr[0]) + __uint_as_float(rr[1]); }
__device__ __forceinline__ bf16x8 pack8(const f32x16& x, int s) {
    v4u p; p.x = cvtpk(x[8 * s], x[8 * s + 1]); p.y = cvtpk(x[8 * s + 2], x[8 * s + 3]); p.z = cvtpk(x[8 * s + 4], x[8 * s + 5]); p.w = cvtpk(x[8 * s + 6], x[8 * s + 7]);
    return __builtin_bit_cast(bf16x8, p);
}
constexpr float LOG2E = 1.4426950408889634f;
constexpr int AT_KSTR = 144, AT_VSTR = 192, AT_VOFF = 64 * AT_KSTR, AT_BUF = AT_VOFF + 64 * AT_VSTR;
constexpr float AT_THR = 8.0f;

__device__ __forceinline__ v4i16_t ds_tr_(const LAS unsigned char* p) { return __builtin_amdgcn_ds_read_tr16_b64_v4i16((LAS v4i16_t*)p); }

template <int MODE>
__device__ __forceinline__ void attn_unit(const bf16* P, bf16* NSA, const unsigned* selmask, LAS unsigned char* lds, int b, int g, int n) {
    const int tid = tid_opaque(), lane = tid & 63, wid = tid >> 6, q = lane & 31, h = lane >> 5;
    const int r = wid >> 1, th = wid & 1, head = g * NR + r;
    const int tl = 64 * n + 32 * th + q;
    const size_t rb = (size_t)b * SEQ, trow = rb + tl;
    bf16x8 qf[4];
    { const bf16* qp = P + trow * PP + PC_NQ + head * NDK + 8 * h;
#pragma unroll
      for (int ks = 0; ks < 4; ++ks) qf[ks] = __builtin_bit_cast(bf16x8, scale8(*(const v4u*)(qp + 16 * ks), 0.125f * LOG2E)); }
    const float slope2 = exp2f(-(float)(head + 1)) * LOG2E;
    const unsigned smask = MODE == 0 ? selmask[trow * NG + g] : 0u;
    const int j0 = MODE == 1 ? (n > 8 ? n - 8 : 0) : 0, j1 = n;
    f32x16 o0, o1;
#pragma unroll
    for (int i = 0; i < 16; ++i) { o0[i] = 0.f; o1[i] = 0.f; }
    float m = 0.f, l = 0.f; bool started = false;
    const int skey = tid >> 3, sch = tid & 7;
    const bf16* kg = P + (rb + skey) * PP + (MODE ? PC_KW : PC_KS) + g * NDK + 8 * sch;
    const bf16* vg = P + (rb + skey) * PP + (MODE ? PC_VW : PC_VS) + g * NDK + 8 * sch;
    v4u kreg = *(const v4u*)(kg + (size_t)(64 * j0) * PP), vreg = *(const v4u*)(vg + (size_t)(64 * j0) * PP);
#define AT_WRITE(bufi) do { LAS unsigned char* kb_ = lds + (bufi) * AT_BUF; *(LAS v4u*)(kb_ + skey * AT_KSTR + sch * 16) = kreg; *(LAS v4u*)(kb_ + AT_VOFF + skey * AT_VSTR + sch * 16) = vreg; } while (0)
    AT_WRITE(0);
    __syncthreads();
    const int vlane = (4 * h + ((lane & 15) >> 2)) * AT_VSTR + (16 * ((lane >> 4) & 1) + 4 * (lane & 3)) * 2;
    for (int j = j0; j <= j1; ++j) {
        const int cur = (j - j0) & 1;
        if (j < j1) { kreg = *(const v4u*)(kg + (size_t)(64 * (j + 1)) * PP); vreg = *(const v4u*)(vg + (size_t)(64 * (j + 1)) * PP); }
        LAS unsigned char* kb = lds + cur * AT_BUF;
        const bool lane_ok = MODE == 0 ? ((smask >> j) & 1u) != 0u : true;
        const float L = lane_ok ? slope2 * (float)(64 * j + 4 * h - tl) - m : -INFINITY;
        f32x16 s0, s1;
#pragma unroll
        for (int i = 0; i < 16; ++i) { const int kk = (i & 3) + 8 * (i >> 2); s0[i] = fmaf(slope2, (float)kk, L); s1[i] = fmaf(slope2, (float)(kk + 32), L); }
#pragma unroll
        for (int ks = 0; ks < 4; ++ks) {
            const bf16x8 a0 = *(const LAS bf16x8*)(kb + q * AT_KSTR + ks * 32 + h * 16);
            const bf16x8 a1 = *(const LAS bf16x8*)(kb + (q + 32) * AT_KSTR + ks * 32 + h * 16);
            s0 = MFMA32(a0, qf[ks], s0); s1 = MFMA32(a1, qf[ks], s1);
        }
        if ((j == n) || (MODE == 1 && j == n - 8)) {
            const int dbase = tl - 64 * j - 4 * h;
#pragma unroll
            for (int i = 0; i < 16; ++i) { const int kk = (i & 3) + 8 * (i >> 2), d0 = dbase - kk, d1 = d0 - 32;
                if (!(d0 >= 0 && (MODE == 0 || d0 < WIN))) s0[i] = -INFINITY;
                if (!(d1 >= 0 && (MODE == 0 || d1 < WIN))) s1[i] = -INFINITY; }
        }
        float mx = fmaxf(s0[0], s1[0]);
#pragma unroll
        for (int i = 1; i < 16; ++i) mx = fmaxf(mx, fmaxf(s0[i], s1[i]));
        mx = xhalf_max(mx);
        const bool fin = mx > -INFINITY;
        const bool resc = fin && (mx > AT_THR || !started);
        if (__any(resc)) {
            const float delta = resc ? mx : 0.f, alpha = started ? __builtin_amdgcn_exp2f(-delta) : 1.0f;
            m += delta; l *= alpha;
#pragma unroll
            for (int i = 0; i < 16; ++i) { s0[i] -= delta; s1[i] -= delta; o0[i] *= alpha; o1[i] *= alpha; }
        }
        started = started || fin;
        float ps = 0.f;
#pragma unroll
        for (int i = 0; i < 16; ++i) { s0[i] = __builtin_amdgcn_exp2f(s0[i]); s1[i] = __builtin_amdgcn_exp2f(s1[i]); ps += s0[i] + s1[i]; }
        l += ps;
        bf16x8 pf[4];
        pf[0] = pack8(s0, 0); pf[1] = pack8(s0, 1); pf[2] = pack8(s1, 0); pf[3] = pack8(s1, 1);
        const LAS unsigned char* vb = kb + AT_VOFF + vlane;
#pragma unroll
        for (int ks = 0; ks < 4; ++ks) {
            const LAS unsigned char* va = vb + 16 * ks * AT_VSTR;
            { const v4i16_t lo = ds_tr_(va), hi = ds_tr_(va + 8 * AT_VSTR);
              o0 = MFMA32(((bf16x8){lo[0], lo[1], lo[2], lo[3], hi[0], hi[1], hi[2], hi[3]}), pf[ks], o0); }
            { const v4i16_t lo = ds_tr_(va + 64), hi = ds_tr_(va + 64 + 8 * AT_VSTR);
              o1 = MFMA32(((bf16x8){lo[0], lo[1], lo[2], lo[3], hi[0], hi[1], hi[2], hi[3]}), pf[ks], o1); }
        }
        if (j < j1) AT_WRITE(cur ^ 1);
        __syncthreads();
    }
#undef AT_WRITE
    l = xhalf_sum(l);
    const float gate = pg8::fsig(bf2f(P[trow * PP + PC_GATE + (MODE ? 16 : 8) + head]));
    const float f = gate / l;
    bf16* op = NSA + trow * 512 + head * NDK + 4 * h;
#pragma unroll
    for (int dt = 0; dt < 2; ++dt)
#pragma unroll
        for (int rg = 0; rg < 4; ++rg) {
            const f32x16& o = dt ? o1 : o0;
            float v0 = o[4 * rg] * f, v1 = o[4 * rg + 1] * f, v2 = o[4 * rg + 2] * f, v3 = o[4 * rg + 3] * f;
            v2u* dst = (v2u*)(op + 32 * dt + 8 * rg);
            if (MODE == 0) { const v2u pv = *dst; v0 += pg8::bf_lo(pv.x); v1 += pg8::bf_hi(pv.x); v2 += pg8::bf_lo(pv.y); v3 += pg8::bf_hi(pv.y); }
            *dst = (v2u){cvtpk(v0, v1), cvtpk(v2, v3)};
        }
}
template <int MODE>
__device__ __forceinline__ void attn_phase(const Args& a, const bf16* P, bf16* NSA, LAS unsigned char* lds, int G, int id) {
    const unsigned* selmask = (const unsigned*)(a.ws + WS_SEL);
    __syncthreads();
    for (int u = id; u < NBATCH * NG * NS; u += G) {
        const int n = 31 - (u >> 5), bg = u & 31;
        attn_unit<MODE>(P, NSA, selmask, lds, bg >> 1, bg & 1, n);
    }
}


__device__ __forceinline__ v4i16_t ds_tr(const LAS unsigned char* p) { return __builtin_amdgcn_ds_read_tr16_b64_v4i16((LAS v4i16_t*)p); }
__device__ __forceinline__ bf16x8 tr_frag(const LAS unsigned char* base, int R, int k0, int n0, int lane) {
    const int grp = lane >> 4, li = lane & 15, qq = li >> 2, pp = li & 3, ngrp = grp & 1, hh = grp >> 1;
    const LAS unsigned char* a = base + (k0 + 8 * hh + qq) * R + (n0 + 16 * ngrp + 4 * pp) * 2;
    const v4i16_t lo = ds_tr(a), hi = ds_tr(a + 4 * R);
    return (bf16x8){lo[0], lo[1], lo[2], lo[3], hi[0], hi[1], hi[2], hi[3]};
}
__device__ __forceinline__ bf16x8 tr_frag_perm(const LAS unsigned char* base, int R, int k0, int n0, int lane) {
    const int grp = lane >> 4, li = lane & 15, qq = li >> 2, pp = li & 3, ngrp = grp & 1, hh = grp >> 1;
    const LAS unsigned char* a = base + (k0 + 4 * hh + qq) * R + (n0 + 16 * ngrp + 4 * pp) * 2;
    const v4i16_t lo = ds_tr(a), hi = ds_tr(a + 8 * R);
    return (bf16x8){lo[0], lo[1], lo[2], lo[3], hi[0], hi[1], hi[2], hi[3]};
}
__device__ __forceinline__ v4u scale8(v4u v, float sc) {
    v4u o;
#pragma unroll
    for (int i = 0; i < 4; ++i) o[i] = cvtpk(pg8::bf_lo(v[i]) * sc, pg8::bf_hi(v[i]) * sc);
    return o;
}
__device__ __forceinline__ float ret_lg2(int hd) { return log2f(1.0f - exp2f(-5.0f - (float)hd)); }

constexpr int RT_VSTR = 576, RT_KSTR = 320, RO_STR = 272;
constexpr size_t KV_UNIT = 256 * 128;
__device__ __forceinline__ void ret_kv_unit(const bf16* P, bf16* KVS, LAS unsigned char* lds, int b, int hd, int n) {
    const int tid = tid_opaque(), lane = tid & 63, wid = tid >> 6, h = lane >> 5;
    const float lg2 = ret_lg2(hd);
    LAS unsigned char* Vs = lds; LAS unsigned char* Ks = lds + 128 * RT_VSTR;
    const size_t rowbase = (size_t)b * SEQ + 128 * n;
    __syncthreads();
#pragma unroll
    for (int i = 0; i < 8; ++i) { const int idx = tid + 512 * i, row = idx >> 5, ch = idx & 31;
        *(LAS v4u*)(Vs + row * RT_VSTR + ch * 16) = *(const v4u*)(P + (rowbase + row) * PP + PC_RV + hd * RDV + 8 * ch); }
#pragma unroll
    for (int i = 0; i < 4; ++i) { const int idx = tid + 512 * i, row = idx >> 4, ch = idx & 15;
        const float sc = 0.08838834764831845f * exp2f(lg2 * (float)(127 - row));
        *(LAS v4u*)(Ks + row * RT_KSTR + ch * 16) = scale8(*(const v4u*)(P + (rowbase + row) * PP + PC_RK + hd * RDK + 8 * ch), sc); }
    __syncthreads();
    f32x16 acc[4];
#pragma unroll
    for (int d = 0; d < 4; ++d)
#pragma unroll
        for (int i = 0; i < 16; ++i) acc[d][i] = 0.f;
#pragma unroll 2
    for (int ks = 0; ks < 8; ++ks) {
        const bf16x8 A = tr_frag(Vs, RT_VSTR, 16 * ks, 32 * wid, lane);
#pragma unroll
        for (int dt = 0; dt < 4; ++dt) { const bf16x8 B = tr_frag(Ks, RT_KSTR, 16 * ks, 32 * dt, lane); acc[dt] = MFMA32(A, B, acc[dt]); }
    }
    bf16* ob = KVS + (size_t)(((b * RH + hd) * 16 + n)) * KV_UNIT;
#pragma unroll
    for (int dt = 0; dt < 4; ++dt)
#pragma unroll
        for (int i = 0; i < 16; ++i) { const int e = 32 * wid + (i & 3) + 8 * (i >> 2) + 4 * h, d = 32 * dt + (lane & 31); ob[e * 128 + d] = (bf16)f2bf(acc[dt][i]); }
}
__device__ __forceinline__ void ret_kv_phase(const bf16* P, bf16* KVS, LAS unsigned char* lds, int G, int id) {
    for (int u = id; u < NBATCH * RH * 16; u += G) ret_kv_unit(P, KVS, lds, u >> 6, (u >> 4) & 3, u & 15);
}
__device__ __forceinline__ void ret_scan_phase(bf16* KVS, int G) {
    for (int it = blockIdx.x * 512 + tid_opaque(); it < NBATCH * RH * 4096; it += G * 512) {
        const int bh = it >> 12, off = (it & 4095) * 8, hd = bh & 3;
        const float decay = exp2f(128.0f * ret_lg2(hd));
        float st[8];
#pragma unroll
        for (int i = 0; i < 8; ++i) st[i] = 0.f;
        bf16* p = KVS + (size_t)bh * 16 * KV_UNIT + off;
        for (int n = 0; n < 16; ++n, p += KV_UNIT) {
            const v4u v = *(const v4u*)p;
            *(v4u*)p = (v4u){cvtpk(st[0], st[1]), cvtpk(st[2], st[3]), cvtpk(st[4], st[5]), cvtpk(st[6], st[7])};
#pragma unroll
            for (int i = 0; i < 4; ++i) { st[2 * i] = st[2 * i] * decay + pg8::bf_lo(v[i]); st[2 * i + 1] = st[2 * i + 1] * decay + pg8::bf_hi(v[i]); }
        }
    }
}
constexpr int RO_QS = 0, RO_SB = 128 * RO_STR, RO_X = 2 * 128 * RO_STR, RO_STATS = RO_X + 128 * RT_VSTR;
static_assert(RO_STATS + 2048 <= 147456 && 256 * RO_STR <= 128 * RT_VSTR, "retention LDS map");
__device__ __forceinline__ void ret_out_unit(bf16* P, const bf16* KVS, const float* gn_g, LAS unsigned char* lds, int b, int hd, int n) {
    const int tid = tid_opaque(), lane = tid & 63, wid = tid >> 6, q = lane & 31, h = lane >> 5;
    const float lg2 = ret_lg2(hd);
    LAS unsigned char* Qs = lds + RO_QS; LAS unsigned char* Sb = lds + RO_SB; LAS unsigned char* X = lds + RO_X;
    const size_t rowbase = (size_t)b * SEQ + 128 * n;
    __syncthreads();
#pragma unroll
    for (int i = 0; i < 4; ++i) { const int idx = tid + 512 * i, row = idx >> 4, ch = idx & 15;
        const float e1 = exp2f(lg2 * (float)(row + 1));
        *(LAS v4u*)(Qs + row * RO_STR + ch * 16) = scale8(*(const v4u*)(P + (rowbase + row) * PP + PC_RQ + hd * RDK + 8 * ch), e1);
        *(LAS v4u*)(X + row * RO_STR + ch * 16) = scale8(*(const v4u*)(P + (rowbase + row) * PP + PC_RK + hd * RDK + 8 * ch), 0.08838834764831845f / e1); }
    __syncthreads();
    const int tt = wid & 3, sh = wid >> 2, trl = 32 * tt + q;
#pragma unroll
    for (int si = 0; si < 2; ++si) {
        const int st = 2 * sh + si;
        if (st > tt) {
#pragma unroll
            for (int rg = 0; rg < 4; ++rg) *(LAS v2u*)(Sb + trl * RO_STR + (32 * st + 8 * rg + 4 * h) * 2) = (v2u){0u, 0u};
        } else {
            f32x16 s;
#pragma unroll
            for (int i = 0; i < 16; ++i) s[i] = 0.f;
#pragma unroll
            for (int ks = 0; ks < 8; ++ks) {
                const bf16x8 a = *(const LAS bf16x8*)(X + (32 * st + q) * RO_STR + ks * 32 + h * 16);
                const bf16x8 bq = *(const LAS bf16x8*)(Qs + trl * RO_STR + ks * 32 + h * 16);
                s = MFMA32(a, bq, s);
            }
#pragma unroll
            for (int rg = 0; rg < 4; ++rg) { const int s0 = 32 * st + 8 * rg + 4 * h;
                const float v0 = (s0 <= trl) ? s[4 * rg] : 0.f, v1 = (s0 + 1 <= trl) ? s[4 * rg + 1] : 0.f, v2 = (s0 + 2 <= trl) ? s[4 * rg + 2] : 0.f, v3 = (s0 + 3 <= trl) ? s[4 * rg + 3] : 0.f;
                *(LAS v2u*)(Sb + trl * RO_STR + s0 * 2) = (v2u){cvtpk(v0, v1), cvtpk(v2, v3)}; }
        }
    }
    __syncthreads();
#pragma unroll
    for (int i = 0; i < 8; ++i) { const int idx = tid + 512 * i, row = idx >> 5, ch = idx & 31;
        *(LAS v4u*)(X + row * RT_VSTR + ch * 16) = *(const v4u*)(P + (rowbase + row) * PP + PC_RV + hd * RDV + 8 * ch); }
    __syncthreads();
    const int eh = wid >> 2;
    f32x16 acc[4];
#pragma unroll
    for (int d = 0; d < 4; ++d)
#pragma unroll
        for (int i = 0; i < 16; ++i) acc[d][i] = 0.f;
    for (int ks = 0; ks < 2 * (tt + 1); ++ks) {
        const bf16x8 bS = *(const LAS bf16x8*)(Sb + trl * RO_STR + ks * 32 + h * 16);
#pragma unroll
        for (int et = 0; et < 4; ++et) { const bf16x8 A = tr_frag(X, RT_VSTR, 16 * ks, 32 * (4 * eh + et), lane); acc[et] = MFMA32(A, bS, acc[et]); }
    }
    __syncthreads();
    { const bf16* rt = KVS + (size_t)(((b * RH + hd) * 16 + n)) * KV_UNIT;
#pragma unroll
      for (int i = 0; i < 8; ++i) { const int idx = tid + 512 * i, row = idx >> 4, ch = idx & 15;
          *(LAS v4u*)(X + row * RO_STR + ch * 16) = *(const v4u*)(rt + row * 128 + 8 * ch); } }
    __syncthreads();
#pragma unroll 2
    for (int ks = 0; ks < 8; ++ks) {
        const bf16x8 bQ = *(const LAS bf16x8*)(Qs + trl * RO_STR + ks * 32 + h * 16);
#pragma unroll
        for (int et = 0; et < 4; ++et) { const bf16x8 A = *(const LAS bf16x8*)(X + (32 * (4 * eh + et) + q) * RO_STR + ks * 32 + h * 16); acc[et] = MFMA32(A, bQ, acc[et]); }
    }
    float s1 = 0.f, s2 = 0.f;
#pragma unroll
    for (int et = 0; et < 4; ++et)
#pragma unroll
        for (int i = 0; i < 16; ++i) { s1 += acc[et][i]; s2 += acc[et][i] * acc[et][i]; }
    s1 = xhalf_sum(s1); s2 = xhalf_sum(s2);
    LAS float* stats = (LAS float*)(lds + RO_STATS);
    if (h == 0) { stats[(eh * 128 + trl) * 2] = s1; stats[(eh * 128 + trl) * 2 + 1] = s2; }
    __syncthreads();
    s1 = stats[trl * 2] + stats[(128 + trl) * 2]; s2 = stats[trl * 2 + 1] + stats[(128 + trl) * 2 + 1];
    const float mu = s1 * (1.f / 256.f), rstd = rsqrtf(fmaxf(s2 * (1.f / 256.f) - mu * mu, 0.f) + EPS);
    bf16* gp = P + (rowbase + trl) * PP + PC_RG + hd * RDV;
    const float* gg = gn_g + hd * RDV;
#pragma unroll
    for (int et = 0; et < 4; ++et)
#pragma unroll
        for (int rg = 0; rg < 4; ++rg) {
            const int e0 = 32 * (4 * eh + et) + 8 * rg + 4 * h;
            const v2u gv = *(const v2u*)(gp + e0); const f32x4 gn = *(const f32x4*)(gg + e0);
            const float g0 = pg8::bf_lo(gv.x), g1 = pg8::bf_hi(gv.x), g2 = pg8::bf_lo(gv.y), g3 = pg8::bf_hi(gv.y);
            const float o0 = (acc[et][4 * rg] - mu) * rstd * gn[0] * g0 * pg8::fsig(g0), o1 = (acc[et][4 * rg + 1] - mu) * rstd * gn[1] * g1 * pg8::fsig(g1);
            const float o2 = (acc[et][4 * rg + 2] - mu) * rstd * gn[2] * g2 * pg8::fsig(g2), o3 = (acc[et][4 * rg + 3] - mu) * rstd * gn[3] * g3 * pg8::fsig(g3);
            *(v2u*)(gp + e0) = (v2u){cvtpk(o0, o1), cvtpk(o2, o3)};
        }
}
__device__ __forceinline__ void ret_out_phase(bf16* P, const bf16* KVS, const float* gn_g, LAS unsigned char* lds, int G) {
    for (int u = blockIdx.x; u < NBATCH * RH * 16; u += G) ret_out_unit(P, KVS, gn_g, lds, u >> 6, (u >> 4) & 3, u & 15);
}

constexpr int CM_KSTR = 144, CM_VSTR = 192;
constexpr int CM_K = 0, CM_V = 128 * CM_KSTR, CM_GW = CM_V + 128 * CM_VSTR, CM_TW = CM_GW + 32768, CM_IMP = CM_TW + 32768;
__device__ __forceinline__ void cmp_unit(const bf16* P, bf16* NSA, const bf16* KC, const bf16* VC, unsigned* selmask, LAS unsigned char* lds, int b, int g, int n) {
    const int tid = tid_opaque(), lane = tid & 63, wid = tid >> 6, q = lane & 31, h = lane >> 5;
    const int r = wid >> 1, th = wid & 1, head = g * NR + r;
    const int tok = 32 * th + q, tl = 64 * n + tok;
    const size_t rb = (size_t)b * SEQ, trow = rb + tl;
    bf16x8 qf[4];
    { const bf16* qp = P + trow * PP + PC_NQ + head * NDK + 8 * h;
#pragma unroll
      for (int ks = 0; ks < 4; ++ks) qf[ks] = *(const bf16x8*)(qp + 16 * ks); }
    const float slope2 = exp2f(-(float)(head + 1)) * LOG2E, c1 = 0.125f * LOG2E;
    __syncthreads();
#pragma unroll
    for (int i = 0; i < 2; ++i) { const int idx = tid + 512 * i, row = idx >> 3, ch = idx & 7;
        v4u kv = (v4u){0u, 0u, 0u, 0u}, vv = kv;
        if (row < NC) { kv = *(const v4u*)(KC + ((size_t)(b * NG + g) * 128 + row) * NDK + 8 * ch); vv = *(const v4u*)(VC + ((size_t)(b * NG + g) * 128 + row) * NDK + 8 * ch); }
        *(LAS v4u*)(lds + CM_K + row * CM_KSTR + ch * 16) = kv; *(LAS v4u*)(lds + CM_V + row * CM_VSTR + ch * 16) = vv; }
    __syncthreads();
    const int ktmax = (4 * n + 2) >> 5;
    f32x16 s[4];
#pragma unroll
    for (int kt = 0; kt < 4; ++kt) {
#pragma unroll
        for (int i = 0; i < 16; ++i) s[kt][i] = 0.f;
        if (kt <= ktmax) {
#pragma unroll
            for (int ks = 0; ks < 4; ++ks) { const bf16x8 a = *(const LAS bf16x8*)(lds + CM_K + (32 * kt + q) * CM_KSTR + ks * 32 + h * 16); s[kt] = MFMA32(a, qf[ks], s[kt]); }
        }
    }
    float mx = -INFINITY;
#pragma unroll
    for (int kt = 0; kt < 4; ++kt)
#pragma unroll
        for (int i = 0; i < 16; ++i) { const int c = 32 * kt + (i & 3) + 8 * (i >> 2) + 4 * h, dc = tl - (c * CSTR + CBLK - 1);
            const float z = (dc >= 0 && kt <= ktmax) ? fmaf(s[kt][i], c1, -slope2 * (float)dc) : -INFINITY;
            s[kt][i] = z; mx = fmaxf(mx, z); }
    mx = xhalf_max(mx);
    const float mref = (mx == -INFINITY) ? 0.f : mx;
    float sum = 0.f;
#pragma unroll
    for (int kt = 0; kt < 4; ++kt)
#pragma unroll
        for (int i = 0; i < 16; ++i) { s[kt][i] = __builtin_amdgcn_exp2f(s[kt][i] - mref); sum += s[kt][i]; }
    sum = xhalf_sum(sum);
    const float inv = sum > 0.f ? 1.f / sum : 0.f;
    LAS float* GW = (LAS float*)(lds + CM_GW); LAS float* TW = (LAS float*)(lds + CM_TW);
#pragma unroll
    for (int kt = 0; kt < 4; ++kt) {
#pragma unroll
        for (int i = 0; i < 16; ++i) s[kt][i] *= inv;
#pragma unroll
        for (int rg = 0; rg < 4; ++rg) { const int j = 8 * kt + 2 * rg + h;
            GW[(r * 64 + tok) * 32 + j] = (s[kt][4 * rg] + s[kt][4 * rg + 1]) + (s[kt][4 * rg + 2] + s[kt][4 * rg + 3]);
            TW[(r * 64 + tok) * 32 + j] = s[kt][4 * rg + 3]; }
    }
    f32x16 o0, o1;
#pragma unroll
    for (int i = 0; i < 16; ++i) { o0[i] = 0.f; o1[i] = 0.f; }
#pragma unroll
    for (int kt = 0; kt < 4; ++kt) {
        if (kt <= ktmax) {
#pragma unroll
            for (int sp = 0; sp < 2; ++sp) { const bf16x8 pf = pack8(s[kt], sp);
                const bf16x8 A0 = tr_frag_perm(lds + CM_V, CM_VSTR, 32 * kt + 16 * sp, 0, lane), A1 = tr_frag_perm(lds + CM_V, CM_VSTR, 32 * kt + 16 * sp, 32, lane);
                o0 = MFMA32(A0, pf, o0); o1 = MFMA32(A1, pf, o1); }
        }
    }
    { const float gate = pg8::fsig(bf2f(P[trow * PP + PC_GATE + head]));
      bf16* op = NSA + trow * 512 + head * NDK + 4 * h;
#pragma unroll
      for (int dt = 0; dt < 2; ++dt)
#pragma unroll
          for (int rg = 0; rg < 4; ++rg) {
              const f32x16& o = dt ? o1 : o0;
              v2u* dst = (v2u*)(op + 32 * dt + 8 * rg); const v2u pv = *dst;
              const float v0 = o[4 * rg] * gate + pg8::bf_lo(pv.x), v1 = o[4 * rg + 1] * gate + pg8::bf_hi(pv.x), v2 = o[4 * rg + 2] * gate + pg8::bf_lo(pv.y), v3 = o[4 * rg + 3] * gate + pg8::bf_hi(pv.y);
              *dst = (v2u){cvtpk(v0, v1), cvtpk(v2, v3)};
          } }
    __syncthreads();
    LAS float* IMP = (LAS float*)(lds + CM_IMP);
    const int j = tid & 31;
#pragma unroll
    for (int pass = 0; pass < 4; ++pass) { const int tk = (tid >> 5) + 16 * pass;
        float imp = 0.f;
#pragma unroll
        for (int rr = 0; rr < 4; ++rr) { imp += GW[(rr * 64 + tk) * 32 + j]; if (j > 0) imp += TW[(rr * 64 + tk) * 32 + j - 1]; }
        if (j == 0 || j == n || j == n - 1) imp = 1e9f;
        if (j > n) imp = -1e9f;
        IMP[tk * 32 + j] = imp; }
    __syncthreads();
#pragma unroll
    for (int pass = 0; pass < 4; ++pass) { const int tk = (tid >> 5) + 16 * pass;
        const float mine = IMP[tk * 32 + j]; int rank = 0;
        for (int i = 0; i < 32; ++i) { const float o = IMP[tk * 32 + i]; rank += (o > mine || (o == mine && i < j)) ? 1 : 0; }
        const unsigned long long bal = __ballot(rank < TOPK && j <= n);
        if ((lane & 31) == 0) selmask[(rb + 64 * n + tk) * NG + g] = (unsigned)(bal >> (lane & 32)); }
}
__device__ __forceinline__ void cmp_phase(const Args& a, const bf16* P, bf16* NSA, LAS unsigned char* lds, int G) {
    const bf16* KC = (const bf16*)(a.ws + WS_KCMP); const bf16* VC = (const bf16*)(a.ws + WS_VCMP);
    unsigned* selmask = (unsigned*)(a.ws + WS_SEL);
    for (int u = blockIdx.x; u < NBATCH * NG * NS; u += G) {
        const int i = u & 255, k = u >> 8, aa = i & 15, hi = i >> 4;
        const int nn = (k & 2) ? ((aa + 8) & 15) : aa, n = (k & 1) ? 31 - nn : nn, bg = hi + 16 * (k >> 1);
        cmp_unit(P, NSA, KC, VC, selmask, lds, bg >> 1, bg & 1, n);
    }
}

__device__ __forceinline__ const Args* args_opaque() { auto p = __builtin_amdgcn_kernarg_segment_ptr(); asm volatile("" : "+s"(p)); return (const Args*)p; }
__global__ void __launch_bounds__(512, 2) mega_fwd(Args kernel_args) {
    extern __shared__ __attribute__((aligned(16))) unsigned char lds_raw[];
    LAS unsigned char* lds = (LAS unsigned char*)lds_raw;
    volatile LAS unsigned* MISC = (volatile LAS unsigned*)(lds + MISC_OFF);
    const int tid = tid_opaque(), G = gridDim.x;
    for (int u = tid; u < (LDS_BYTES - 131072) / 4; u += 512) ((LAS unsigned*)(lds + 131072))[u] = 0u;
    __syncthreads();
    XcdBarrier bar;
    { const Args& a = *args_opaque(); bar = xcd_barrier_post((unsigned*)(a.ws + WS_CTL) + CW_BAR, MISC + 8); }
#define PH_PRELUDE const Args& a = *args_opaque(); bf16* P = (bf16*)(a.ws + WS_PROJ); bf16* XB = (bf16*)((unsigned char*)a.out + DO_XB); bf16* NSA = (bf16*)((unsigned char*)a.out + DO_NSA); \
    bf16* KVS = (bf16*)((unsigned char*)a.out + DO_XB); float* rs2 = (float*)(a.ws + WS_RS2); float* rs3 = (float*)(a.ws + WS_RS3); float* rsdummy = (float*)(a.ws + 44 * MiB); \
    bf16* NSAdummy = (bf16*)((unsigned char*)a.out + 96 * MiB); (void)P; (void)XB; (void)NSA; (void)KVS; (void)rs2; (void)rs3; (void)rsdummy; (void)NSAdummy
#ifndef PROBE_REP
#define PROBE_REP 0
#endif
#define REPS(k) ((PROBE_REP == (k)) ? 2 : 1)
    for (int rep_ = 0; rep_ < REPS(1); ++rep_) { PH_PRELUDE;
    p0_prologue(a, lds, G);
    xcd_barrier(bar);
    }
    for (int rep_ = 0; rep_ < REPS(2); ++rep_) { PH_PRELUDE;
    { pg8::Gemm g{XB, (const bf16*)(a.ws + WS_WIN), DM, DM, 128, 256, (long)128 * DM * 2, (long)256 * DM * 2}; pg8::StaticOrder S; S.init(M, NPAD_IN, G, (int)blockIdx.x);
      pg8::EpiRowScale<0> E{P, PP, nullptr};
      pg8::gemm_phase<pg8::EpiRowScale<0>, pg8::StaticOrder, true, true>(lds, g, S, E); }
    xcd_barrier(bar);
    }
    for (int rep3_ = 0; rep3_ < REPS(3); ++rep3_) {
    for (int rep_ = 0; rep_ < REPS(4); ++rep_) { PH_PRELUDE;
    if (G >= 64 && blockIdx.x < 32) {
        for (int kv = 0; kv < 2; ++kv) {
            pg8::Gemm g{P + (kv ? PC_VCR : PC_KCR), (const bf16*)(a.ws + (kv ? WS_WC1V : WS_WC1K)), 16 * PP, CBLK * NDK, PP * 2, 2 * PP * 2, (long)NDK * 2, (long)SEQ * PP * 2};
            pg8::FewUnits S{NBATCH, (int)blockIdx.x - 16 * kv};
            pg8::EpiCompress E{(const float*)(a.ws + WS_CBIAS) + kv * CHID, (const bf16*)(a.ws + WS_W2T) + kv * (NDK * CHID), (bf16*)(a.ws + (kv ? WS_VCMP : WS_KCMP))};
            pg8::gemm_phase<pg8::EpiCompress, pg8::FewUnits, false, true>(lds, g, S, E);
        }
    } else if (G >= 64) {
        attn_phase<1>(a, P, NSA, lds, G - 32, (int)blockIdx.x - 32);
        ret_kv_phase(P, KVS, lds, G - 32, (int)blockIdx.x - 32);
    } else {
        n_compress(a, P, lds, G);
        attn_phase<1>(a, P, NSA, lds, G, (int)blockIdx.x);
        ret_kv_phase(P, KVS, lds, G, (int)blockIdx.x);
    }
    xcd_barrier(bar);
    }
    { PH_PRELUDE;
    cmp_phase(a, P, NSA, lds, G);
    ret_scan_phase(KVS, G);
    xcd_barrier(bar); }
    }
    { PH_PRELUDE;
    if (PROBE_REP == 9) attn_phase<0>(a, P, NSAdummy, lds, G, (int)blockIdx.x);
    attn_phase<0>(a, P, NSA, lds, G, (int)blockIdx.x);
    ret_out_phase(P, KVS, a.in[3], lds, G);
    xcd_barrier(bar); }
    for (int rep_ = 0; rep_ < REPS(5); ++rep_) { PH_PRELUDE;
    { pg8::Gemm g{P + PC_RG, (const bf16*)(a.ws + WS_WRO), PP, 1024, 128, 256, (long)128 * PP * 2, (long)256 * PP * 2}; pg8::StaticOrder S; S.init(M, DM, G, (int)blockIdx.x);
      pg8::EpiMerge<true> E{P + PC_MERGED, P + PC_GA, PP};
      pg8::gemm_phase<pg8::EpiMerge<true>, pg8::StaticOrder, true, true>(lds, g, S, E); }
    { pg8::Gemm g{NSA, (const bf16*)(a.ws + WS_WNO), 512, 512, 128, 256, (long)128 * 512 * 2, (long)256 * 512 * 2}; pg8::StaticOrder S; S.init(M, DM, G, (int)blockIdx.x);
      pg8::EpiMerge<false> E{P + PC_MERGED, P + PC_GB, PP};
      pg8::gemm_phase<pg8::EpiMerge<false>, pg8::StaticOrder, true, true>(lds, g, S, E); }
    xcd_barrier(bar);
    }
    for (int rep_ = 0; rep_ < REPS(6); ++rep_) { PH_PRELUDE;
    { pg8::Gemm g{P + PC_MERGED, (const bf16*)(a.ws + WS_WOUT), PP, DM, 128, 256, (long)128 * PP * 2, (long)256 * PP * 2}; pg8::StaticOrder S; S.init(M, DM, G, (int)blockIdx.x);
      pg8::EpiResid<true> E{a.in[0], a.out, P + PC_X1B, PP, (rep_ + 1 < REPS(6)) ? rsdummy : rs2};
      pg8::gemm_phase<pg8::EpiResid<true>, pg8::StaticOrder, true, true>(lds, g, S, E); }
    xcd_barrier(bar);
    }
    for (int rep8_ = 0; rep8_ < REPS(8); ++rep8_) {
    for (int rep_ = 0; rep_ < REPS(7); ++rep_) { PH_PRELUDE;
    { pg8::Gemm g{P + PC_X1B, (const bf16*)(a.ws + WS_WUP), PP, DM, 128, 256, (long)128 * PP * 2, (long)256 * PP * 2}; pg8::StaticOrder S; S.init(M, NUP, G, (int)blockIdx.x);
      pg8::EpiRowScale<1> E{P + PC_UP, PP, rs2};
      pg8::gemm_phase<pg8::EpiRowScale<1>, pg8::StaticOrder, true, true>(lds, g, S, E); }
    xcd_barrier(bar);
    }
    { PH_PRELUDE; n_conv(a, P, G); }
    xcd_barrier(bar);
    }
    { PH_PRELUDE;
    { pg8::Gemm g{P + PC_UP + 128, (const bf16*)(a.ws + WS_WDN), PP, DFF, 128, 512, (long)128 * PP * 2, (long)256 * PP * 2}; pg8::StaticOrder S; S.init(M, DM, G, (int)blockIdx.x);
      pg8::EpiResid<false> E{a.out, a.out, nullptr, 0, rs3};
      pg8::gemm_phase<pg8::EpiResid<false>, pg8::StaticOrder, true, true>(lds, g, S, E); }
    xcd_barrier(bar); }
    { const Args& a = *args_opaque(); n_final(a, G); }
}

extern "C" void kernel_launch(void* const* d_in, const int* in_sizes, int n_in, void* d_out, int out_size, void* d_ws, size_t ws_size, hipStream_t stream) {
    static int grid = 0;
    if (grid == 0) {
        if (n_in != 21 || out_size != M * DM || ws_size < WS_END) { fprintf(stderr, "kernel_launch: unexpected sizes n_in %d out %d ws %zu (need %zu)\n", n_in, out_size, ws_size, (size_t)WS_END); grid = -1; return; }
        int dev = 0, cus = 0;
        if (hipGetDevice(&dev) != hipSuccess || hipDeviceGetAttribute(&cus, hipDeviceAttributeMultiprocessorCount, dev) != hipSuccess) { grid = -1; return; }
        if (hipFuncSetAttribute((const void*)mega_fwd, hipFuncAttributeMaxDynamicSharedMemorySize, LDS_BYTES) != hipSuccess) { fprintf(stderr, "kernel_launch: hipFuncSetAttribute failed\n"); grid = -1; return; }
        grid = cus;
    }
    if (grid < 0) return;
    (void)hipMemsetAsync((char*)d_ws + WS_CTL, 0, CTL_ZERO_BYTES, stream);
    Args a{};
    for (int i = 0; i < 21; ++i) a.in[i] = (const float*)d_in[i];
    a.out = (float*)d_out; a.ws = (unsigned char*)d_ws;
    hipLaunchKernelGGL(mega_fwd, dim3(grid), dim3(512), LDS_BYTES, stream, a);
}
```

```cpp
#include <hip/hip_runtime.h>
#include <cstdio>
#include <cstdint>
namespace pg8 {
#define PG8_LAS __attribute__((address_space(3)))
typedef unsigned short bf16_t;
typedef short bf16x8 __attribute__((ext_vector_type(8)));
typedef float f32x4 __attribute__((ext_vector_type(4)));
typedef unsigned u32x4 __attribute__((ext_vector_type(4)));
constexpr int BM = 256, BK = 64, HALF = 128, HTB = HALF * BK * 2  , STAGE_BYTES = 8 * HTB, NXCD = 8, WGM = 8;

__host__ __device__ __forceinline__ int lds_byte(int r, int c) { const int st = (r >> 4) * 2 + (c >> 5), rr = r & 15, cc = c & 31, ob = rr * 64 + cc * 2; return st * 1024 + (ob ^ (((ob >> 9) & 1) << 5)); }
__host__ __device__ __forceinline__ void stage_rc(int b, int& R, int& C) { const int st = b / 1024, sb = b % 1024, swz = sb ^ (((sb >> 9) & 1) << 5); R = (st >> 1) * 16 + swz / 64; C = (st & 1) * 32 + (swz % 64) / 2; }
__host__ __device__ __forceinline__ int perm32(int rho) { const int n = rho >> 4, i = rho & 15; return 8 * (i >> 2) + 4 * n + (i & 3); }

struct Unit { int pm, pn; };
struct Gemm { const bf16_t* A; const bf16_t* Bt; int lda, K, ks1, ks2; long hsA, tsA; };

struct StaticOrder {
    int nM, nN, nwg, G, c;
    __host__ __device__ void init(int M, int N, int G_, int c_) { nM = M / BM; nN = N / BM; nwg = nM * nN; G = G_; c = c_; }
    __host__ __device__ bool next(int i, Unit& u) const {
        const long L = (long)i * G + c; if (L >= nwg) return false;
        int wgid = (int)L; { const int q = nwg / NXCD, r = nwg % NXCD, xcd = wgid % NXCD, off = wgid / NXCD; wgid = (xcd < r ? xcd * (q + 1) : r * (q + 1) + (xcd - r) * q) + off; }
        const int nig = WGM * nN, gid = wgid / nig, fm = gid * WGM, gsz = (nM - fm) < WGM ? (nM - fm) : WGM;
        u.pm = fm + ((wgid % nig) % gsz); u.pn = (wgid % nig) / gsz; return true;
    }
    __device__ __forceinline__ void a_ready(const Unit&) const {}
    __device__ __forceinline__ void done(const Unit&) const {}
};

__device__ __forceinline__ unsigned cvt_pk_bf16(float lo, float hi) { unsigned r; asm volatile("v_cvt_pk_bf16_f32 %0, %1, %2" : "=v"(r) : "v"(lo), "v"(hi)); return r; }
__device__ __forceinline__ float bf_lo(unsigned u) { return __builtin_bit_cast(float, u << 16); }
__device__ __forceinline__ float bf_hi(unsigned u) { return __builtin_bit_cast(float, u & 0xffff0000u); }
__device__ __forceinline__ float fsig(float x) { return __builtin_amdgcn_rcpf(1.f + __builtin_amdgcn_exp2f(-1.4426950408889634f * x)); }

template <int MODE> struct EpiRowScale {
    static constexpr bool PERM = true, AFTER_DRAIN = false;
    bf16_t* O; int ldc; const float* rs;
    __device__ __forceinline__ void operator()(const f32x4 (&acc)[2][2][4][2], const Unit& u, int wr, int wc, int fr, int fq) const {
        const int row0 = u.pm * BM + wr * 64 + fr, col0 = u.pn * BM + wc * 32 + 8 * fq;
#pragma unroll
        for (int ai = 0; ai < 2; ++ai)
#pragma unroll
            for (int m = 0; m < 4; ++m) { const int row = row0 + ai * HALF + m * 16; float s = 1.f;
                if (MODE == 1) s = __builtin_amdgcn_rsqf(rs[row] * (1.0f / 1024.0f) + 1e-6f);
                bf16_t* rowp = O + (size_t)row * ldc + col0;
#pragma unroll
                for (int bj = 0; bj < 2; ++bj) { const f32x4 v0 = acc[ai][bj][m][0] * s, v1 = acc[ai][bj][m][1] * s;
                    u32x4 w; w.x = cvt_pk_bf16(v0[0], v0[1]); w.y = cvt_pk_bf16(v0[2], v0[3]); w.z = cvt_pk_bf16(v1[0], v1[1]); w.w = cvt_pk_bf16(v1[2], v1[3]);
                    *(u32x4*)(rowp + bj * HALF) = w; } }
    }
};
template <bool FIRST> struct EpiMerge {
    static constexpr bool PERM = true, AFTER_DRAIN = false;
    bf16_t* O; const bf16_t* G; int ldc;
    __device__ __forceinline__ void operator()(const f32x4 (&acc)[2][2][4][2], const Unit& u, int wr, int wc, int fr, int fq) const {
        const int row0 = u.pm * BM + wr * 64 + fr, col0 = u.pn * BM + wc * 32 + 8 * fq;
#pragma unroll
        for (int ai = 0; ai < 2; ++ai)
#pragma unroll
            for (int m = 0; m < 4; ++m) { const size_t off = (size_t)(row0 + ai * HALF + m * 16) * ldc + col0;
#pragma unroll
                for (int bj = 0; bj < 2; ++bj) { const u32x4 gv = *(const u32x4*)(G + off + bj * HALF);
                    const f32x4 v0 = acc[ai][bj][m][0], v1 = acc[ai][bj][m][1];
                    float r[8];
                    r[0] = fsig(bf_lo(gv.x)) * v0[0]; r[1] = fsig(bf_hi(gv.x)) * v0[1]; r[2] = fsig(bf_lo(gv.y)) * v0[2]; r[3] = fsig(bf_hi(gv.y)) * v0[3];
                    r[4] = fsig(bf_lo(gv.z)) * v1[0]; r[5] = fsig(bf_hi(gv.z)) * v1[1]; r[6] = fsig(bf_lo(gv.w)) * v1[2]; r[7] = fsig(bf_hi(gv.w)) * v1[3];
                    if (!FIRST) { const u32x4 pv = *(const u32x4*)(O + off + bj * HALF);
                        r[0] += bf_lo(pv.x); r[1] += bf_hi(pv.x); r[2] += bf_lo(pv.y); r[3] += bf_hi(pv.y); r[4] += bf_lo(pv.z); r[5] += bf_hi(pv.z); r[6] += bf_lo(pv.w); r[7] += bf_hi(pv.w); }
                    u32x4 w; w.x = cvt_pk_bf16(r[0], r[1]); w.y = cvt_pk_bf16(r[2], r[3]); w.z = cvt_pk_bf16(r[4], r[5]); w.w = cvt_pk_bf16(r[6], r[7]);
                    *(u32x4*)(O + off + bj * HALF) = w; } }
    }
};
template <int MODE> struct EpiResid {
    static constexpr bool PERM = false, AFTER_DRAIN = false;
    const float* X; float* X1; bf16_t* Xb; int ldb; float* sumsq;
    __device__ __forceinline__ void operator()(const f32x4 (&acc)[2][2][4][2], const Unit& u, int wr, int wc, int fr, int fq) const {
        const int row0 = u.pm * BM + wr * 64 + fr, col0 = u.pn * BM + wc * 32 + 4 * fq;
#pragma unroll
        for (int ai = 0; ai < 2; ++ai)
#pragma unroll
            for (int m = 0; m < 4; ++m) { const int row = row0 + ai * HALF + m * 16; float ss = 0.f;
#pragma unroll
                for (int bj = 0; bj < 2; ++bj)
#pragma unroll
                    for (int n = 0; n < 2; ++n) { const int c = col0 + bj * HALF + n * 16;
                        f32x4 x;
                        if (MODE == 0) x = *(const f32x4*)(X + (size_t)row * 1024 + c);
                        else { const unsigned long long w = *(const unsigned long long*)(Xb + (size_t)row * ldb + c); const unsigned lo = (unsigned)w, hi = (unsigned)(w >> 32);
                               x = (f32x4){bf_lo(lo), bf_hi(lo), bf_lo(hi), bf_hi(hi)}; }
                        x = x + acc[ai][bj][m][n];
                        ss += (x[0] * x[0] + x[1] * x[1]) + (x[2] * x[2] + x[3] * x[3]);
                        if (MODE == 0) { const unsigned long long w = (unsigned long long)cvt_pk_bf16(x[0], x[1]) | ((unsigned long long)cvt_pk_bf16(x[2], x[3]) << 32);
                            *(unsigned long long*)(Xb + (size_t)row * ldb + c) = w; }
                        else *(f32x4*)(X1 + (size_t)row * 1024 + c) = x; }
                ss += __shfl_xor(ss, 16); ss += __shfl_xor(ss, 32);
                if (fq == 0) atomicAdd(sumsq + row, ss); }
    }
};
__device__ __forceinline__ float gelu_fast(float x) { return x * fsig(1.5957691216057308f * (x + 0.044715f * x * x * x)); }
typedef float f32x16 __attribute__((ext_vector_type(16)));
struct EpiCompress {
    static constexpr bool PERM = false, AFTER_DRAIN = true;
    const float* bias; const bf16_t* w2t; bf16_t* out;
    __device__ __forceinline__ void fused(f32x4 (&acc)[2][2][4][2], const Unit& u, int wr, int wc, int fr, int fq, PG8_LAS unsigned char* lds, int wid, int lane) const {
        const int col0 = wc * 32 + 4 * fq;
#pragma unroll
        for (int bj = 0; bj < 2; ++bj)
#pragma unroll
            for (int n = 0; n < 2; ++n) { const int c = col0 + bj * HALF + n * 16; const f32x4 bv = *(const f32x4*)(bias + c);
#pragma unroll
                for (int ai = 0; ai < 2; ++ai)
#pragma unroll
                    for (int m = 0; m < 4; ++m) { const int r = ai * HALF + wr * 64 + m * 16 + fr; const f32x4 v = acc[ai][bj][m][n] + bv;
                        const unsigned long long w = (unsigned long long)cvt_pk_bf16(gelu_fast(v[0]), gelu_fast(v[1])) | ((unsigned long long)cvt_pk_bf16(gelu_fast(v[2]), gelu_fast(v[3])) << 32);
                        *(PG8_LAS unsigned long long*)(lds + r * 528 + c * 2) = w; asm volatile("" ::: "memory"); } }
        asm volatile("s_waitcnt lgkmcnt(0)" ::: "memory"); __builtin_amdgcn_s_barrier(); asm volatile("" ::: "memory");
        const int q = lane & 31, h = lane >> 5;
        f32x16 o0, o1;
#pragma unroll
        for (int i = 0; i < 16; ++i) { o0[i] = 0.f; o1[i] = 0.f; }
#pragma unroll 4
        for (int ks = 0; ks < 16; ++ks) {
            const bf16x8 a = *(const PG8_LAS bf16x8*)(lds + (32 * wid + q) * 528 + ks * 32 + h * 16);
            const bf16x8 b0 = *(const bf16x8*)(w2t + q * 256 + 16 * ks + 8 * h), b1 = *(const bf16x8*)(w2t + (q + 32) * 256 + 16 * ks + 8 * h);
            o0 = __builtin_amdgcn_mfma_f32_32x32x16_bf16(a, b0, o0, 0, 0, 0); o1 = __builtin_amdgcn_mfma_f32_32x32x16_bf16(a, b1, o1, 0, 0, 0);
        }
#pragma unroll
        for (int i = 0; i < 16; ++i) { const int r = 32 * wid + (i & 3) + 8 * (i >> 2) + 4 * h, gg = r >> 7, c = r & 127;
            if (c < 127) { bf16_t* op = out + ((size_t)(u.pm * 2 + gg) * 128 + c) * 64 + q;
                op[0] = (bf16_t)(cvt_pk_bf16(o0[i], 0.f) & 0xffffu); op[32] = (bf16_t)(cvt_pk_bf16(o1[i], 0.f) & 0xffffu); } }
    }
};
struct FewUnits {
    int n, c;
    __device__ __forceinline__ bool next(int i, Unit& u) const { if (i != 0 || c >= n || c < 0) return false; u.pm = c; u.pn = 0; return true; }
    __device__ __forceinline__ void a_ready(const Unit&) const {}
    __device__ __forceinline__ void done(const Unit&) const {}
};

template <class Epi, class Sched, bool ALIGN_EPI = false, bool SP2 = false>
__device__ __forceinline__ void gemm_phase(PG8_LAS unsigned char* lds, const Gemm g, const Sched& S, const Epi& E) {
    int tid_ = threadIdx.x; asm volatile("" : "+v"(tid_));
    const int tid = tid_, wid = __builtin_amdgcn_readfirstlane(tid >> 6), lane = tid & 63, wr = wid >> 2, wc = wid & 3, fr = lane & 15, fq = lane >> 4;
    const int K = g.K, nt = K / BK;
    unsigned voffA[2], voffB[2];
#pragma unroll
    for (int i = 0; i < 2; ++i) { int R, C; stage_rc(tid * 16 + i * 8192, R, C); const int Rb = Epi::PERM ? ((R & ~31) + perm32(R & 31)) : R;
        voffA[i] = (unsigned)(R * g.lda + C) * 2u; voffB[i] = (unsigned)(Rb * K + C) * 2u; }
    const size_t kstep = (size_t)(BK * 2);
    const size_t hstepB = (size_t)HALF * K * 2, hstepA = (size_t)g.hsA, ks1 = (size_t)g.ks1, ks2 = (size_t)g.ks2;
    const size_t tstepA = (size_t)g.tsA, tstepB = 2 * hstepB;
    const unsigned ldsw = (unsigned)wid * 1024u;
    const int aoff = lds_byte(wr * 64 + fr, fq * 8), boff = lds_byte(wc * 32 + fr, fq * 8);
#define PG8_SA(b, h) (((b) * 2 + (h)) * HTB)
#define PG8_SB(b, h) ((4 + (b) * 2 + (h)) * HTB)
#define PG8_STAGE(bufoff, gbase, voff) do { _Pragma("unroll") for (int _i = 0; _i < 2; ++_i) \
        __builtin_amdgcn_global_load_lds((const unsigned*)((const char*)(gbase) + (voff)[_i]), (PG8_LAS unsigned*)(lds + (bufoff) + ldsw + _i * 8192), 16, 0, 0); } while (0)
#define PG8_LDA(dst, b, h) do { _Pragma("unroll") for (int m = 0; m < 4; ++m) _Pragma("unroll") for (int k = 0; k < 2; ++k) dst[m][k] = *(const PG8_LAS bf16x8*)(lds + PG8_SA(b, h) + aoff + m * 2048 + k * 1024); } while (0)
#define PG8_LDB(dst, b, h) do { _Pragma("unroll") for (int n = 0; n < 2; ++n) _Pragma("unroll") for (int k = 0; k < 2; ++k) dst[n][k] = *(const PG8_LAS bf16x8*)(lds + PG8_SB(b, h) + boff + n * 2048 + k * 1024); } while (0)
#define PG8_MMA(ai, bj, At, Bt) do { __builtin_amdgcn_s_setprio(1); _Pragma("unroll") for (int m = 0; m < 4; ++m) _Pragma("unroll") for (int n = 0; n < 2; ++n) _Pragma("unroll") for (int k = 0; k < 2; ++k) \
        acc[ai][bj][m][n] = __builtin_amdgcn_mfma_f32_16x16x32_bf16(Bt[n][k], At[m][k], acc[ai][bj][m][n], 0, 0, 0); __builtin_amdgcn_s_setprio(0); } while (0)
#define PG8_WAIT_V(n) asm volatile("s_waitcnt vmcnt(" #n ")" ::: "memory")
#define PG8_WAIT_L(n) asm volatile("s_waitcnt lgkmcnt(" #n ")" ::: "memory")
#define PG8_BAR __builtin_amdgcn_s_barrier()
#define PG8_SCHED __builtin_amdgcn_sched_barrier(0)
    Unit cur, nxt; int ui = 0;
    if (!S.next(0, cur)) return;
    f32x4 acc[2][2][4][2];
#pragma unroll
    for (int a = 0; a < 2; ++a)
#pragma unroll
        for (int b = 0; b < 2; ++b)
#pragma unroll
            for (int m = 0; m < 4; ++m)
#pragma unroll
                for (int n = 0; n < 2; ++n) acc[a][b][m][n] = (f32x4){0.f, 0.f, 0.f, 0.f};
    bf16x8 At[4][2], B0[2][2], B1[2][2];
    const char* cA = (const char*)g.A + (size_t)cur.pm * tstepA; const char* cB = (const char*)g.Bt + (size_t)cur.pn * tstepB;
    S.a_ready(cur);
    if constexpr (SP2) {
        PG8_STAGE(PG8_SB(0, 0), cB, voffB); PG8_STAGE(PG8_SB(0, 1), cB + hstepB, voffB); PG8_STAGE(PG8_SA(0, 0), cA, voffA); PG8_STAGE(PG8_SA(0, 1), cA + hstepA, voffA);
        if (wr == 1) PG8_BAR;
        PG8_WAIT_V(2); PG8_BAR;
        PG8_STAGE(PG8_SB(1, 0), cB + kstep, voffB); PG8_STAGE(PG8_SA(1, 0), cA + ks1, voffA); PG8_STAGE(PG8_SB(1, 1), cB + hstepB + kstep, voffB);
        PG8_WAIT_V(6); PG8_BAR;
    } else {
        PG8_STAGE(PG8_SB(0, 0), cB, voffB); PG8_STAGE(PG8_SA(0, 0), cA, voffA); PG8_STAGE(PG8_SB(0, 1), cB + hstepB, voffB); PG8_STAGE(PG8_SA(0, 1), cA + hstepA, voffA);
        if (wr == 1) PG8_BAR;
        PG8_WAIT_V(4); PG8_BAR;
        PG8_STAGE(PG8_SB(1, 0), cB + kstep, voffB); PG8_STAGE(PG8_SA(1, 0), cA + ks1, voffA); PG8_STAGE(PG8_SB(1, 1), cB + hstepB + kstep, voffB);
        PG8_WAIT_V(6); PG8_BAR;
    }
    for (;;) {
        const bool has_next = S.next(ui + 1, nxt);
        const char* nA = has_next ? (const char*)g.A + (size_t)nxt.pm * tstepA : cA; const char* nB = has_next ? (const char*)g.Bt + (size_t)nxt.pn * tstepB : cB;
        for (int t = 0; t < nt; t += 2) {
            const bool last = (t == nt - 2);
            const char* a1 = cA + (size_t)(t >> 1) * ks2 + ks1;
            const char* a2 = last ? nA : cA + (size_t)((t + 2) >> 1) * ks2; const char* b2 = last ? nB : cB + (size_t)(t + 2) * kstep;
            const char* a3 = a2 + ks1; const char* b3 = b2 + kstep;
            if (last && has_next) S.a_ready(nxt);
            if constexpr (SP2) {
            PG8_LDB(B0, 0, 0); PG8_LDB(B1, 0, 1); PG8_SCHED; PG8_LDA(At, 0, 0); PG8_STAGE(PG8_SA(1, 1), a1 + hstepA, voffA);
            PG8_WAIT_V(8); PG8_WAIT_L(0); PG8_BAR; PG8_MMA(0, 0, At, B0); PG8_MMA(0, 1, At, B1); PG8_BAR; PG8_SCHED;
            PG8_LDA(At, 0, 1); PG8_STAGE(PG8_SB(0, 0), b2, voffB); PG8_STAGE(PG8_SB(0, 1), b2 + hstepB, voffB); PG8_STAGE(PG8_SA(0, 0), a2, voffA);
            PG8_WAIT_V(8); PG8_WAIT_L(0); PG8_BAR; PG8_MMA(1, 0, At, B0); PG8_MMA(1, 1, At, B1); PG8_BAR; PG8_SCHED;
            PG8_LDB(B0, 1, 0); PG8_LDB(B1, 1, 1); PG8_SCHED; PG8_LDA(At, 1, 0); PG8_STAGE(PG8_SA(0, 1), a2 + hstepA, voffA);
            PG8_WAIT_V(8); PG8_WAIT_L(0); PG8_BAR; PG8_MMA(0, 0, At, B0); PG8_MMA(0, 1, At, B1); PG8_BAR; PG8_SCHED;
            PG8_LDA(At, 1, 1); PG8_STAGE(PG8_SB(1, 0), b3, voffB); PG8_STAGE(PG8_SB(1, 1), b3 + hstepB, voffB); PG8_STAGE(PG8_SA(1, 0), a3, voffA);
            PG8_WAIT_V(8); PG8_WAIT_L(0); PG8_BAR; PG8_MMA(1, 0, At, B0); PG8_MMA(1, 1, At, B1); PG8_BAR; PG8_SCHED;
            } else {
            PG8_LDB(B0, 0, 0); PG8_SCHED; PG8_LDA(At, 0, 0); PG8_STAGE(PG8_SA(1, 1), a1 + hstepA, voffA);
            PG8_WAIT_L(8); PG8_BAR; PG8_WAIT_L(0); PG8_MMA(0, 0, At, B0); PG8_BAR; PG8_SCHED;
            PG8_LDB(B1, 0, 1); PG8_STAGE(PG8_SB(0, 0), b2, voffB);
            PG8_BAR; PG8_WAIT_L(0); PG8_MMA(0, 1, At, B1); PG8_BAR;
            PG8_LDA(At, 0, 1); PG8_STAGE(PG8_SA(0, 0), a2, voffA);
            PG8_BAR; PG8_WAIT_L(0); PG8_MMA(1, 0, At, B0); PG8_BAR; PG8_SCHED;
            PG8_STAGE(PG8_SB(0, 1), b2 + hstepB, voffB);
            PG8_WAIT_V(6); PG8_BAR; PG8_MMA(1, 1, At, B1); PG8_BAR;
            PG8_LDB(B0, 1, 0); PG8_SCHED; PG8_LDA(At, 1, 0); PG8_STAGE(PG8_SA(0, 1), a2 + hstepA, voffA);
            PG8_WAIT_L(8); PG8_BAR; PG8_WAIT_L(0); PG8_MMA(0, 0, At, B0); PG8_BAR; PG8_SCHED;
            PG8_LDB(B1, 1, 1); PG8_STAGE(PG8_SB(1, 0), b3, voffB);
            PG8_BAR; PG8_WAIT_L(0); PG8_MMA(0, 1, At, B1); PG8_BAR;
            PG8_LDA(At, 1, 1); PG8_STAGE(PG8_SA(1, 0), a3, voffA);
            PG8_BAR; PG8_WAIT_L(0); PG8_MMA(1, 0, At, B0); PG8_BAR; PG8_SCHED;
            PG8_STAGE(PG8_SB(1, 1), b3 + hstepB, voffB);
            PG8_WAIT_V(6); PG8_BAR; PG8_MMA(1, 1, At, B1); PG8_BAR;
            }
        }
        if constexpr (ALIGN_EPI) { if (wr == 0) PG8_BAR; }
        if constexpr (!Epi::AFTER_DRAIN) { E(acc, cur, wr, wc, fr, fq); S.done(cur); }
        if (!has_next) break;
#pragma unroll
        for (int a = 0; a < 2; ++a)
#pragma unroll
            for (int b = 0; b < 2; ++b)
#pragma unroll
                for (int m = 0; m < 4; ++m)
#pragma unroll
                    for (int n = 0; n < 2; ++n) acc[a][b][m][n] = (f32x4){0.f, 0.f, 0.f, 0.f};
        cur = nxt; cA = nA; cB = nB; ++ui;
        if constexpr (ALIGN_EPI) { if (wr == 1) PG8_BAR; }
    }
    PG8_WAIT_V(0);
    if constexpr (!ALIGN_EPI) { if (wr == 0) PG8_BAR; }
    PG8_BAR;
    if constexpr (Epi::AFTER_DRAIN) { E.fused(acc, cur, wr, wc, fr, fq, lds, wid, lane); S.done(cur); }
#undef PG8_SA
#undef PG8_SB
#undef PG8_STAGE
#undef PG8_LDA
#undef PG8_LDB
#undef PG8_MMA
#undef PG8_WAIT_V
#undef PG8_WAIT_L
#undef PG8_BAR
#undef PG8_SCHED
}
}
constexpr int M = 32768, DM = 1024, SEQ = 2048, NBATCH = 16;
constexpr int RH = 4, RDK = 128, RDV = 256;
constexpr int NG = 2, NR = 4, NDK = 64, CBLK = 32, CSTR = 16, CHID = 256, TOPK = 8, WIN = 512;
constexpr int DFF = 2816, NIN = 6424;
constexpr int NC = SEQ / CSTR - 1;
constexpr int NS = SEQ / 64;
constexpr float EPS = 1e-6f;
constexpr int C_GATE = 4352, C_GA = 4376, C_GB = 5400;
constexpr int PP = 6656;
constexpr int PC_RQ = 0, PC_RK = 512, PC_RV = 1024, PC_RG = 2048, PC_NQ = 3072, PC_KCR = 3584, PC_VCR = 3712, PC_KS = 3840, PC_VS = 3968,
              PC_KW = 4096, PC_VW = 4224, PC_GA = 4352, PC_GB = 5376, PC_GATE = 6400;
constexpr int PC_MERGED = 1024, PC_X1B = 0, PC_UP = 1024;
constexpr int NPAD_IN = 6656, NUP = 2 * DFF;
constexpr size_t MiB = 1u << 20;
constexpr size_t WS_CTL = 0, CTL_ZERO_BYTES = 1 * MiB;
constexpr size_t WS_RS2 = 256 * 1024, WS_RS3 = 512 * 1024;
constexpr size_t WS_WIN = 1 * MiB, WS_WUP = 14 * MiB, WS_WDN = 25 * MiB, WS_WRO = 31 * MiB, WS_WNO = 33 * MiB, WS_WOUT = 34 * MiB;
constexpr size_t WS_KCMP = 39 * MiB, WS_VCMP = 41 * MiB, WS_SEL = 43 * MiB;
constexpr size_t WS_WC1K = 36 * MiB, WS_WC1V = 37 * MiB, WS_W2T = 38 * MiB, WS_CBIAS = 768 * 1024;
constexpr size_t WS_PROJ = 48 * MiB;
constexpr size_t WS_END = WS_PROJ + (size_t)(M + 32) * PP * 2;
static_assert(WS_END <= 512 * MiB, "d_ws map");
constexpr int CW_BAR = 4096;
constexpr size_t DO_XB = 0, DO_NSA = 64 * MiB;

constexpr int LDS_BYTES = 163840;
constexpr int MISC_OFF = 163840 - 512;

typedef unsigned short bf16;
typedef unsigned v4u __attribute__((ext_vector_type(4)));
typedef float f32x4 __attribute__((ext_vector_type(4)));
#define GAS __attribute__((address_space(1)))
#define LDS_WAIT() asm volatile("s_waitcnt lgkmcnt(0)" ::: "memory")
__device__ __forceinline__ unsigned f2bf(float f) { unsigned u = __builtin_bit_cast(unsigned, f); return (u + 0x7fffu + ((u >> 16) & 1u)) >> 16; }
__device__ __forceinline__ unsigned pk2(float lo, float hi) { return f2bf(lo) | (f2bf(hi) << 16); }
__device__ __forceinline__ float bf2f(bf16 v) { return __builtin_bit_cast(float, (unsigned)v << 16); }
__device__ __forceinline__ float wave_sum(float v) {
#pragma unroll
    for (int o = 1; o < 64; o <<= 1) v += __shfl_xor(v, o);
    return v;
}
__device__ __forceinline__ float wave_max(float v) {
#pragma unroll
    for (int o = 1; o < 64; o <<= 1) v = fmaxf(v, __shfl_xor(v, o));
    return v;
}
__device__ __forceinline__ float gelu_tanh(float x) { const float c = 0.7978845608028654f; return 0.5f * x * (1.f + tanhf(c * (x + 0.044715f * x * x * x))); }
__device__ __forceinline__ float sigmoidf_(float x) { return 1.f / (1.f + expf(-x)); }

__device__ __forceinline__ int tid_opaque() { int t = threadIdx.x; asm volatile("" : "+v"(t)); return t; }
#define XB_TMO      128
#define XB_XCNT(j)  (256  + 64 * (j))
#define XB_XSUB(j)  (1280 + 64 * (j))
#define XB_XGEN(j)  (2304 + 64 * (j))
#define XB_TOP      3328
#define XB_TOPGEN   3392
#define XCD_BAR_WORDS 3456
#define XB_SPIN_CAP (1u << 21)
#define LAS __attribute__((address_space(3)))

__device__ __forceinline__ unsigned xb_ld(unsigned* p)              { return __hip_atomic_load(p, __ATOMIC_RELAXED, __HIP_MEMORY_SCOPE_AGENT); }
__device__ __forceinline__ unsigned xb_add(unsigned* p, unsigned v) { return __hip_atomic_fetch_add(p, v, __ATOMIC_RELAXED, __HIP_MEMORY_SCOPE_AGENT); }
__device__ __forceinline__ unsigned xb_xcc_id() { return (unsigned)__builtin_amdgcn_s_getreg((3 << 11) | 20) & 0xFu; }
#define XB_SPIN(cond, bar) do { unsigned _sp = 0; while (cond) { __builtin_amdgcn_s_sleep(1); \
    if ((++_sp & 255u) == 0u) { if (xb_ld(&(bar)[XB_TMO])) break; if (_sp > XB_SPIN_CAP) { atomicAdd(&(bar)[XB_TMO], 1u); break; } } } } while (0)

struct XcdBarrier {
    unsigned* bar; unsigned x;
    volatile LAS unsigned* st;
};

__device__ __forceinline__ XcdBarrier xcd_barrier_post(unsigned* bar, volatile LAS unsigned* st) {
    XcdBarrier b; b.bar = bar; b.x = xb_xcc_id(); b.st = st;
    if (threadIdx.x == 0) (void)xb_add(&bar[XB_XCNT(b.x)], 1u);
    return b;
}
__device__ __forceinline__ void xcd_barrier_complete(unsigned* bar, unsigned x, unsigned& nloc, unsigned& nx) {
    const unsigned G = gridDim.x * gridDim.y * gridDim.z;
    unsigned sum, cnt, mine, sp = 0u;
    for (;;) {
        sum = 0u; cnt = 0u; mine = 0u;
#pragma unroll
        for (unsigned j = 0; j < 16; ++j) { const unsigned c = xb_ld(&bar[XB_XCNT(j)]); sum += c; cnt += (c > 0u) ? 1u : 0u; mine = (j == x) ? c : mine; }
        if (sum == G) break;
        __builtin_amdgcn_s_sleep(1);
        if ((++sp & 255u) == 0u) { if (xb_ld(&bar[XB_TMO])) break; if (sp > XB_SPIN_CAP) { atomicAdd(&bar[XB_TMO], 1u); break; } }
    }
    nloc = mine > 0u ? mine : 1u; nx = cnt > 0u ? cnt : 1u;
}

__device__ __forceinline__ void xcd_barrier(const XcdBarrier& b) {
    asm volatile("s_waitcnt vmcnt(0)" ::: "memory");
    __syncthreads();
    if (threadIdx.x == 0) {
        unsigned* bar = b.bar;
        __builtin_amdgcn_s_waitcnt(0);
        unsigned nloc = b.st[0], nx = b.st[1];
        if (nloc == 0u) { xcd_barrier_complete(bar, b.x, nloc, nx); b.st[0] = nloc; b.st[1] = nx; }
        const unsigned old = xb_add(&bar[XB_XSUB(b.x)], 1u);
        const unsigned gen = old / nloc;
        if (old + 1u == (gen + 1u) * nloc) {
            __builtin_amdgcn_fence(__ATOMIC_RELEASE, "agent");
            asm volatile("s_waitcnt vmcnt(0)" ::: "memory");
            const unsigned og = xb_add(&bar[XB_TOP], 1u);
            const unsigned tg = og / nx;
            if (og + 1u == (tg + 1u) * nx) xb_add(&bar[XB_TOPGEN], 1u);
            else XB_SPIN(xb_ld(&bar[XB_TOPGEN]) == tg, bar);
            __builtin_amdgcn_fence(__ATOMIC_ACQUIRE, "agent");
            xb_add(&bar[XB_XGEN(b.x)], 1u);
            asm volatile("s_waitcnt vmcnt(0)" ::: "memory");
        } else {
            XB_SPIN(xb_ld(&bar[XB_XGEN(b.x)]) == gen, bar);
            __builtin_amdgcn_fence(__ATOMIC_ACQUIRE, "agent");
            asm volatile("s_waitcnt vmcnt(0)" ::: "memory");
        }
    }
    __syncthreads();
}

struct Args { const float* in[21]; float* out; unsigned char* ws; };
__device__ __forceinline__ unsigned cvtpk(float lo, float hi);
typedef short v4i16_t __attribute__((ext_vector_type(4)));
__device__ __forceinline__ v4u scale8(v4u v, float sc);

struct MapIn { __device__ __forceinline__ int operator()(int n) const { return n < 4352 ? n : (n < 6400 ? n + 24 : (n < 6424 ? n - 2048 : -1)); } };
struct MapUp { __device__ __forceinline__ int operator()(int n) const { const int pn = n >> 8, j = n & 255; return j < 128 ? 128 * pn + j : DFF + 128 * pn + (j - 128); } };
struct MapId { __device__ __forceinline__ int operator()(int n) const { return n; } };
template <class MAP>
__device__ __forceinline__ void p0_transpose_item(const float* W, int K, int Nsrc, int nblk, bf16* WT, const float* ksc, LAS float* scr, int item, int lane, MAP map) {
    const int kb = item / nblk, nb = item % nblk, k0 = 64 * kb, n0 = 32 * nb;
    const int sc = map(n0 + (lane & 31));
#pragma unroll 8
    for (int i = 0; i < 32; ++i) { const int kk = 2 * i + (lane >> 5); float v = 0.f; if (sc >= 0) { v = W[(size_t)(k0 + kk) * Nsrc + sc]; if (ksc) v *= ksc[k0 + kk]; } scr[kk * 33 + (lane & 31)] = v; }
    LDS_WAIT(); asm volatile("" ::: "memory");
    const int c = lane & 7;
#pragma unroll
    for (int j = 0; j < 4; ++j) { const int n = (lane >> 3) + 8 * j; const LAS float* s = scr + (8 * c) * 33 + n;
        v4u o; o.x = pk2(s[0 * 33], s[1 * 33]); o.y = pk2(s[2 * 33], s[3 * 33]); o.z = pk2(s[4 * 33], s[5 * 33]); o.w = pk2(s[6 * 33], s[7 * 33]);
        *(GAS v4u*)(WT + (size_t)(n0 + n) * K + k0 + 8 * c) = o; }
    LDS_WAIT(); asm volatile("" ::: "memory");
}
__device__ __forceinline__ void p0_prologue(const Args& a, LAS unsigned char* lds, int G) {
    const int tid = tid_opaque(), lane = tid & 63, wave = tid >> 6;
    LAS float* scr = (LAS float*)(lds + wave * 16384);
    const int gw = blockIdx.x * 8 + wave, NGW = G * 8;
    unsigned char* ws = a.ws;
    constexpr int I_IN = 16 * (NPAD_IN / 32), I_UP = 16 * (NUP / 32), I_DN = (DFF / 64) * 32, I_RO = 16 * 32, I_NO = 8 * 32, I_OUT = 16 * 32;
    constexpr int NITEMS = I_IN + I_UP + I_DN + I_RO + I_NO + I_OUT;
    for (int it = gw; it < NITEMS; it += NGW) {
        int r = it;
        if (r < I_IN) { p0_transpose_item(a.in[2], DM, NIN, NPAD_IN / 32, (bf16*)(ws + WS_WIN), a.in[1], scr, r, lane, MapIn()); continue; } r -= I_IN;
        if (r < I_UP) { p0_transpose_item(a.in[16], DM, NUP, NUP / 32, (bf16*)(ws + WS_WUP), a.in[15], scr, r, lane, MapUp()); continue; } r -= I_UP;
        if (r < I_DN) { p0_transpose_item(a.in[19], DFF, DM, 32, (bf16*)(ws + WS_WDN), nullptr, scr, r, lane, MapId()); continue; } r -= I_DN;
        if (r < I_RO) { p0_transpose_item(a.in[12], 1024, DM, 32, (bf16*)(ws + WS_WRO), nullptr, scr, r, lane, MapId()); continue; } r -= I_RO;
        if (r < I_NO) { p0_transpose_item(a.in[13], 512, DM, 32, (bf16*)(ws + WS_WNO), nullptr, scr, r, lane, MapId()); continue; } r -= I_NO;
        p0_transpose_item(a.in[14], DM, DM, 32, (bf16*)(ws + WS_WOUT), nullptr, scr, r, lane, MapId());
    }
    for (int it = gw; it < 2 * 256; it += NGW) { const int kv = it >> 8, r = it & 255;
        p0_transpose_item(a.in[kv ? 9 : 5], 2048, CHID, CHID / 32, (bf16*)(ws + (kv ? WS_WC1V : WS_WC1K)), nullptr, scr, r, lane, MapId()); }
    for (int it = gw; it < 2 * 8; it += NGW) { const int kv = it >> 3, r = it & 7;
        p0_transpose_item(a.in[kv ? 11 : 7], CHID, NDK, 2, (bf16*)(ws + WS_W2T) + kv * (NDK * CHID), nullptr, scr, r, lane, MapId()); }
    for (int it = gw; it < 2 * 4 * 32; it += NGW) { const int kv = it >> 7, j = ((it >> 5) & 3) * 64 + lane, ksl = it & 31;
        const float* pos = a.in[kv ? 8 : 4]; const float* w1 = a.in[kv ? 9 : 5]; const float* b1 = a.in[kv ? 10 : 6];
        float acc = ksl == 0 ? b1[j] : 0.f;
#pragma unroll 16
        for (int k = ksl * 64; k < ksl * 64 + 64; ++k) acc += pos[k] * w1[(size_t)k * CHID + j];
        atomicAdd((float*)(ws + WS_CBIAS) + kv * CHID + j, acc); }
    bf16* XB = (bf16*)((unsigned char*)a.out + DO_XB);
    for (int m0 = gw * 4; m0 < M; m0 += NGW * 4) {
        f32x4 v[4][4];
#pragma unroll
        for (int r = 0; r < 4; ++r) { const GAS f32x4* xr = (const GAS f32x4*)(a.in[0] + (size_t)(m0 + r) * DM) + lane;
#pragma unroll
            for (int j = 0; j < 4; ++j) v[r][j] = xr[64 * j]; }
#pragma unroll
        for (int r = 0; r < 4; ++r) { float s = 0.f;
#pragma unroll
            for (int j = 0; j < 4; ++j) s += (v[r][j].x * v[r][j].x + v[r][j].y * v[r][j].y) + (v[r][j].z * v[r][j].z + v[r][j].w * v[r][j].w);
            const float rstd = rsqrtf(wave_sum(s) * (1.f / DM) + EPS);
            GAS unsigned long long* o8 = (GAS unsigned long long*)(XB + (size_t)(m0 + r) * DM) + lane;
#pragma unroll
            for (int j = 0; j < 4; ++j) o8[64 * j] = (unsigned long long)pk2(v[r][j].x * rstd, v[r][j].y * rstd) | ((unsigned long long)pk2(v[r][j].z * rstd, v[r][j].w * rstd) << 32); }
    }
}

__device__ __forceinline__ float ldp(const bf16* P, size_t row, int col) { return bf2f(P[row * PP + col]); }

__device__ __forceinline__ void n_compress(const Args& a, const bf16* P, LAS unsigned char* lds, int G) {
    const int tid = tid_opaque(), sub = tid >> 8, lt = tid & 255;
    LAS float* bv = (LAS float*)(lds + sub * 16384); LAS float* hid = bv + CBLK * NDK;
    for (int it = blockIdx.x; it < NBATCH * NC * 2; it += G) {
        const int u = it * 2 + sub, kv = u & 1, g = (u >> 1) & 1, c = (u >> 2) % NC, b = (u >> 2) / NC;
        const float* pos = a.in[kv ? 8 : 4]; const float* w1 = a.in[kv ? 9 : 5]; const float* b1 = a.in[kv ? 10 : 6]; const float* w2 = a.in[kv ? 11 : 7];
        bf16* out = (bf16*)(a.ws + (kv ? WS_VCMP : WS_KCMP));
        const int colbase = (kv ? PC_VCR : PC_KCR) + g * NDK;
        __syncthreads();
        for (int i = lt; i < CBLK * NDK; i += 256) { const int ii = i >> 6, d = i & 63; bv[i] = ldp(P, (size_t)b * SEQ + c * CSTR + ii, colbase + d) + pos[i]; }
        __syncthreads();
        float acc = b1[lt];
        for (int k = 0; k < CBLK * NDK; ++k) acc += bv[k] * w1[(size_t)k * CHID + lt];
        hid[lt] = gelu_tanh(acc);
        __syncthreads();
        if (lt < NDK) { float o = 0.f; for (int j = 0; j < CHID; ++j) o += hid[j] * w2[j * NDK + lt]; out[(((size_t)b * NG + g) * 128 + c) * NDK + lt] = (bf16)f2bf(o); }
    }
}

template <int MODE>
__device__ __forceinline__ void n_attn(const Args& a, const bf16* P, bf16* NSA, LAS unsigned char* lds, int G) {
    const int tid = tid_opaque(), sub = tid >> 8, r = (tid >> 6) & 3, lane = tid & 63;
    LAS float* qs = (LAS float*)(lds + sub * 16384) + r * 64;
    LAS float* scs = (LAS float*)(lds + sub * 16384 + 1024) + r * 576;
    LAS int* blks = (LAS int*)(lds + sub * 16384 + 1024 + 9216) + r * 12;
    const unsigned* selmask = (const unsigned*)(a.ws + WS_SEL);
    const int kcol = MODE ? PC_KW : PC_KS, vcol = MODE ? PC_VW : PC_VS;
    for (int it = blockIdx.x; it < M; it += G) {
        const int u = it * 2 + sub, g = u & 1, t = u >> 1, tl = t & (SEQ - 1), h = g * NR + r, cur = tl >> 6;
        const size_t rb = (size_t)(t - tl);
        const float slope = exp2f(-(float)(h + 1));
        __syncthreads();
        qs[lane] = ldp(P, t, PC_NQ + h * NDK + lane);
        unsigned mask;
        if (MODE) { const int lo = (tl - (WIN - 1)) > 0 ? ((tl - (WIN - 1)) >> 6) : 0; mask = 0u; for (int j = lo; j <= cur; ++j) mask |= 1u << j; }
        else mask = selmask[t * NG + g];
        int nb = 0;
        for (int j = 0; j < NS; ++j) if ((mask >> j) & 1u) { if (lane == 0) blks[nb] = j; ++nb; }
        __syncthreads();
        float m = -1e30f;
        for (int b = 0; b < nb; ++b) {
            const int s = blks[b] * 64 + lane; const int d = tl - s;
            const bool valid = d >= 0 && (!MODE || d < WIN);
            float sc = -1e30f;
            if (valid) { float dot = 0.f; const bf16* kr = P + (rb + s) * PP + kcol + g * NDK; for (int x = 0; x < NDK; ++x) dot += qs[x] * bf2f(kr[x]); sc = dot * 0.125f - slope * (float)d; }
            scs[b * 64 + lane] = sc; m = fmaxf(m, sc);
        }
        m = wave_max(m);
        float sum = 0.f;
        for (int b = 0; b < nb; ++b) { const float sc = scs[b * 64 + lane]; const float p = sc > -1e29f ? expf(sc - m) : 0.f; scs[b * 64 + lane] = p; sum += p; }
        sum = wave_sum(sum);
        __syncthreads();
        float o = 0.f;
        for (int b = 0; b < nb; ++b) {
            const int s0 = blks[b] * 64;
            for (int i = 0; i < 64; ++i) { const float p = scs[b * 64 + i]; if (p != 0.f) o += p * ldp(P, rb + s0 + i, vcol + g * NDK + lane); }
        }
        const float gate = sigmoidf_(ldp(P, t, PC_GATE + (MODE ? 16 : 8) + h));
        const size_t oi = (size_t)t * 512 + h * NDK + lane;
        float res = gate * o / sum;
        if (!MODE) res += bf2f(NSA[oi]);
        NSA[oi] = (bf16)f2bf(res);
    }
}

__device__ __forceinline__ void n_cmp(const Args& a, const bf16* P, bf16* NSA, LAS unsigned char* lds, int G) {
    const int tid = tid_opaque(), w = tid >> 6, lane = tid & 63;
    LAS float* qs = (LAS float*)(lds + w * 4096);
    LAS float* ps = qs + 256;
    const float* kcmp = (const float*)(a.ws + WS_KCMP); const float* vcmp = (const float*)(a.ws + WS_VCMP);
    unsigned* selmask = (unsigned*)(a.ws + WS_SEL);
    for (int it = blockIdx.x; it < M * NG / 8; it += G) {
        const int u = it * 8 + w, g = u & 1, t = u >> 1, tl = t & (SEQ - 1), b = t >> 11;
        const float* kc = kcmp + ((size_t)b * NG + g) * NC * NDK; const float* vc = vcmp + ((size_t)b * NG + g) * NC * NDK;
        __syncthreads();
        for (int r = 0; r < NR; ++r) qs[r * 64 + lane] = ldp(P, t, PC_NQ + (g * NR + r) * NDK + lane);
        __syncthreads();
        for (int r = 0; r < NR; ++r) {
            const int h = g * NR + r; const float slope = exp2f(-(float)(h + 1));
            float sc[2]; bool val[2];
#pragma unroll
            for (int q = 0; q < 2; ++q) {
                const int c = lane + 64 * q; sc[q] = -1e30f; val[q] = false;
                if (c < NC) {
                    float d = 0.f; const float* kr = kc + (size_t)c * NDK;
                    for (int x = 0; x < NDK; ++x) d += qs[r * 64 + x] * kr[x];
                    const int dc = tl - (c * CSTR + CBLK - 1);
                    if (dc >= 0) { val[q] = true; sc[q] = d * 0.125f - slope * (float)dc; }
                }
            }
            const float mx = wave_max(fmaxf(sc[0], sc[1]));
            float p0 = val[0] ? expf(sc[0] - mx) : 0.f, p1 = val[1] ? expf(sc[1] - mx) : 0.f;
            const float sum = wave_sum(p0 + p1);
            const float inv = sum > 0.f ? 1.f / sum : 0.f;
            ps[r * 128 + lane] = p0 * inv; ps[r * 128 + 64 + lane] = p1 * inv;
        }
        __syncthreads();
        for (int r = 0; r < NR; ++r) {
            const int h = g * NR + r;
            float o = 0.f;
            for (int c = 0; c < NC; ++c) o += ps[r * 128 + c] * vc[(size_t)c * NDK + lane];
            const float gate = sigmoidf_(ldp(P, t, PC_GATE + h));
            const size_t oi = (size_t)t * 512 + h * NDK + lane;
            NSA[oi] = (bf16)f2bf(bf2f(NSA[oi]) + gate * o);
        }
        float imp = 0.f; const int j = lane & 31;
        for (int r = 0; r < NR; ++r)
            for (int c = 4 * j - 1; c <= 4 * j + 3; ++c) if (c >= 0 && c < NC) imp += ps[r * 128 + c];
        const int cur = tl >> 6;
        if (j == 0 || j == cur || j == cur - 1) imp = 1e9f;
        if (j > cur) imp = -1e9f;
        int rank = 0;
        for (int i = 0; i < NS; ++i) { const float o = __shfl(imp, i); rank += (o > imp || (o == imp && i < j)) ? 1 : 0; }
        const unsigned long long bal = __ballot(rank < TOPK && lane < 32 && j <= cur);
        if (lane == 0) selmask[t * NG + g] = (unsigned)bal;
    }
}

__device__ __forceinline__ void n_retention(const Args& a, bf16* P, LAS unsigned char* lds, int G) {
    const int tid = tid_opaque(), sub = tid >> 8, lt = tid & 255;
    LAS float* Qs = (LAS float*)(lds + sub * 49152);
    LAS float* Ks = Qs + 32 * 129;
    LAS float* Vs = Ks + 16 * 129;
    LAS float* Ps = Vs + 16 * 256;
    const float* gn_g = a.in[3];
    for (int p = blockIdx.x; p < NBATCH * 2 * 64; p += G) {
        const int k_ = p >> 8, qt0 = p & 63, qt = (k_ & 1) ? 63 - qt0 : qt0, idx = p >> 6, hp = idx & 1, b = idx >> 1, h = hp * 2 + sub;
        const size_t rb = (size_t)b * SEQ;
        const float lg = log1pf(-exp2f(-5.0f - (float)h));
        const float scale = 0.08838834764831845f;
        __syncthreads();
        for (int i = lt; i < 32 * 128; i += 256) { const int r = i >> 7, c = i & 127; Qs[r * 129 + c] = ldp(P, rb + qt * 32 + r, PC_RQ + h * RDK + c); }
        float acc[32];
#pragma unroll
        for (int e = 0; e < 32; ++e) acc[e] = 0.f;
        const int pi = lt >> 3, pj0 = (lt & 7) * 2;
        for (int kt = 0; kt <= 2 * qt + 1; ++kt) {
            __syncthreads();
            for (int i = lt; i < 16 * 128; i += 256) { const int r = i >> 7, c = i & 127; Ks[r * 129 + c] = ldp(P, rb + kt * 16 + r, PC_RK + h * RDK + c); }
            for (int i = lt; i < 16 * 256; i += 256) { const int r = i >> 8, c = i & 255; Vs[r * 256 + c] = ldp(P, rb + kt * 16 + r, PC_RV + h * RDV + c); }
            __syncthreads();
#pragma unroll
            for (int jj = 0; jj < 2; ++jj) {
                const int j = pj0 + jj; float d = 0.f;
                for (int c = 0; c < 128; ++c) d += Qs[pi * 129 + c] * Ks[j * 129 + c];
                const int diff = (qt * 32 + pi) - (kt * 16 + j);
                Ps[pi * 17 + j] = diff >= 0 ? d * scale * expf(lg * (float)diff) : 0.f;
            }
            __syncthreads();
            for (int j = 0; j < 16; ++j) {
                const float pv = Ps[pi * 17 + j];
#pragma unroll
                for (int e = 0; e < 32; ++e) acc[e] += pv * Vs[j * 256 + (lt & 7) + 8 * e];
            }
        }
        float s = 0.f;
#pragma unroll
        for (int e = 0; e < 32; ++e) s += acc[e];
        s += __shfl_xor(s, 1); s += __shfl_xor(s, 2); s += __shfl_xor(s, 4);
        const float mu = s / 256.f;
        float q = 0.f;
#pragma unroll
        for (int e = 0; e < 32; ++e) { const float d = acc[e] - mu; q += d * d; }
        q += __shfl_xor(q, 1); q += __shfl_xor(q, 2); q += __shfl_xor(q, 4);
        const float rstd = rsqrtf(q / 256.f + EPS);
        const size_t t = rb + qt * 32 + pi;
#pragma unroll
        for (int e = 0; e < 32; ++e) {
            const int col = h * RDV + (lt & 7) + 8 * e;
            const float on = (acc[e] - mu) * rstd * gn_g[col];
            const float gg = ldp(P, t, PC_RG + col);
            P[t * PP + PC_RG + col] = (bf16)f2bf(gg * sigmoidf_(gg) * on);
        }
    }
}

__device__ __forceinline__ void n_conv(const Args& a, bf16* P, int G) {
    const float* cw = a.in[17]; const float* cb = a.in[18];
    constexpr int NF8 = DFF / 8, NITEM = (M / 16) * NF8;
    for (int it = blockIdx.x * 512 + tid_opaque(); it < NITEM; it += G * 512) {
        const int rblk = it / NF8, f8 = (it - rblk * NF8) * 8, pn = f8 >> 7, j = f8 & 127, t0 = rblk * 16, tl0 = t0 & (SEQ - 1);
        bf16* pa = P + (size_t)t0 * PP + PC_UP + 256 * pn + j;
        float w0[8], w1[8], w2[8], bb[8];
#pragma unroll
        for (int q = 0; q < 2; ++q) { const f32x4 c0 = *(const f32x4*)(cw + f8 + 4 * q), c1 = *(const f32x4*)(cw + DFF + f8 + 4 * q), c2 = *(const f32x4*)(cw + 2 * DFF + f8 + 4 * q), cc = *(const f32x4*)(cb + f8 + 4 * q);
#pragma unroll
            for (int e = 0; e < 4; ++e) { w0[4 * q + e] = c0[e]; w1[4 * q + e] = c1[e]; w2[4 * q + e] = c2[e]; bb[4 * q + e] = cc[e]; } }
        v4u p1 = (v4u){0u, 0u, 0u, 0u}, p2 = p1;
        if (tl0 != 0) { p1 = *(const v4u*)(pa - PP); p2 = *(const v4u*)(pa - 2 * PP); }
#pragma unroll 1
        for (int r0 = 0; r0 < 16; r0 += 4) {
            v4u av[4], bv[4];
#pragma unroll
            for (int r = 0; r < 4; ++r) { av[r] = *(const v4u*)(pa + (size_t)(r0 + r) * PP); bv[r] = *(const v4u*)(pa + (size_t)(r0 + r) * PP + 128); }
#pragma unroll
            for (int r = 0; r < 4; ++r) {
                unsigned o[4];
#pragma unroll
                for (int q = 0; q < 4; ++q) {
                    const float ac0 = bb[2 * q] + w2[2 * q] * pg8::bf_lo(av[r][q]) + w1[2 * q] * pg8::bf_lo(p1[q]) + w0[2 * q] * pg8::bf_lo(p2[q]);
                    const float ac1 = bb[2 * q + 1] + w2[2 * q + 1] * pg8::bf_hi(av[r][q]) + w1[2 * q + 1] * pg8::bf_hi(p1[q]) + w0[2 * q + 1] * pg8::bf_hi(p2[q]);
                    o[q] = cvtpk(pg8::gelu_fast(ac0) * pg8::bf_lo(bv[r][q]), pg8::gelu_fast(ac1) * pg8::bf_hi(bv[r][q]));
                }
                *(v4u*)(pa + (size_t)(r0 + r) * PP + 128) = (v4u){o[0], o[1], o[2], o[3]};
                p2 = p1; p1 = av[r];
            }
        }
    }
}

__device__ __forceinline__ void n_final(const Args& a, int G) {
    const int tid_ = tid_opaque(), lane = tid_ & 63, gw = blockIdx.x * 8 + (tid_ >> 6), NGW = G * 8;
    const float* rs3 = (const float*)(a.ws + WS_RS3); const float* gf = a.in[20];
    f32x4 gv[4];
#pragma unroll
    for (int j = 0; j < 4; ++j) gv[j] = *((const f32x4*)gf + lane + 64 * j);
    for (int m0 = gw * 4; m0 < M; m0 += NGW * 4) {
        f32x4 v[4][4]; float rstd[4];
#pragma unroll
        for (int r = 0; r < 4; ++r) { const f32x4* xr = (const f32x4*)(a.out + (size_t)(m0 + r) * DM) + lane;
#pragma unroll
            for (int j = 0; j < 4; ++j) v[r][j] = xr[64 * j];
            rstd[r] = rsqrtf(rs3[m0 + r] * (1.f / DM) + EPS); }
#pragma unroll
        for (int r = 0; r < 4; ++r) { f32x4* xr = (f32x4*)(a.out + (size_t)(m0 + r) * DM) + lane;
#pragma unroll
            for (int j = 0; j < 4; ++j) xr[64 * j] = v[r][j] * rstd[r] * gv[j]; }
    }
}

typedef short bf16x8 __attribute__((ext_vector_type(8)));
typedef float f32x16 __attribute__((ext_vector_type(16)));
typedef float f32x2_t __attribute__((ext_vector_type(2))); typedef __bf16 bf16x2_t __attribute__((ext_vector_type(2)));
typedef unsigned v2u __attribute__((ext_vector_type(2)));
#define MFMA32(a, b, c) __builtin_amdgcn_mfma_f32_32x32x16_bf16((a), (b), (c), 0, 0, 0)
__device__ __forceinline__ unsigned cvtpk(float lo, float hi) { f32x2_t v = {lo, hi}; bf16x2_t b = __builtin_convertvector(v, bf16x2_t); return __builtin_bit_cast(unsigned, b); }
__device__ __forceinline__ float xhalf_max(float m) { auto rr = __builtin_amdgcn_permlane32_swap(__float_as_uint(m), __float_as_uint(m), false, false); return fmaxf(__uint_as_float(rr[0]), __uint_as_float(rr[1])); }
__device__ __forceinline__ float xhalf_sum(float m) { auto rr = __builtin_amdgcn_permlane32_swap(__float_as_uint(m), __float_as_uint(m), false, false); return __uint_as_float(rr[0]) + __uint_as_float(rr[1]); }
__device__ __forceinline__ bf16x8 pack8(const f32x16& x, int s) {
    v4u p; p.x = cvtpk(x[8 * s], x[8 * s + 1]); p.y = cvtpk(x[8 * s + 2], x[8 * s + 3]); p.z = cvtpk(x[8 * s + 4], x[8 * s + 5]); p.w = cvtpk(x[8 * s + 6], x[8 * s + 7]);
    return __builtin_bit_cast(bf16x8, p);
}
constexpr float LOG2E = 1.4426950408889634f;
constexpr int AT_KSTR = 144, AT_VSTR = 192, AT_VOFF = 64 * AT_KSTR, AT_BUF = AT_VOFF + 64 * AT_VSTR;
constexpr float AT_THR = 8.0f;

__device__ __forceinline__ v4i16_t ds_tr_(const LAS unsigned char* p) { return __builtin_amdgcn_ds_read_tr16_b64_v4i16((LAS v4i16_t*)p); }

template <int MODE>
__device__ __forceinline__ void attn_unit(const bf16* P, bf16* NSA, const unsigned* selmask, LAS unsigned char* lds, int b, int g, int n) {
    const int tid = tid_opaque(), lane = tid & 63, wid = tid >> 6, q = lane & 31, h = lane >> 5;
    const int r = wid >> 1, th = wid & 1, head = g * NR + r;
    const int tl = 64 * n + 32 * th + q;
    const size_t rb = (size_t)b * SEQ, trow = rb + tl;
    bf16x8 qf[4];
    { const bf16* qp = P + trow * PP + PC_NQ + head * NDK + 8 * h;
#pragma unroll
      for (int ks = 0; ks < 4; ++ks) qf[ks] = __builtin_bit_cast(bf16x8, scale8(*(const v4u*)(qp + 16 * ks), 0.125f * LOG2E)); }
    const float slope2 = exp2f(-(float)(head + 1)) * LOG2E;
    const unsigned smask = MODE == 0 ? selmask[trow * NG + g] : 0u;
    const int j0 = MODE == 1 ? (n > 8 ? n - 8 : 0) : 0, j1 = n;
    f32x16 o0, o1;
#pragma unroll
    for (int i = 0; i < 16; ++i) { o0[i] = 0.f; o1[i] = 0.f; }
    float m = 0.f, l = 0.f; bool started = false;
    const int skey = tid >> 3, sch = tid & 7;
    const bf16* kg = P + (rb + skey) * PP + (MODE ? PC_KW : PC_KS) + g * NDK + 8 * sch;
    const bf16* vg = P + (rb + skey) * PP + (MODE ? PC_VW : PC_VS) + g * NDK + 8 * sch;
    v4u kreg = *(const v4u*)(kg + (size_t)(64 * j0) * PP), vreg = *(const v4u*)(vg + (size_t)(64 * j0) * PP);
#define AT_WRITE(bufi) do { LAS unsigned char* kb_ = lds + (bufi) * AT_BUF; *(LAS v4u*)(kb_ + skey * AT_KSTR + sch * 16) = kreg; *(LAS v4u*)(kb_ + AT_VOFF + skey * AT_VSTR + sch * 16) = vreg; } while (0)
    AT_WRITE(0);
    __syncthreads();
    const int vlane = (4 * h + ((lane & 15) >> 2)) * AT_VSTR + (16 * ((lane >> 4) & 1) + 4 * (lane & 3)) * 2;
    for (int j = j0; j <= j1; ++j) {
        const int cur = (j - j0) & 1;
        if (j < j1) { kreg = *(const v4u*)(kg + (size_t)(64 * (j + 1)) * PP); vreg = *(const v4u*)(vg + (size_t)(64 * (j + 1)) * PP); }
        LAS unsigned char* kb = lds + cur * AT_BUF;
        const bool lane_ok = MODE == 0 ? ((smask >> j) & 1u) != 0u : true;
        const float L = lane_ok ? slope2 * (float)(64 * j + 4 * h - tl) - m : -INFINITY;
        f32x16 s0, s1;
#pragma unroll
        for (int i = 0; i < 16; ++i) { const int kk = (i & 3) + 8 * (i >> 2); s0[i] = fmaf(slope2, (float)kk, L); s1[i] = fmaf(slope2, (float)(kk + 32), L); }
#pragma unroll
        for (int ks = 0; ks < 4; ++ks) {
            const bf16x8 a0 = *(const LAS bf16x8*)(kb + q * AT_KSTR + ks * 32 + h * 16);
            const bf16x8 a1 = *(const LAS bf16x8*)(kb + (q + 32) * AT_KSTR + ks * 32 + h * 16);
            s0 = MFMA32(a0, qf[ks], s0); s1 = MFMA32(a1, qf[ks], s1);
        }
        if ((j == n) || (MODE == 1 && j == n - 8)) {
            const int dbase = tl - 64 * j - 4 * h;
#pragma unroll
            for (int i = 0; i < 16; ++i) { const int kk = (i & 3) + 8 * (i >> 2), d0 = dbase - kk, d1 = d0 - 32;
                if (!(d0 >= 0 && (MODE == 0 || d0 < WIN))) s0[i] = -INFINITY;
                if (!(d1 >= 0 && (MODE == 0 || d1 < WIN))) s1[i] = -INFINITY; }
        }
        float mx = fmaxf(s0[0], s1[0]);
#pragma unroll
        for (int i = 1; i < 16; ++i) mx = fmaxf(mx, fmaxf(s0[i], s1[i]));
        mx = xhalf_max(mx);
        const bool fin = mx > -INFINITY;
        const bool resc = fin && (mx > AT_THR || !started);
        if (__any(resc)) {
            const float delta = resc ? mx : 0.f, alpha = started ? __builtin_amdgcn_exp2f(-delta) : 1.0f;
            m += delta; l *= alpha;
#pragma unroll
            for (int i = 0; i < 16; ++i) { s0[i] -= delta; s1[i] -= delta; o0[i] *= alpha; o1[i] *= alpha; }
        }
        started = started || fin;
        float ps = 0.f;
#pragma unroll
        for (int i = 0; i < 16; ++i) { s0[i] = __builtin_amdgcn_exp2f(s0[i]); s1[i] = __builtin_amdgcn_exp2f(s1[i]); ps += s0[i] + s1[i]; }
        l += ps;
        bf16x8 pf[4];
        pf[0] = pack8(s0, 0); pf[1] = pack8(s0, 1); pf[2] = pack8(s1, 0); pf[3] = pack8(s1, 1);
        const LAS unsigned char* vb = kb + AT_VOFF + vlane;
#pragma unroll
        for (int ks = 0; ks < 4; ++ks) {
            const LAS unsigned char* va = vb + 16 * ks * AT_VSTR;
            { const v4i16_t lo = ds_tr_(va), hi = ds_tr_(va + 8 * AT_VSTR);
              o0 = MFMA32(((bf16x8){lo[0], lo[1], lo[2], lo[3], hi[0], hi[1], hi[2], hi[3]}), pf[ks], o0); }
            { const v4i16_t lo = ds_tr_(va + 64), hi = ds_tr_(va + 64 + 8 * AT_VSTR);
              o1 = MFMA32(((bf16x8){lo[0], lo[1], lo[2], lo[3], hi[0], hi[1], hi[2], hi[3]}), pf[ks], o1); }
        }
        if (j < j1) AT_WRITE(cur ^ 1);
        __syncthreads();
    }
#undef AT_WRITE
    l = xhalf_sum(l);
    const float gate = pg8::fsig(bf2f(P[trow * PP + PC_GATE + (MODE ? 16 : 8) + head]));
    const float f = gate / l;
    bf16* op = NSA + trow * 512 + head * NDK + 4 * h;
#pragma unroll
    for (int dt = 0; dt < 2; ++dt)
#pragma unroll
        for (int rg = 0; rg < 4; ++rg) {
            const f32x16& o = dt ? o1 : o0;
            float v0 = o[4 * rg] * f, v1 = o[4 * rg + 1] * f, v2 = o[4 * rg + 2] * f, v3 = o[4 * rg + 3] * f;
            v2u* dst = (v2u*)(op + 32 * dt + 8 * rg);
            if (MODE == 0) { const v2u pv = *dst; v0 += pg8::bf_lo(pv.x); v1 += pg8::bf_hi(pv.x); v2 += pg8::bf_lo(pv.y); v3 += pg8::bf_hi(pv.y); }
            *dst = (v2u){cvtpk(v0, v1), cvtpk(v2, v3)};
        }
}
template <int MODE>
__device__ __forceinline__ void attn_phase(const Args& a, const bf16* P, bf16* NSA, LAS unsigned char* lds, int G, int id) {
    const unsigned* selmask = (const unsigned*)(a.ws + WS_SEL);
    __syncthreads();
    if (MODE == 0 && G == 256) {
        for (int k = 0; k < 4; ++k) { const int aa = id & 15, hi = id >> 4, nn = (k & 2) ? ((aa + 8) & 15) : aa;
            const int n = (k & 1) ? nn : 31 - nn, bg = hi + 16 * (k >> 1);
            attn_unit<MODE>(P, NSA, selmask, lds, bg >> 1, bg & 1, n); }
        return;
    }
    for (int u = id; u < NBATCH * NG * NS; u += G) {
        const int n = 31 - (u >> 5), bg = u & 31;
        attn_unit<MODE>(P, NSA, selmask, lds, bg >> 1, bg & 1, n);
    }
}


__device__ __forceinline__ v4i16_t ds_tr(const LAS unsigned char* p) { return __builtin_amdgcn_ds_read_tr16_b64_v4i16((LAS v4i16_t*)p); }
__device__ __forceinline__ bf16x8 tr_frag(const LAS unsigned char* base, int R, int k0, int n0, int lane) {
    const int grp = lane >> 4, li = lane & 15, qq = li >> 2, pp = li & 3, ngrp = grp & 1, hh = grp >> 1;
    const LAS unsigned char* a = base + (k0 + 8 * hh + qq) * R + (n0 + 16 * ngrp + 4 * pp) * 2;
    const v4i16_t lo = ds_tr(a), hi = ds_tr(a + 4 * R);
    return (bf16x8){lo[0], lo[1], lo[2], lo[3], hi[0], hi[1], hi[2], hi[3]};
}
__device__ __forceinline__ bf16x8 tr_frag_perm(const LAS unsigned char* base, int R, int k0, int n0, int lane) {
    const int grp = lane >> 4, li = lane & 15, qq = li >> 2, pp = li & 3, ngrp = grp & 1, hh = grp >> 1;
    const LAS unsigned char* a = base + (k0 + 4 * hh + qq) * R + (n0 + 16 * ngrp + 4 * pp) * 2;
    const v4i16_t lo = ds_tr(a), hi = ds_tr(a + 8 * R);
    return (bf16x8){lo[0], lo[1], lo[2], lo[3], hi[0], hi[1], hi[2], hi[3]};
}
__device__ __forceinline__ v4u scale8(v4u v, float sc) {
    v4u o;
#pragma unroll
    for (int i = 0; i < 4; ++i) o[i] = cvtpk(pg8::bf_lo(v[i]) * sc, pg8::bf_hi(v[i]) * sc);
    return o;
}
__device__ __forceinline__ float ret_lg2(int hd) { return log2f(1.0f - exp2f(-5.0f - (float)hd)); }

constexpr int RT_VSTR = 576, RT_KSTR = 320, RO_STR = 272;
constexpr size_t KV_UNIT = 256 * 128;
__device__ __forceinline__ void ret_kv_unit(const bf16* P, bf16* KVS, LAS unsigned char* lds, int b, int hd, int n) {
    const int tid = tid_opaque(), lane = tid & 63, wid = tid >> 6, h = lane >> 5;
    const float lg2 = ret_lg2(hd);
    LAS unsigned char* Vs = lds; LAS unsigned char* Ks = lds + 128 * RT_VSTR;
    const size_t rowbase = (size_t)b * SEQ + 128 * n;
    __syncthreads();
#pragma unroll
    for (int i = 0; i < 8; ++i) { const int idx = tid + 512 * i, row = idx >> 5, ch = idx & 31;
        *(LAS v4u*)(Vs + row * RT_VSTR + ch * 16) = *(const v4u*)(P + (rowbase + row) * PP + PC_RV + hd * RDV + 8 * ch); }
#pragma unroll
    for (int i = 0; i < 4; ++i) { const int idx = tid + 512 * i, row = idx >> 4, ch = idx & 15;
        const float sc = 0.08838834764831845f * exp2f(lg2 * (float)(127 - row));
        *(LAS v4u*)(Ks + row * RT_KSTR + ch * 16) = scale8(*(const v4u*)(P + (rowbase + row) * PP + PC_RK + hd * RDK + 8 * ch), sc); }
    __syncthreads();
    f32x16 acc[4];
#pragma unroll
    for (int d = 0; d < 4; ++d)
#pragma unroll
        for (int i = 0; i < 16; ++i) acc[d][i] = 0.f;
#pragma unroll 2
    for (int ks = 0; ks < 8; ++ks) {
        const bf16x8 A = tr_frag(Vs, RT_VSTR, 16 * ks, 32 * wid, lane);
#pragma unroll
        for (int dt = 0; dt < 4; ++dt) { const bf16x8 B = tr_frag(Ks, RT_KSTR, 16 * ks, 32 * dt, lane); acc[dt] = MFMA32(A, B, acc[dt]); }
    }
    bf16* ob = KVS + (size_t)(((b * RH + hd) * 16 + n)) * KV_UNIT;
#pragma unroll
    for (int dt = 0; dt < 4; ++dt)
#pragma unroll
        for (int i = 0; i < 16; ++i) { const int e = 32 * wid + (i & 3) + 8 * (i >> 2) + 4 * h, d = 32 * dt + (lane & 31); ob[e * 128 + d] = (bf16)f2bf(acc[dt][i]); }
}
__device__ __forceinline__ void ret_kv_phase(const bf16* P, bf16* KVS, LAS unsigned char* lds, int G, int id) {
    for (int u = id; u < NBATCH * RH * 16; u += G) ret_kv_unit(P, KVS, lds, u >> 6, (u >> 4) & 3, u & 15);
}
__device__ __forceinline__ void ret_scan_phase(bf16* KVS, int G) {
    for (int it = blockIdx.x * 512 + tid_opaque(); it < NBATCH * RH * 4096; it += G * 512) {
        const int bh = it >> 12, off = (it & 4095) * 8, hd = bh & 3;
        const float decay = exp2f(128.0f * ret_lg2(hd));
        bf16* p = KVS + (size_t)bh * 16 * KV_UNIT + off;
        v4u v[16];
#pragma unroll
        for (int n = 0; n < 16; ++n) v[n] = *(const v4u*)(p + (size_t)n * KV_UNIT);
        float st[8];
#pragma unroll
        for (int i = 0; i < 8; ++i) st[i] = 0.f;
#pragma unroll
        for (int n = 0; n < 16; ++n) {
            *(v4u*)(p + (size_t)n * KV_UNIT) = (v4u){cvtpk(st[0], st[1]), cvtpk(st[2], st[3]), cvtpk(st[4], st[5]), cvtpk(st[6], st[7])};
#pragma unroll
            for (int i = 0; i < 4; ++i) { st[2 * i] = st[2 * i] * decay + pg8::bf_lo(v[n][i]); st[2 * i + 1] = st[2 * i + 1] * decay + pg8::bf_hi(v[n][i]); }
        }
    }
}
constexpr int RO_QS = 0, RO_SB = 128 * RO_STR, RO_X = 2 * 128 * RO_STR, RO_STATS = RO_X + 128 * RT_VSTR;
static_assert(RO_STATS + 2048 <= 147456 && 256 * RO_STR <= 128 * RT_VSTR, "retention LDS map");
__device__ __forceinline__ void ret_out_unit(bf16* P, const bf16* KVS, const float* gn_g, LAS unsigned char* lds, int b, int hd, int n) {
    const int tid = tid_opaque(), lane = tid & 63, wid = tid >> 6, q = lane & 31, h = lane >> 5;
    const float lg2 = ret_lg2(hd);
    LAS unsigned char* Qs = lds + RO_QS; LAS unsigned char* Sb = lds + RO_SB; LAS unsigned char* X = lds + RO_X;
    const size_t rowbase = (size_t)b * SEQ + 128 * n;
    __syncthreads();
#pragma unroll
    for (int i = 0; i < 4; ++i) { const int idx = tid + 512 * i, row = idx >> 4, ch = idx & 15;
        const float e1 = exp2f(lg2 * (float)(row + 1));
        *(LAS v4u*)(Qs + row * RO_STR + ch * 16) = scale8(*(const v4u*)(P + (rowbase + row) * PP + PC_RQ + hd * RDK + 8 * ch), e1);
        *(LAS v4u*)(X + row * RO_STR + ch * 16) = scale8(*(const v4u*)(P + (rowbase + row) * PP + PC_RK + hd * RDK + 8 * ch), 0.08838834764831845f / e1); }
    __syncthreads();
    const int tt = wid & 3, sh = wid >> 2, trl = 32 * tt + q;
#pragma unroll
    for (int si = 0; si < 2; ++si) {
        const int st = 2 * sh + si;
        if (st > tt) {
#pragma unroll
            for (int rg = 0; rg < 4; ++rg) *(LAS v2u*)(Sb + trl * RO_STR + (32 * st + 8 * rg + 4 * h) * 2) = (v2u){0u, 0u};
        } else {
            f32x16 s;
#pragma unroll
            for (int i = 0; i < 16; ++i) s[i] = 0.f;
#pragma unroll
            for (int ks = 0; ks < 8; ++ks) {
                const bf16x8 a = *(const LAS bf16x8*)(X + (32 * st + q) * RO_STR + ks * 32 + h * 16);
                const bf16x8 bq = *(const LAS bf16x8*)(Qs + trl * RO_STR + ks * 32 + h * 16);
                s = MFMA32(a, bq, s);
            }
#pragma unroll
            for (int rg = 0; rg < 4; ++rg) { const int s0 = 32 * st + 8 * rg + 4 * h;
                const float v0 = (s0 <= trl) ? s[4 * rg] : 0.f, v1 = (s0 + 1 <= trl) ? s[4 * rg + 1] : 0.f, v2 = (s0 + 2 <= trl) ? s[4 * rg + 2] : 0.f, v3 = (s0 + 3 <= trl) ? s[4 * rg + 3] : 0.f;
                *(LAS v2u*)(Sb + trl * RO_STR + s0 * 2) = (v2u){cvtpk(v0, v1), cvtpk(v2, v3)}; }
        }
    }
    __syncthreads();
#pragma unroll
    for (int i = 0; i < 8; ++i) { const int idx = tid + 512 * i, row = idx >> 5, ch = idx & 31;
        *(LAS v4u*)(X + row * RT_VSTR + ch * 16) = *(const v4u*)(P + (rowbase + row) * PP + PC_RV + hd * RDV + 8 * ch); }
    __syncthreads();
    const int eh = wid >> 2;
    f32x16 acc[4];
#pragma unroll
    for (int d = 0; d < 4; ++d)
#pragma unroll
        for (int i = 0; i < 16; ++i) acc[d][i] = 0.f;
    for (int ks = 0; ks < 2 * (tt + 1); ++ks) {
        const bf16x8 bS = *(const LAS bf16x8*)(Sb + trl * RO_STR + ks * 32 + h * 16);
#pragma unroll
        for (int et = 0; et < 4; ++et) { const bf16x8 A = tr_frag(X, RT_VSTR, 16 * ks, 32 * (4 * eh + et), lane); acc[et] = MFMA32(A, bS, acc[et]); }
    }
    __syncthreads();
    { const bf16* rt = KVS + (size_t)(((b * RH + hd) * 16 + n)) * KV_UNIT;
#pragma unroll
      for (int i = 0; i < 8; ++i) { const int idx = tid + 512 * i, row = idx >> 4, ch = idx & 15;
          *(LAS v4u*)(X + row * RO_STR + ch * 16) = *(const v4u*)(rt + row * 128 + 8 * ch); } }
    __syncthreads();
#pragma unroll 2
    for (int ks = 0; ks < 8; ++ks) {
        const bf16x8 bQ = *(const LAS bf16x8*)(Qs + trl * RO_STR + ks * 32 + h * 16);
#pragma unroll
        for (int et = 0; et < 4; ++et) { const bf16x8 A = *(const LAS bf16x8*)(X + (32 * (4 * eh + et) + q) * RO_STR + ks * 32 + h * 16); acc[et] = MFMA32(A, bQ, acc[et]); }
    }
    float s1 = 0.f, s2 = 0.f;
#pragma unroll
    for (int et = 0; et < 4; ++et)
#pragma unroll
        for (int i = 0; i < 16; ++i) { s1 += acc[et][i]; s2 += acc[et][i] * acc[et][i]; }
    s1 = xhalf_sum(s1); s2 = xhalf_sum(s2);
    LAS float* stats = (LAS float*)(lds + RO_STATS);
    if (h == 0) { stats[(eh * 128 + trl) * 2] = s1; stats[(eh * 128 + trl) * 2 + 1] = s2; }
    __syncthreads();
    s1 = stats[trl * 2] + stats[(128 + trl) * 2]; s2 = stats[trl * 2 + 1] + stats[(128 + trl) * 2 + 1];
    const float mu = s1 * (1.f / 256.f), rstd = rsqrtf(fmaxf(s2 * (1.f / 256.f) - mu * mu, 0.f) + EPS);
    bf16* gp = P + (rowbase + trl) * PP + PC_RG + hd * RDV;
    const float* gg = gn_g + hd * RDV;
#pragma unroll
    for (int et = 0; et < 4; ++et)
#pragma unroll
        for (int rg = 0; rg < 4; ++rg) {
            const int e0 = 32 * (4 * eh + et) + 8 * rg + 4 * h;
            const v2u gv = *(const v2u*)(gp + e0); const f32x4 gn = *(const f32x4*)(gg + e0);
            const float g0 = pg8::bf_lo(gv.x), g1 = pg8::bf_hi(gv.x), g2 = pg8::bf_lo(gv.y), g3 = pg8::bf_hi(gv.y);
            const float o0 = (acc[et][4 * rg] - mu) * rstd * gn[0] * g0 * pg8::fsig(g0), o1 = (acc[et][4 * rg + 1] - mu) * rstd * gn[1] * g1 * pg8::fsig(g1);
            const float o2 = (acc[et][4 * rg + 2] - mu) * rstd * gn[2] * g2 * pg8::fsig(g2), o3 = (acc[et][4 * rg + 3] - mu) * rstd * gn[3] * g3 * pg8::fsig(g3);
            *(v2u*)(gp + e0) = (v2u){cvtpk(o0, o1), cvtpk(o2, o3)};
        }
}
__device__ __forceinline__ void ret_out_phase(bf16* P, const bf16* KVS, const float* gn_g, LAS unsigned char* lds, int G) {
    for (int u = blockIdx.x; u < NBATCH * RH * 16; u += G) ret_out_unit(P, KVS, gn_g, lds, u >> 6, (u >> 4) & 3, u & 15);
}

constexpr int CM_KSTR = 144, CM_VSTR = 192;
constexpr int CM_K = 0, CM_V = 128 * CM_KSTR, CM_GW = CM_V + 128 * CM_VSTR, CM_TW = CM_GW + 32768, CM_IMP = CM_TW + 32768;
__device__ __forceinline__ void cmp_unit(const bf16* P, bf16* NSA, const bf16* KC, const bf16* VC, unsigned* selmask, LAS unsigned char* lds, int b, int g, int n) {
    const int tid = tid_opaque(), lane = tid & 63, wid = tid >> 6, q = lane & 31, h = lane >> 5;
    const int r = wid >> 1, th = wid & 1, head = g * NR + r;
    const int tok = 32 * th + q, tl = 64 * n + tok;
    const size_t rb = (size_t)b * SEQ, trow = rb + tl;
    bf16x8 qf[4];
    { const bf16* qp = P + trow * PP + PC_NQ + head * NDK + 8 * h;
#pragma unroll
      for (int ks = 0; ks < 4; ++ks) qf[ks] = *(const bf16x8*)(qp + 16 * ks); }
    const float slope2 = exp2f(-(float)(head + 1)) * LOG2E, c1 = 0.125f * LOG2E;
    __syncthreads();
#pragma unroll
    for (int i = 0; i < 2; ++i) { const int idx = tid + 512 * i, row = idx >> 3, ch = idx & 7;
        v4u kv = (v4u){0u, 0u, 0u, 0u}, vv = kv;
        if (row < NC) { kv = *(const v4u*)(KC + ((size_t)(b * NG + g) * 128 + row) * NDK + 8 * ch); vv = *(const v4u*)(VC + ((size_t)(b * NG + g) * 128 + row) * NDK + 8 * ch); }
        *(LAS v4u*)(lds + CM_K + row * CM_KSTR + ch * 16) = kv; *(LAS v4u*)(lds + CM_V + row * CM_VSTR + ch * 16) = vv; }
    __syncthreads();
    const int ktmax = (4 * n + 2) >> 5;
    f32x16 s[4];
#pragma unroll
    for (int kt = 0; kt < 4; ++kt) {
#pragma unroll
        for (int i = 0; i < 16; ++i) s[kt][i] = 0.f;
        if (kt <= ktmax) {
#pragma unroll
            for (int ks = 0; ks < 4; ++ks) { const bf16x8 a = *(const LAS bf16x8*)(lds + CM_K + (32 * kt + q) * CM_KSTR + ks * 32 + h * 16); s[kt] = MFMA32(a, qf[ks], s[kt]); }
        }
    }
    float mx = -INFINITY;
#pragma unroll
    for (int kt = 0; kt < 4; ++kt)
#pragma unroll
        for (int i = 0; i < 16; ++i) { const int c = 32 * kt + (i & 3) + 8 * (i >> 2) + 4 * h, dc = tl - (c * CSTR + CBLK - 1);
            const float z = (dc >= 0 && kt <= ktmax) ? fmaf(s[kt][i], c1, -slope2 * (float)dc) : -INFINITY;
            s[kt][i] = z; mx = fmaxf(mx, z); }
    mx = xhalf_max(mx);
    const float mref = (mx == -INFINITY) ? 0.f : mx;
    float sum = 0.f;
#pragma unroll
    for (int kt = 0; kt < 4; ++kt)
#pragma unroll
        for (int i = 0; i < 16; ++i) { s[kt][i] = __builtin_amdgcn_exp2f(s[kt][i] - mref); sum += s[kt][i]; }
    sum = xhalf_sum(sum);
    const float inv = sum > 0.f ? 1.f / sum : 0.f;
    LAS float* GW = (LAS float*)(lds + CM_GW); LAS float* TW = (LAS float*)(lds + CM_TW);
#pragma unroll
    for (int kt = 0; kt < 4; ++kt) {
#pragma unroll
        for (int i = 0; i < 16; ++i) s[kt][i] *= inv;
#pragma unroll
        for (int rg = 0; rg < 4; ++rg) { const int j = 8 * kt + 2 * rg + h;
            GW[(r * 64 + tok) * 32 + j] = (s[kt][4 * rg] + s[kt][4 * rg + 1]) + (s[kt][4 * rg + 2] + s[kt][4 * rg + 3]);
            TW[(r * 64 + tok) * 32 + j] = s[kt][4 * rg + 3]; }
    }
    f32x16 o0, o1;
#pragma unroll
    for (int i = 0; i < 16; ++i) { o0[i] = 0.f; o1[i] = 0.f; }
#pragma unroll
    for (int kt = 0; kt < 4; ++kt) {
        if (kt <= ktmax) {
#pragma unroll
            for (int sp = 0; sp < 2; ++sp) { const bf16x8 pf = pack8(s[kt], sp);
                const bf16x8 A0 = tr_frag_perm(lds + CM_V, CM_VSTR, 32 * kt + 16 * sp, 0, lane), A1 = tr_frag_perm(lds + CM_V, CM_VSTR, 32 * kt + 16 * sp, 32, lane);
                o0 = MFMA32(A0, pf, o0); o1 = MFMA32(A1, pf, o1); }
        }
    }
    { const float gate = pg8::fsig(bf2f(P[trow * PP + PC_GATE + head]));
      bf16* op = NSA + trow * 512 + head * NDK + 4 * h;
#pragma unroll
      for (int dt = 0; dt < 2; ++dt)
#pragma unroll
          for (int rg = 0; rg < 4; ++rg) {
              const f32x16& o = dt ? o1 : o0;
              v2u* dst = (v2u*)(op + 32 * dt + 8 * rg); const v2u pv = *dst;
              const float v0 = o[4 * rg] * gate + pg8::bf_lo(pv.x), v1 = o[4 * rg + 1] * gate + pg8::bf_hi(pv.x), v2 = o[4 * rg + 2] * gate + pg8::bf_lo(pv.y), v3 = o[4 * rg + 3] * gate + pg8::bf_hi(pv.y);
              *dst = (v2u){cvtpk(v0, v1), cvtpk(v2, v3)};
          } }
    __syncthreads();
    LAS float* IMP = (LAS float*)(lds + CM_IMP);
    const int j = tid & 31;
#pragma unroll
    for (int pass = 0; pass < 4; ++pass) { const int tk = (tid >> 5) + 16 * pass;
        float imp = 0.f;
#pragma unroll
        for (int rr = 0; rr < 4; ++rr) { imp += GW[(rr * 64 + tk) * 32 + j]; if (j > 0) imp += TW[(rr * 64 + tk) * 32 + j - 1]; }
        if (j == 0 || j == n || j == n - 1) imp = 1e9f;
        if (j > n) imp = -1e9f;
        IMP[tk * 32 + j] = imp; }
    __syncthreads();
#pragma unroll
    for (int pass = 0; pass < 4; ++pass) { const int tk = (tid >> 5) + 16 * pass;
        const float mine = IMP[tk * 32 + j]; int rank = 0;
        for (int i = 0; i < 32; ++i) { const float o = IMP[tk * 32 + i]; rank += (o > mine || (o == mine && i < j)) ? 1 : 0; }
        const unsigned long long bal = __ballot(rank < TOPK && j <= n);
        if ((lane & 31) == 0) selmask[(rb + 64 * n + tk) * NG + g] = (unsigned)(bal >> (lane & 32)); }
}
__device__ __forceinline__ void cmp_phase(const Args& a, const bf16* P, bf16* NSA, LAS unsigned char* lds, int G) {
    const bf16* KC = (const bf16*)(a.ws + WS_KCMP); const bf16* VC = (const bf16*)(a.ws + WS_VCMP);
    unsigned* selmask = (unsigned*)(a.ws + WS_SEL);
    for (int u = blockIdx.x; u < NBATCH * NG * NS; u += G) {
        const int i = u & 255, k = u >> 8, aa = i & 15, hi = i >> 4;
        const int nn = (k & 2) ? ((aa + 8) & 15) : aa, n = (k & 1) ? 31 - nn : nn, bg = hi + 16 * (k >> 1);
        cmp_unit(P, NSA, KC, VC, selmask, lds, bg >> 1, bg & 1, n);
    }
}

__device__ __forceinline__ const Args* args_opaque() { auto p = __builtin_amdgcn_kernarg_segment_ptr(); asm volatile("" : "+s"(p)); return (const Args*)p; }
__global__ void __launch_bounds__(512, 2) mega_fwd(Args kernel_args) {
    extern __shared__ __attribute__((aligned(16))) unsigned char lds_raw[];
    LAS unsigned char* lds = (LAS unsigned char*)lds_raw;
    volatile LAS unsigned* MISC = (volatile LAS unsigned*)(lds + MISC_OFF);
    const int tid = tid_opaque(), G = gridDim.x;
    for (int u = tid; u < (LDS_BYTES - 131072) / 4; u += 512) ((LAS unsigned*)(lds + 131072))[u] = 0u;
    __syncthreads();
    XcdBarrier bar;
    { const Args& a = *args_opaque(); bar = xcd_barrier_post((unsigned*)(a.ws + WS_CTL) + CW_BAR, MISC + 8); }
#define PH_PRELUDE const Args& a = *args_opaque(); bf16* P = (bf16*)(a.ws + WS_PROJ); bf16* XB = (bf16*)((unsigned char*)a.out + DO_XB); bf16* NSA = (bf16*)((unsigned char*)a.out + DO_NSA); \
    bf16* KVS = (bf16*)((unsigned char*)a.out + DO_XB); float* rs2 = (float*)(a.ws + WS_RS2); float* rs3 = (float*)(a.ws + WS_RS3); float* rsdummy = (float*)(a.ws + 44 * MiB); \
    bf16* NSAdummy = (bf16*)((unsigned char*)a.out + 96 * MiB); (void)P; (void)XB; (void)NSA; (void)KVS; (void)rs2; (void)rs3; (void)rsdummy; (void)NSAdummy
#ifndef PROBE_REP
#define PROBE_REP 0
#endif
#define REPS(k) ((PROBE_REP == (k)) ? 2 : 1)
    for (int rep_ = 0; rep_ < REPS(1); ++rep_) { PH_PRELUDE;
    p0_prologue(a, lds, G);
    xcd_barrier(bar);
    }
    for (int rep_ = 0; rep_ < REPS(2); ++rep_) { PH_PRELUDE;
    { pg8::Gemm g{XB, (const bf16*)(a.ws + WS_WIN), DM, DM, 128, 256, (long)128 * DM * 2, (long)256 * DM * 2}; pg8::StaticOrder S; S.init(M, NPAD_IN, G, (int)blockIdx.x);
      pg8::EpiRowScale<0> E{P, PP, nullptr};
      pg8::gemm_phase<pg8::EpiRowScale<0>, pg8::StaticOrder, true, true>(lds, g, S, E); }
    xcd_barrier(bar);
    }
    for (int rep3_ = 0; rep3_ < REPS(3); ++rep3_) {
    for (int rep_ = 0; rep_ < REPS(4); ++rep_) { PH_PRELUDE;
    if (G >= 64 && blockIdx.x < 32) {
        for (int kv = 0; kv < 2; ++kv) {
            pg8::Gemm g{P + (kv ? PC_VCR : PC_KCR), (const bf16*)(a.ws + (kv ? WS_WC1V : WS_WC1K)), 16 * PP, CBLK * NDK, PP * 2, 2 * PP * 2, (long)NDK * 2, (long)SEQ * PP * 2};
            pg8::FewUnits S{NBATCH, (int)blockIdx.x - 16 * kv};
            pg8::EpiCompress E{(const float*)(a.ws + WS_CBIAS) + kv * CHID, (const bf16*)(a.ws + WS_W2T) + kv * (NDK * CHID), (bf16*)(a.ws + (kv ? WS_VCMP : WS_KCMP))};
            pg8::gemm_phase<pg8::EpiCompress, pg8::FewUnits, false, true>(lds, g, S, E);
        }
    } else if (G >= 64) {
        attn_phase<1>(a, P, NSA, lds, G - 32, (int)blockIdx.x - 32);
        ret_kv_phase(P, KVS, lds, G - 32, (int)blockIdx.x - 32);
    } else {
        n_compress(a, P, lds, G);
        attn_phase<1>(a, P, NSA, lds, G, (int)blockIdx.x);
        ret_kv_phase(P, KVS, lds, G, (int)blockIdx.x);
    }
    xcd_barrier(bar);
    }
    { PH_PRELUDE;
    cmp_phase(a, P, NSA, lds, G);
    ret_scan_phase(KVS, G);
    xcd_barrier(bar); }
    }
    { PH_PRELUDE;
    if (PROBE_REP == 9) attn_phase<0>(a, P, NSAdummy, lds, G, (int)blockIdx.x);
    attn_phase<0>(a, P, NSA, lds, G, (int)blockIdx.x);
    ret_out_phase(P, KVS, a.in[3], lds, G);
    xcd_barrier(bar); }
    for (int rep_ = 0; rep_ < REPS(5); ++rep_) { PH_PRELUDE;
    { pg8::Gemm g{P + PC_RG, (const bf16*)(a.ws + WS_WRO), PP, 1024, 128, 256, (long)128 * PP * 2, (long)256 * PP * 2}; pg8::StaticOrder S; S.init(M, DM, G, (int)blockIdx.x);
      pg8::EpiMerge<true> E{P + PC_MERGED, P + PC_GA, PP};
      pg8::gemm_phase<pg8::EpiMerge<true>, pg8::StaticOrder, true, true>(lds, g, S, E); }
    { pg8::Gemm g{NSA, (const bf16*)(a.ws + WS_WNO), 512, 512, 128, 256, (long)128 * 512 * 2, (long)256 * 512 * 2}; pg8::StaticOrder S; S.init(M, DM, G, (int)blockIdx.x);
      pg8::EpiMerge<false> E{P + PC_MERGED, P + PC_GB, PP};
      pg8::gemm_phase<pg8::EpiMerge<false>, pg8::StaticOrder, true, true>(lds, g, S, E); }
    xcd_barrier(bar);
    }
    for (int rep_ = 0; rep_ < REPS(6); ++rep_) { PH_PRELUDE;
    { pg8::Gemm g{P + PC_MERGED, (const bf16*)(a.ws + WS_WOUT), PP, DM, 128, 256, (long)128 * PP * 2, (long)256 * PP * 2}; pg8::StaticOrder S; S.init(M, DM, G, (int)blockIdx.x);
      pg8::EpiResid<0> E{a.in[0], nullptr, P + PC_X1B, PP, (rep_ + 1 < REPS(6)) ? rsdummy : rs2};
      pg8::gemm_phase<pg8::EpiResid<0>, pg8::StaticOrder, true, true>(lds, g, S, E); }
    xcd_barrier(bar);
    }
    for (int rep8_ = 0; rep8_ < REPS(8); ++rep8_) {
    for (int rep_ = 0; rep_ < REPS(7); ++rep_) { PH_PRELUDE;
    { pg8::Gemm g{P + PC_X1B, (const bf16*)(a.ws + WS_WUP), PP, DM, 128, 256, (long)128 * PP * 2, (long)256 * PP * 2}; pg8::StaticOrder S; S.init(M, NUP, G, (int)blockIdx.x);
      pg8::EpiRowScale<1> E{P + PC_UP, PP, rs2};
      pg8::gemm_phase<pg8::EpiRowScale<1>, pg8::StaticOrder, true, true>(lds, g, S, E); }
    xcd_barrier(bar);
    }
    { PH_PRELUDE; n_conv(a, P, G); }
    xcd_barrier(bar);
    }
    { PH_PRELUDE;
    { pg8::Gemm g{P + PC_UP + 128, (const bf16*)(a.ws + WS_WDN), PP, DFF, 128, 512, (long)128 * PP * 2, (long)256 * PP * 2}; pg8::StaticOrder S; S.init(M, DM, G, (int)blockIdx.x);
      pg8::EpiResid<1> E{nullptr, a.out, P + PC_X1B, PP, rs3};
      pg8::gemm_phase<pg8::EpiResid<1>, pg8::StaticOrder, true, true>(lds, g, S, E); }
    xcd_barrier(bar); }
    { const Args& a = *args_opaque(); n_final(a, G); }
}

extern "C" void kernel_launch(void* const* d_in, const int* in_sizes, int n_in, void* d_out, int out_size, void* d_ws, size_t ws_size, hipStream_t stream) {
    static int grid = 0;
    if (grid == 0) {
        if (n_in != 21 || out_size != M * DM || ws_size < WS_END) { fprintf(stderr, "kernel_launch: unexpected sizes n_in %d out %d ws %zu (need %zu)\n", n_in, out_size, ws_size, (size_t)WS_END); grid = -1; return; }
        int dev = 0, cus = 0;
        if (hipGetDevice(&dev) != hipSuccess || hipDeviceGetAttribute(&cus, hipDeviceAttributeMultiprocessorCount, dev) != hipSuccess) { grid = -1; return; }
        if (hipFuncSetAttribute((const void*)mega_fwd, hipFuncAttributeMaxDynamicSharedMemorySize, LDS_BYTES) != hipSuccess) { fprintf(stderr, "kernel_launch: hipFuncSetAttribute failed\n"); grid = -1; return; }
        grid = cus;
    }
    if (grid < 0) return;
    (void)hipMemsetAsync((char*)d_ws + WS_CTL, 0, CTL_ZERO_BYTES, stream);
    Args a{};
    for (int i = 0; i < 21; ++i) a.in[i] = (const float*)d_in[i];
    a.out = (float*)d_out; a.ws = (unsigned char*)d_ws;
    hipLaunchKernelGGL(mega_fwd, dim3(grid), dim3(512), LDS_BYTES, stream, a);
}
```

```cpp
#include <hip/hip_runtime.h>
#include <cstdio>
#include <cstdint>
namespace pg8 {
#define PG8_LAS __attribute__((address_space(3)))
typedef unsigned short bf16_t;
typedef short bf16x8 __attribute__((ext_vector_type(8)));
typedef float f32x4 __attribute__((ext_vector_type(4)));
typedef unsigned u32x4 __attribute__((ext_vector_type(4)));
constexpr int BM = 256, BK = 64, HALF = 128, HTB = HALF * BK * 2  , STAGE_BYTES = 8 * HTB, NXCD = 8, WGM = 8;

__host__ __device__ __forceinline__ int lds_byte(int r, int c) { const int st = (r >> 4) * 2 + (c >> 5), rr = r & 15, cc = c & 31, ob = rr * 64 + cc * 2; return st * 1024 + (ob ^ (((ob >> 9) & 1) << 5)); }
__host__ __device__ __forceinline__ void stage_rc(int b, int& R, int& C) { const int st = b / 1024, sb = b % 1024, swz = sb ^ (((sb >> 9) & 1) << 5); R = (st >> 1) * 16 + swz / 64; C = (st & 1) * 32 + (swz % 64) / 2; }
__host__ __device__ __forceinline__ int perm32(int rho) { const int n = rho >> 4, i = rho & 15; return 8 * (i >> 2) + 4 * n + (i & 3); }

struct Unit { int pm, pn; };
struct Gemm { const bf16_t* A; const bf16_t* Bt; int lda, K, ks1, ks2; long hsA, tsA; };

struct StaticOrder {
    int nM, nN, nwg, G, c;
    __host__ __device__ void init(int M, int N, int G_, int c_) { nM = M / BM; nN = N / BM; nwg = nM * nN; G = G_; c = c_; }
    __host__ __device__ bool next(int i, Unit& u) const {
        const long L = (long)i * G + c; if (L >= nwg) return false;
        int wgid = (int)L; { const int q = nwg / NXCD, r = nwg % NXCD, xcd = wgid % NXCD, off = wgid / NXCD; wgid = (xcd < r ? xcd * (q + 1) : r * (q + 1) + (xcd - r) * q) + off; }
        const int nig = WGM * nN, gid = wgid / nig, fm = gid * WGM, gsz = (nM - fm) < WGM ? (nM - fm) : WGM;
        u.pm = fm + ((wgid % nig) % gsz); u.pn = (wgid % nig) / gsz; return true;
    }
    __device__ __forceinline__ void a_ready(const Unit&) const {}
    __device__ __forceinline__ void done(const Unit&) const {}
};

__device__ __forceinline__ unsigned cvt_pk_bf16(float lo, float hi) { unsigned r; asm volatile("v_cvt_pk_bf16_f32 %0, %1, %2" : "=v"(r) : "v"(lo), "v"(hi)); return r; }
__device__ __forceinline__ float bf_lo(unsigned u) { return __builtin_bit_cast(float, u << 16); }
__device__ __forceinline__ float bf_hi(unsigned u) { return __builtin_bit_cast(float, u & 0xffff0000u); }
__device__ __forceinline__ float fsig(float x) { return __builtin_amdgcn_rcpf(1.f + __builtin_amdgcn_exp2f(-1.4426950408889634f * x)); }

template <int MODE> struct EpiRowScale {
    static constexpr bool PERM = true, AFTER_DRAIN = false;
    bf16_t* O; int ldc; const float* rs;
    __device__ __forceinline__ void operator()(const f32x4 (&acc)[2][2][4][2], const Unit& u, int wr, int wc, int fr, int fq) const {
        const int row0 = u.pm * BM + wr * 64 + fr, col0 = u.pn * BM + wc * 32 + 8 * fq;
#pragma unroll
        for (int ai = 0; ai < 2; ++ai)
#pragma unroll
            for (int m = 0; m < 4; ++m) { const int row = row0 + ai * HALF + m * 16; float s = 1.f;
                if (MODE == 1) s = __builtin_amdgcn_rsqf(rs[row] * (1.0f / 1024.0f) + 1e-6f);
                bf16_t* rowp = O + (size_t)row * ldc + col0;
#pragma unroll
                for (int bj = 0; bj < 2; ++bj) { const f32x4 v0 = acc[ai][bj][m][0] * s, v1 = acc[ai][bj][m][1] * s;
                    u32x4 w; w.x = cvt_pk_bf16(v0[0], v0[1]); w.y = cvt_pk_bf16(v0[2], v0[3]); w.z = cvt_pk_bf16(v1[0], v1[1]); w.w = cvt_pk_bf16(v1[2], v1[3]);
                    *(u32x4*)(rowp + bj * HALF) = w; } }
    }
};
template <bool FIRST> struct EpiMerge {
    static constexpr bool PERM = true, AFTER_DRAIN = false;
    bf16_t* O; const bf16_t* G; int ldc;
    __device__ __forceinline__ void operator()(const f32x4 (&acc)[2][2][4][2], const Unit& u, int wr, int wc, int fr, int fq) const {
        const int row0 = u.pm * BM + wr * 64 + fr, col0 = u.pn * BM + wc * 32 + 8 * fq;
#pragma unroll
        for (int ai = 0; ai < 2; ++ai)
#pragma unroll
            for (int m = 0; m < 4; ++m) { const size_t off = (size_t)(row0 + ai * HALF + m * 16) * ldc + col0;
#pragma unroll
                for (int bj = 0; bj < 2; ++bj) { const u32x4 gv = *(const u32x4*)(G + off + bj * HALF);
                    const f32x4 v0 = acc[ai][bj][m][0], v1 = acc[ai][bj][m][1];
                    float r[8];
                    r[0] = fsig(bf_lo(gv.x)) * v0[0]; r[1] = fsig(bf_hi(gv.x)) * v0[1]; r[2] = fsig(bf_lo(gv.y)) * v0[2]; r[3] = fsig(bf_hi(gv.y)) * v0[3];
                    r[4] = fsig(bf_lo(gv.z)) * v1[0]; r[5] = fsig(bf_hi(gv.z)) * v1[1]; r[6] = fsig(bf_lo(gv.w)) * v1[2]; r[7] = fsig(bf_hi(gv.w)) * v1[3];
                    if (!FIRST) { const u32x4 pv = *(const u32x4*)(O + off + bj * HALF);
                        r[0] += bf_lo(pv.x); r[1] += bf_hi(pv.x); r[2] += bf_lo(pv.y); r[3] += bf_hi(pv.y); r[4] += bf_lo(pv.z); r[5] += bf_hi(pv.z); r[6] += bf_lo(pv.w); r[7] += bf_hi(pv.w); }
                    u32x4 w; w.x = cvt_pk_bf16(r[0], r[1]); w.y = cvt_pk_bf16(r[2], r[3]); w.z = cvt_pk_bf16(r[4], r[5]); w.w = cvt_pk_bf16(r[6], r[7]);
                    *(u32x4*)(O + off + bj * HALF) = w; } }
    }
};
template <int MODE> struct EpiResid {
    static constexpr bool PERM = false, AFTER_DRAIN = false;
    const float* X; float* X1; bf16_t* Xb; int ldb; float* sumsq;
    __device__ __forceinline__ void operator()(const f32x4 (&acc)[2][2][4][2], const Unit& u, int wr, int wc, int fr, int fq) const {
        const int row0 = u.pm * BM + wr * 64 + fr, col0 = u.pn * BM + wc * 32 + 4 * fq;
#pragma unroll
        for (int ai = 0; ai < 2; ++ai)
#pragma unroll
            for (int m = 0; m < 4; ++m) { const int row = row0 + ai * HALF + m * 16; float ss = 0.f;
#pragma unroll
                for (int bj = 0; bj < 2; ++bj)
#pragma unroll
                    for (int n = 0; n < 2; ++n) { const int c = col0 + bj * HALF + n * 16;
                        f32x4 x;
                        if (MODE == 0) x = *(const f32x4*)(X + (size_t)row * 1024 + c);
                        else { const unsigned long long w = *(const unsigned long long*)(Xb + (size_t)row * ldb + c); const unsigned lo = (unsigned)w, hi = (unsigned)(w >> 32);
                               x = (f32x4){bf_lo(lo), bf_hi(lo), bf_lo(hi), bf_hi(hi)}; }
                        x = x + acc[ai][bj][m][n];
                        ss += (x[0] * x[0] + x[1] * x[1]) + (x[2] * x[2] + x[3] * x[3]);
                        if (MODE == 0) { const unsigned long long w = (unsigned long long)cvt_pk_bf16(x[0], x[1]) | ((unsigned long long)cvt_pk_bf16(x[2], x[3]) << 32);
                            *(unsigned long long*)(Xb + (size_t)row * ldb + c) = w; }
                        else *(f32x4*)(X1 + (size_t)row * 1024 + c) = x; }
                ss += __shfl_xor(ss, 16); ss += __shfl_xor(ss, 32);
                if (fq == 0) atomicAdd(sumsq + row, ss); }
    }
};
__device__ __forceinline__ float gelu_fast(float x) { return x * fsig(1.5957691216057308f * (x + 0.044715f * x * x * x)); }
typedef float f32x16 __attribute__((ext_vector_type(16)));
struct EpiCompress {
    static constexpr bool PERM = false, AFTER_DRAIN = true;
    const float* bias; const bf16_t* w2t; bf16_t* out;
    __device__ __forceinline__ void fused(f32x4 (&acc)[2][2][4][2], const Unit& u, int wr, int wc, int fr, int fq, PG8_LAS unsigned char* lds, int wid, int lane) const {
        const int col0 = wc * 32 + 4 * fq;
#pragma unroll
        for (int bj = 0; bj < 2; ++bj)
#pragma unroll
            for (int n = 0; n < 2; ++n) { const int c = col0 + bj * HALF + n * 16; const f32x4 bv = *(const f32x4*)(bias + c);
#pragma unroll
                for (int ai = 0; ai < 2; ++ai)
#pragma unroll
                    for (int m = 0; m < 4; ++m) { const int r = ai * HALF + wr * 64 + m * 16 + fr; const f32x4 v = acc[ai][bj][m][n] + bv;
                        const unsigned long long w = (unsigned long long)cvt_pk_bf16(gelu_fast(v[0]), gelu_fast(v[1])) | ((unsigned long long)cvt_pk_bf16(gelu_fast(v[2]), gelu_fast(v[3])) << 32);
                        *(PG8_LAS unsigned long long*)(lds + r * 528 + c * 2) = w; asm volatile("" ::: "memory"); } }
        asm volatile("s_waitcnt lgkmcnt(0)" ::: "memory"); __builtin_amdgcn_s_barrier(); asm volatile("" ::: "memory");
        const int q = lane & 31, h = lane >> 5;
        f32x16 o0, o1;
#pragma unroll
        for (int i = 0; i < 16; ++i) { o0[i] = 0.f; o1[i] = 0.f; }
#pragma unroll 4
        for (int ks = 0; ks < 16; ++ks) {
            const bf16x8 a = *(const PG8_LAS bf16x8*)(lds + (32 * wid + q) * 528 + ks * 32 + h * 16);
            const bf16x8 b0 = *(const bf16x8*)(w2t + q * 256 + 16 * ks + 8 * h), b1 = *(const bf16x8*)(w2t + (q + 32) * 256 + 16 * ks + 8 * h);
            o0 = __builtin_amdgcn_mfma_f32_32x32x16_bf16(a, b0, o0, 0, 0, 0); o1 = __builtin_amdgcn_mfma_f32_32x32x16_bf16(a, b1, o1, 0, 0, 0);
        }
#pragma unroll
        for (int i = 0; i < 16; ++i) { const int r = 32 * wid + (i & 3) + 8 * (i >> 2) + 4 * h, gg = r >> 7, c = r & 127;
            if (c < 127) { bf16_t* op = out + ((size_t)(u.pm * 2 + gg) * 128 + c) * 64 + q;
                op[0] = (bf16_t)(cvt_pk_bf16(o0[i], 0.f) & 0xffffu); op[32] = (bf16_t)(cvt_pk_bf16(o1[i], 0.f) & 0xffffu); } }
    }
};
struct FewUnits {
    int n, c;
    __device__ __forceinline__ bool next(int i, Unit& u) const { if (i != 0 || c >= n || c < 0) return false; u.pm = c; u.pn = 0; return true; }
    __device__ __forceinline__ void a_ready(const Unit&) const {}
    __device__ __forceinline__ void done(const Unit&) const {}
};

#define PG8_DPP(old_, src_, ctrl_) __builtin_bit_cast(float, __builtin_amdgcn_update_dpp(__builtin_bit_cast(int, (old_)), __builtin_bit_cast(int, (src_)), (ctrl_), 0xf, 0xf, false))
struct EpiUpConv {
    static constexpr bool PERM = true, AFTER_DRAIN = false;
    bf16_t* H; int ldh; const float* rs; const float* cw; const float* cb; float* tail; float* head; PG8_LAS float* hl; int dff;
    __device__ __forceinline__ void operator()(const f32x4 (&acc)[2][2][4][2], const Unit& u, int wr, int wc, int fr, int fq) const {
        const int f0 = u.pn * 128 + wc * 32 + 8 * fq, row0 = u.pm * BM + wr * 64 + fr;
        float w0[8], w1[8], w2[8], cbv[8];
#pragma unroll
        for (int q = 0; q < 2; ++q) { const f32x4 c0 = *(const f32x4*)(cw + f0 + 4 * q), c1 = *(const f32x4*)(cw + dff + f0 + 4 * q), c2 = *(const f32x4*)(cw + 2 * dff + f0 + 4 * q), cc = *(const f32x4*)(cb + f0 + 4 * q);
#pragma unroll
            for (int e_ = 0; e_ < 4; ++e_) { w0[4 * q + e_] = c0[e_]; w1[4 * q + e_] = c1[e_]; w2[4 * q + e_] = c2[e_]; cbv[4 * q + e_] = cc[e_]; } }
        float rsv[2][4];
#pragma unroll
        for (int ai = 0; ai < 2; ++ai)
#pragma unroll
            for (int m = 0; m < 4; ++m) rsv[ai][m] = __builtin_amdgcn_rsqf(rs[row0 + ai * HALF + m * 16] * (1.0f / 1024.0f) + 1e-6f);
        if (fr >= 14) {
#pragma unroll
            for (int ai = 0; ai < 2; ++ai) { PG8_LAS float* d = hl + ((ai * 2 + wr) * 4 + wc) * 64 + (fr - 14) * 32 + 8 * fq;
#pragma unroll
                for (int j = 0; j < 8; ++j) d[j] = acc[ai][0][3][j >> 2][j & 3] * rsv[ai][3]; }
            if (wr == 1) { float* t = tail + ((size_t)u.pm * 2 + (fr - 14)) * dff + f0;
#pragma unroll
                for (int j = 0; j < 8; ++j) t[j] = acc[1][0][3][j >> 2][j & 3] * rsv[1][3]; }
        }
        asm volatile("s_waitcnt lgkmcnt(0)" ::: "memory"); __builtin_amdgcn_s_barrier(); asm volatile("" ::: "memory");
        const bool seq_start = (u.pm & 7) == 0;
#pragma unroll
        for (int ai = 0; ai < 2; ++ai) {
            float r1[8], r2[8];
            {
                const bool have = (wr == 1) || (ai == 1);
                const PG8_LAS float* s = hl + ((((wr == 1) ? ai : 0) * 2 + ((wr == 1) ? 0 : 1)) * 4 + wc) * 64 + 8 * fq;
#pragma unroll
                for (int j = 0; j < 8; ++j) { const float hm1 = have ? s[32 + j] : 0.f, hm2 = have ? s[j] : 0.f;
                    r1[j] = hm1; r2[j] = (fr == 0) ? hm2 : hm1; }
            }
#pragma unroll
            for (int m = 0; m < 4; ++m) {
                const int row = row0 + ai * HALF + m * 16;
                float hv[8];
#pragma unroll
                for (int j = 0; j < 8; ++j) {
                    const float av = acc[ai][0][m][j >> 2][j & 3] * rsv[ai][m], bv = acc[ai][1][m][j >> 2][j & 3] * rsv[ai][m];
                    const float p1 = PG8_DPP(r1[j], av, 0x111), p2 = PG8_DPP(r2[j], av, 0x112);
                    const float ac = cbv[j] + w2[j] * av + w1[j] * p1 + w0[j] * p2;
                    hv[j] = gelu_fast(ac) * bv;
                    if (ai == 0 && m == 0 && wr == 0 && fr < 2 && !seq_start) { float* hp = head + (((size_t)u.pm * 2 + fr) * dff + f0 + j) * 2; hp[0] = ac; hp[1] = bv; }
                    r1[j] = PG8_DPP(av, av, 0x121); r2[j] = PG8_DPP(av, av, 0x122);
                }
                u32x4 w; w.x = cvt_pk_bf16(hv[0], hv[1]); w.y = cvt_pk_bf16(hv[2], hv[3]); w.z = cvt_pk_bf16(hv[4], hv[5]); w.w = cvt_pk_bf16(hv[6], hv[7]);
                *(u32x4*)(H + (size_t)row * ldh + f0) = w;
            }
        }
    }
};

template <class Epi, class Sched, bool ALIGN_EPI = false, bool SP2 = false>
__device__ __forceinline__ void gemm_phase(PG8_LAS unsigned char* lds, const Gemm g, const Sched& S, const Epi& E) {
    int tid_ = threadIdx.x; asm volatile("" : "+v"(tid_));
    const int tid = tid_, wid = __builtin_amdgcn_readfirstlane(tid >> 6), lane = tid & 63, wr = wid >> 2, wc = wid & 3, fr = lane & 15, fq = lane >> 4;
    const int K = g.K, nt = K / BK;
    unsigned voffA[2], voffB[2];
#pragma unroll
    for (int i = 0; i < 2; ++i) { int R, C; stage_rc(tid * 16 + i * 8192, R, C); const int Rb = Epi::PERM ? ((R & ~31) + perm32(R & 31)) : R;
        voffA[i] = (unsigned)(R * g.lda + C) * 2u; voffB[i] = (unsigned)(Rb * K + C) * 2u; }
    const size_t kstep = (size_t)(BK * 2);
    const size_t hstepB = (size_t)HALF * K * 2, hstepA = (size_t)g.hsA, ks1 = (size_t)g.ks1, ks2 = (size_t)g.ks2;
    const size_t tstepA = (size_t)g.tsA, tstepB = 2 * hstepB;
    const unsigned ldsw = (unsigned)wid * 1024u;
    const int aoff = lds_byte(wr * 64 + fr, fq * 8), boff = lds_byte(wc * 32 + fr, fq * 8);
#define PG8_SA(b, h) (((b) * 2 + (h)) * HTB)
#define PG8_SB(b, h) ((4 + (b) * 2 + (h)) * HTB)
#define PG8_STAGE(bufoff, gbase, voff) do { _Pragma("unroll") for (int _i = 0; _i < 2; ++_i) \
        __builtin_amdgcn_global_load_lds((const unsigned*)((const char*)(gbase) + (voff)[_i]), (PG8_LAS unsigned*)(lds + (bufoff) + ldsw + _i * 8192), 16, 0, 0); } while (0)
#define PG8_LDA(dst, b, h) do { _Pragma("unroll") for (int m = 0; m < 4; ++m) _Pragma("unroll") for (int k = 0; k < 2; ++k) dst[m][k] = *(const PG8_LAS bf16x8*)(lds + PG8_SA(b, h) + aoff + m * 2048 + k * 1024); } while (0)
#define PG8_LDB(dst, b, h) do { _Pragma("unroll") for (int n = 0; n < 2; ++n) _Pragma("unroll") for (int k = 0; k < 2; ++k) dst[n][k] = *(const PG8_LAS bf16x8*)(lds + PG8_SB(b, h) + boff + n * 2048 + k * 1024); } while (0)
#define PG8_MMA(ai, bj, At, Bt) do { __builtin_amdgcn_s_setprio(1); _Pragma("unroll") for (int m = 0; m < 4; ++m) _Pragma("unroll") for (int n = 0; n < 2; ++n) _Pragma("unroll") for (int k = 0; k < 2; ++k) \
        acc[ai][bj][m][n] = __builtin_amdgcn_mfma_f32_16x16x32_bf16(Bt[n][k], At[m][k], acc[ai][bj][m][n], 0, 0, 0); __builtin_amdgcn_s_setprio(0); } while (0)
#define PG8_WAIT_V(n) asm volatile("s_waitcnt vmcnt(" #n ")" ::: "memory")
#define PG8_WAIT_L(n) asm volatile("s_waitcnt lgkmcnt(" #n ")" ::: "memory")
#define PG8_BAR __builtin_amdgcn_s_barrier()
#define PG8_SCHED __builtin_amdgcn_sched_barrier(0)
    Unit cur, nxt; int ui = 0;
    if (!S.next(0, cur)) return;
    f32x4 acc[2][2][4][2];
#pragma unroll
    for (int a = 0; a < 2; ++a)
#pragma unroll
        for (int b = 0; b < 2; ++b)
#pragma unroll
            for (int m = 0; m < 4; ++m)
#pragma unroll
                for (int n = 0; n < 2; ++n) acc[a][b][m][n] = (f32x4){0.f, 0.f, 0.f, 0.f};
    bf16x8 At[4][2], B0[2][2], B1[2][2];
    const char* cA = (const char*)g.A + (size_t)cur.pm * tstepA; const char* cB = (const char*)g.Bt + (size_t)cur.pn * tstepB;
    S.a_ready(cur);
    if constexpr (SP2) {
        PG8_STAGE(PG8_SB(0, 0), cB, voffB); PG8_STAGE(PG8_SB(0, 1), cB + hstepB, voffB); PG8_STAGE(PG8_SA(0, 0), cA, voffA); PG8_STAGE(PG8_SA(0, 1), cA + hstepA, voffA);
        if (wr == 1) PG8_BAR;
        PG8_WAIT_V(2); PG8_BAR;
        PG8_STAGE(PG8_SB(1, 0), cB + kstep, voffB); PG8_STAGE(PG8_SA(1, 0), cA + ks1, voffA); PG8_STAGE(PG8_SB(1, 1), cB + hstepB + kstep, voffB);
        PG8_WAIT_V(6); PG8_BAR;
    } else {
        PG8_STAGE(PG8_SB(0, 0), cB, voffB); PG8_STAGE(PG8_SA(0, 0), cA, voffA); PG8_STAGE(PG8_SB(0, 1), cB + hstepB, voffB); PG8_STAGE(PG8_SA(0, 1), cA + hstepA, voffA);
        if (wr == 1) PG8_BAR;
        PG8_WAIT_V(4); PG8_BAR;
        PG8_STAGE(PG8_SB(1, 0), cB + kstep, voffB); PG8_STAGE(PG8_SA(1, 0), cA + ks1, voffA); PG8_STAGE(PG8_SB(1, 1), cB + hstepB + kstep, voffB);
        PG8_WAIT_V(6); PG8_BAR;
    }
    for (;;) {
        const bool has_next = S.next(ui + 1, nxt);
        const char* nA = has_next ? (const char*)g.A + (size_t)nxt.pm * tstepA : cA; const char* nB = has_next ? (const char*)g.Bt + (size_t)nxt.pn * tstepB : cB;
        for (int t = 0; t < nt; t += 2) {
            const bool last = (t == nt - 2);
            const char* a1 = cA + (size_t)(t >> 1) * ks2 + ks1;
            const char* a2 = last ? nA : cA + (size_t)((t + 2) >> 1) * ks2; const char* b2 = last ? nB : cB + (size_t)(t + 2) * kstep;
            const char* a3 = a2 + ks1; const char* b3 = b2 + kstep;
            if (last && has_next) S.a_ready(nxt);
            if constexpr (SP2) {
            PG8_LDB(B0, 0, 0); PG8_LDB(B1, 0, 1); PG8_SCHED; PG8_LDA(At, 0, 0); PG8_STAGE(PG8_SA(1, 1), a1 + hstepA, voffA);
            PG8_WAIT_V(8); PG8_WAIT_L(0); PG8_BAR; PG8_MMA(0, 0, At, B0); PG8_MMA(0, 1, At, B1); PG8_BAR; PG8_SCHED;
            PG8_LDA(At, 0, 1); PG8_STAGE(PG8_SB(0, 0), b2, voffB); PG8_STAGE(PG8_SB(0, 1), b2 + hstepB, voffB); PG8_STAGE(PG8_SA(0, 0), a2, voffA);
            PG8_WAIT_V(8); PG8_WAIT_L(0); PG8_BAR; PG8_MMA(1, 0, At, B0); PG8_MMA(1, 1, At, B1); PG8_BAR; PG8_SCHED;
            PG8_LDB(B0, 1, 0); PG8_LDB(B1, 1, 1); PG8_SCHED; PG8_LDA(At, 1, 0); PG8_STAGE(PG8_SA(0, 1), a2 + hstepA, voffA);
            PG8_WAIT_V(8); PG8_WAIT_L(0); PG8_BAR; PG8_MMA(0, 0, At, B0); PG8_MMA(0, 1, At, B1); PG8_BAR; PG8_SCHED;
            PG8_LDA(At, 1, 1); PG8_STAGE(PG8_SB(1, 0), b3, voffB); PG8_STAGE(PG8_SB(1, 1), b3 + hstepB, voffB); PG8_STAGE(PG8_SA(1, 0), a3, voffA);
            PG8_WAIT_V(8); PG8_WAIT_L(0); PG8_BAR; PG8_MMA(1, 0, At, B0); PG8_MMA(1, 1, At, B1); PG8_BAR; PG8_SCHED;
            } else {
            PG8_LDB(B0, 0, 0); PG8_SCHED; PG8_LDA(At, 0, 0); PG8_STAGE(PG8_SA(1, 1), a1 + hstepA, voffA);
            PG8_WAIT_L(8); PG8_BAR; PG8_WAIT_L(0); PG8_MMA(0, 0, At, B0); PG8_BAR; PG8_SCHED;
            PG8_LDB(B1, 0, 1); PG8_STAGE(PG8_SB(0, 0), b2, voffB);
            PG8_BAR; PG8_WAIT_L(0); PG8_MMA(0, 1, At, B1); PG8_BAR;
            PG8_LDA(At, 0, 1); PG8_STAGE(PG8_SA(0, 0), a2, voffA);
            PG8_BAR; PG8_WAIT_L(0); PG8_MMA(1, 0, At, B0); PG8_BAR; PG8_SCHED;
            PG8_STAGE(PG8_SB(0, 1), b2 + hstepB, voffB);
            PG8_WAIT_V(6); PG8_BAR; PG8_MMA(1, 1, At, B1); PG8_BAR;
            PG8_LDB(B0, 1, 0); PG8_SCHED; PG8_LDA(At, 1, 0); PG8_STAGE(PG8_SA(0, 1), a2 + hstepA, voffA);
            PG8_WAIT_L(8); PG8_BAR; PG8_WAIT_L(0); PG8_MMA(0, 0, At, B0); PG8_BAR; PG8_SCHED;
            PG8_LDB(B1, 1, 1); PG8_STAGE(PG8_SB(1, 0), b3, voffB);
            PG8_BAR; PG8_WAIT_L(0); PG8_MMA(0, 1, At, B1); PG8_BAR;
            PG8_LDA(At, 1, 1); PG8_STAGE(PG8_SA(1, 0), a3, voffA);
            PG8_BAR; PG8_WAIT_L(0); PG8_MMA(1, 0, At, B0); PG8_BAR; PG8_SCHED;
            PG8_STAGE(PG8_SB(1, 1), b3 + hstepB, voffB);
            PG8_WAIT_V(6); PG8_BAR; PG8_MMA(1, 1, At, B1); PG8_BAR;
            }
        }
        if constexpr (ALIGN_EPI) { if (wr == 0) PG8_BAR; }
        if constexpr (!Epi::AFTER_DRAIN) { E(acc, cur, wr, wc, fr, fq); S.done(cur); }
        if (!has_next) break;
#pragma unroll
        for (int a = 0; a < 2; ++a)
#pragma unroll
            for (int b = 0; b < 2; ++b)
#pragma unroll
                for (int m = 0; m < 4; ++m)
#pragma unroll
                    for (int n = 0; n < 2; ++n) acc[a][b][m][n] = (f32x4){0.f, 0.f, 0.f, 0.f};
        cur = nxt; cA = nA; cB = nB; ++ui;
        if constexpr (ALIGN_EPI) { if (wr == 1) PG8_BAR; }
    }
    PG8_WAIT_V(0);
    if constexpr (!ALIGN_EPI) { if (wr == 0) PG8_BAR; }
    PG8_BAR;
    if constexpr (Epi::AFTER_DRAIN) { E.fused(acc, cur, wr, wc, fr, fq, lds, wid, lane); S.done(cur); }
#undef PG8_SA
#undef PG8_SB
#undef PG8_STAGE
#undef PG8_LDA
#undef PG8_LDB
#undef PG8_MMA
#undef PG8_WAIT_V
#undef PG8_WAIT_L
#undef PG8_BAR
#undef PG8_SCHED
}
}
constexpr int M = 32768, DM = 1024, SEQ = 2048, NBATCH = 16;
constexpr int RH = 4, RDK = 128, RDV = 256;
constexpr int NG = 2, NR = 4, NDK = 64, CBLK = 32, CSTR = 16, CHID = 256, TOPK = 8, WIN = 512;
constexpr int DFF = 2816, NIN = 6424;
constexpr int NC = SEQ / CSTR - 1;
constexpr int NS = SEQ / 64;
constexpr float EPS = 1e-6f;
constexpr int C_GATE = 4352, C_GA = 4376, C_GB = 5400;
constexpr int PP = 6656;
constexpr int PC_RQ = 0, PC_RK = 512, PC_RV = 1024, PC_RG = 2048, PC_NQ = 3072, PC_KCR = 3584, PC_VCR = 3712, PC_KS = 3840, PC_VS = 3968,
              PC_KW = 4096, PC_VW = 4224, PC_GA = 4352, PC_GB = 5376, PC_GATE = 6400;
constexpr int PC_MERGED = 1024, PC_X1B = 0, PC_UP = 1024;
constexpr int NPAD_IN = 6656, NUP = 2 * DFF;
constexpr size_t MiB = 1u << 20;
constexpr size_t WS_CTL = 0, CTL_ZERO_BYTES = 1 * MiB;
constexpr size_t WS_RS2 = 256 * 1024, WS_RS3 = 512 * 1024;
constexpr size_t WS_WIN = 1 * MiB, WS_WUP = 14 * MiB, WS_WDN = 25 * MiB, WS_WRO = 31 * MiB, WS_WNO = 33 * MiB, WS_WOUT = 34 * MiB;
constexpr size_t WS_KCMP = 39 * MiB, WS_VCMP = 41 * MiB, WS_SEL = 43 * MiB;
constexpr size_t WS_WC1K = 36 * MiB, WS_WC1V = 37 * MiB, WS_W2T = 38 * MiB, WS_CBIAS = 768 * 1024;
constexpr size_t WS_TAIL = 45 * MiB, WS_HEAD = 48 * MiB;
constexpr size_t WS_PROJ = 56 * MiB;
constexpr size_t WS_END = WS_PROJ + (size_t)(M + 32) * PP * 2;
static_assert(WS_END <= 512 * MiB, "d_ws map");
constexpr int CW_BAR = 4096;
constexpr size_t DO_XB = 0, DO_NSA = 64 * MiB;

constexpr int LDS_BYTES = 163840;
constexpr int MISC_OFF = 163840 - 512;

typedef unsigned short bf16;
typedef unsigned v4u __attribute__((ext_vector_type(4)));
typedef float f32x4 __attribute__((ext_vector_type(4)));
#define GAS __attribute__((address_space(1)))
#define LDS_WAIT() asm volatile("s_waitcnt lgkmcnt(0)" ::: "memory")
__device__ __forceinline__ unsigned f2bf(float f) { unsigned u = __builtin_bit_cast(unsigned, f); return (u + 0x7fffu + ((u >> 16) & 1u)) >> 16; }
__device__ __forceinline__ unsigned pk2(float lo, float hi) { return f2bf(lo) | (f2bf(hi) << 16); }
__device__ __forceinline__ float bf2f(bf16 v) { return __builtin_bit_cast(float, (unsigned)v << 16); }
__device__ __forceinline__ float wave_sum(float v) {
#pragma unroll
    for (int o = 1; o < 64; o <<= 1) v += __shfl_xor(v, o);
    return v;
}
__device__ __forceinline__ float wave_max(float v) {
#pragma unroll
    for (int o = 1; o < 64; o <<= 1) v = fmaxf(v, __shfl_xor(v, o));
    return v;
}
__device__ __forceinline__ float gelu_tanh(float x) { const float c = 0.7978845608028654f; return 0.5f * x * (1.f + tanhf(c * (x + 0.044715f * x * x * x))); }
__device__ __forceinline__ float sigmoidf_(float x) { return 1.f / (1.f + expf(-x)); }

__device__ __forceinline__ int tid_opaque() { int t = threadIdx.x; asm volatile("" : "+v"(t)); return t; }
#define XB_TMO      128
#define XB_XCNT(j)  (256  + 64 * (j))
#define XB_XSUB(j)  (1280 + 64 * (j))
#define XB_XGEN(j)  (2304 + 64 * (j))
#define XB_TOP      3328
#define XB_TOPGEN   3392
#define XCD_BAR_WORDS 3456
#define XB_SPIN_CAP (1u << 21)
#define LAS __attribute__((address_space(3)))

__device__ __forceinline__ unsigned xb_ld(unsigned* p)              { return __hip_atomic_load(p, __ATOMIC_RELAXED, __HIP_MEMORY_SCOPE_AGENT); }
__device__ __forceinline__ unsigned xb_add(unsigned* p, unsigned v) { return __hip_atomic_fetch_add(p, v, __ATOMIC_RELAXED, __HIP_MEMORY_SCOPE_AGENT); }
__device__ __forceinline__ unsigned xb_xcc_id() { return (unsigned)__builtin_amdgcn_s_getreg((3 << 11) | 20) & 0xFu; }
#define XB_SPIN(cond, bar) do { unsigned _sp = 0; while (cond) { __builtin_amdgcn_s_sleep(1); \
    if ((++_sp & 255u) == 0u) { if (xb_ld(&(bar)[XB_TMO])) break; if (_sp > XB_SPIN_CAP) { atomicAdd(&(bar)[XB_TMO], 1u); break; } } } } while (0)

struct XcdBarrier {
    unsigned* bar; unsigned x;
    volatile LAS unsigned* st;
};

__device__ __forceinline__ XcdBarrier xcd_barrier_post(unsigned* bar, volatile LAS unsigned* st) {
    XcdBarrier b; b.bar = bar; b.x = xb_xcc_id(); b.st = st;
    if (threadIdx.x == 0) (void)xb_add(&bar[XB_XCNT(b.x)], 1u);
    return b;
}
__device__ __forceinline__ void xcd_barrier_complete(unsigned* bar, unsigned x, unsigned& nloc, unsigned& nx) {
    const unsigned G = gridDim.x * gridDim.y * gridDim.z;
    unsigned sum, cnt, mine, sp = 0u;
    for (;;) {
        sum = 0u; cnt = 0u; mine = 0u;
#pragma unroll
        for (unsigned j = 0; j < 16; ++j) { const unsigned c = xb_ld(&bar[XB_XCNT(j)]); sum += c; cnt += (c > 0u) ? 1u : 0u; mine = (j == x) ? c : mine; }
        if (sum == G) break;
        __builtin_amdgcn_s_sleep(1);
        if ((++sp & 255u) == 0u) { if (xb_ld(&bar[XB_TMO])) break; if (sp > XB_SPIN_CAP) { atomicAdd(&bar[XB_TMO], 1u); break; } }
    }
    nloc = mine > 0u ? mine : 1u; nx = cnt > 0u ? cnt : 1u;
}

__device__ __forceinline__ void xcd_barrier(const XcdBarrier& b) {
    asm volatile("s_waitcnt vmcnt(0)" ::: "memory");
    __syncthreads();
    if (threadIdx.x == 0) {
        unsigned* bar = b.bar;
        __builtin_amdgcn_s_waitcnt(0);
        unsigned nloc = b.st[0], nx = b.st[1];
        if (nloc == 0u) { xcd_barrier_complete(bar, b.x, nloc, nx); b.st[0] = nloc; b.st[1] = nx; }
        const unsigned old = xb_add(&bar[XB_XSUB(b.x)], 1u);
        const unsigned gen = old / nloc;
        if (old + 1u == (gen + 1u) * nloc) {
            __builtin_amdgcn_fence(__ATOMIC_RELEASE, "agent");
            asm volatile("s_waitcnt vmcnt(0)" ::: "memory");
            const unsigned og = xb_add(&bar[XB_TOP], 1u);
            const unsigned tg = og / nx;
            if (og + 1u == (tg + 1u) * nx) xb_add(&bar[XB_TOPGEN], 1u);
            else XB_SPIN(xb_ld(&bar[XB_TOPGEN]) == tg, bar);
            __builtin_amdgcn_fence(__ATOMIC_ACQUIRE, "agent");
            xb_add(&bar[XB_XGEN(b.x)], 1u);
            asm volatile("s_waitcnt vmcnt(0)" ::: "memory");
        } else {
            XB_SPIN(xb_ld(&bar[XB_XGEN(b.x)]) == gen, bar);
            __builtin_amdgcn_fence(__ATOMIC_ACQUIRE, "agent");
            asm volatile("s_waitcnt vmcnt(0)" ::: "memory");
        }
    }
    __syncthreads();
}

struct Args { const float* in[21]; float* out; unsigned char* ws; };
__device__ __forceinline__ unsigned cvtpk(float lo, float hi);
typedef short v4i16_t __attribute__((ext_vector_type(4)));
__device__ __forceinline__ v4u scale8(v4u v, float sc);

struct MapIn { __device__ __forceinline__ int operator()(int n) const { return n < 4352 ? n : (n < 6400 ? n + 24 : (n < 6424 ? n - 2048 : -1)); } };
struct MapUp { __device__ __forceinline__ int operator()(int n) const { const int pn = n >> 8, j = n & 255; return j < 128 ? 128 * pn + j : DFF + 128 * pn + (j - 128); } };
struct MapId { __device__ __forceinline__ int operator()(int n) const { return n; } };
template <class MAP>
__device__ __forceinline__ void p0_transpose_item(const float* W, int K, int Nsrc, int nblk, bf16* WT, const float* ksc, LAS float* scr, int item, int lane, MAP map) {
    const int kb = item / nblk, nb = item % nblk, k0 = 64 * kb, n0 = 32 * nb;
    const int sc = map(n0 + (lane & 31));
#pragma unroll 8
    for (int i = 0; i < 32; ++i) { const int kk = 2 * i + (lane >> 5); float v = 0.f; if (sc >= 0) { v = W[(size_t)(k0 + kk) * Nsrc + sc]; if (ksc) v *= ksc[k0 + kk]; } scr[kk * 33 + (lane & 31)] = v; }
    LDS_WAIT(); asm volatile("" ::: "memory");
    const int c = lane & 7;
#pragma unroll
    for (int j = 0; j < 4; ++j) { const int n = (lane >> 3) + 8 * j; const LAS float* s = scr + (8 * c) * 33 + n;
        v4u o; o.x = pk2(s[0 * 33], s[1 * 33]); o.y = pk2(s[2 * 33], s[3 * 33]); o.z = pk2(s[4 * 33], s[5 * 33]); o.w = pk2(s[6 * 33], s[7 * 33]);
        *(GAS v4u*)(WT + (size_t)(n0 + n) * K + k0 + 8 * c) = o; }
    LDS_WAIT(); asm volatile("" ::: "memory");
}
__device__ __forceinline__ void p0_prologue(const Args& a, LAS unsigned char* lds, int G) {
    const int tid = tid_opaque(), lane = tid & 63, wave = tid >> 6;
    LAS float* scr = (LAS float*)(lds + wave * 16384);
    const int gw = blockIdx.x * 8 + wave, NGW = G * 8;
    unsigned char* ws = a.ws;
    constexpr int I_IN = 16 * (NPAD_IN / 32), I_UP = 16 * (NUP / 32), I_DN = (DFF / 64) * 32, I_RO = 16 * 32, I_NO = 8 * 32, I_OUT = 16 * 32;
    constexpr int NITEMS = I_IN + I_UP + I_DN + I_RO + I_NO + I_OUT;
    for (int it = gw; it < NITEMS; it += NGW) {
        int r = it;
        if (r < I_IN) { p0_transpose_item(a.in[2], DM, NIN, NPAD_IN / 32, (bf16*)(ws + WS_WIN), a.in[1], scr, r, lane, MapIn()); continue; } r -= I_IN;
        if (r < I_UP) { p0_transpose_item(a.in[16], DM, NUP, NUP / 32, (bf16*)(ws + WS_WUP), a.in[15], scr, r, lane, MapUp()); continue; } r -= I_UP;
        if (r < I_DN) { p0_transpose_item(a.in[19], DFF, DM, 32, (bf16*)(ws + WS_WDN), nullptr, scr, r, lane, MapId()); continue; } r -= I_DN;
        if (r < I_RO) { p0_transpose_item(a.in[12], 1024, DM, 32, (bf16*)(ws + WS_WRO), nullptr, scr, r, lane, MapId()); continue; } r -= I_RO;
        if (r < I_NO) { p0_transpose_item(a.in[13], 512, DM, 32, (bf16*)(ws + WS_WNO), nullptr, scr, r, lane, MapId()); continue; } r -= I_NO;
        p0_transpose_item(a.in[14], DM, DM, 32, (bf16*)(ws + WS_WOUT), nullptr, scr, r, lane, MapId());
    }
    for (int it = gw; it < 2 * 256; it += NGW) { const int kv = it >> 8, r = it & 255;
        p0_transpose_item(a.in[kv ? 9 : 5], 2048, CHID, CHID / 32, (bf16*)(ws + (kv ? WS_WC1V : WS_WC1K)), nullptr, scr, r, lane, MapId()); }
    for (int it = gw; it < 2 * 8; it += NGW) { const int kv = it >> 3, r = it & 7;
        p0_transpose_item(a.in[kv ? 11 : 7], CHID, NDK, 2, (bf16*)(ws + WS_W2T) + kv * (NDK * CHID), nullptr, scr, r, lane, MapId()); }
    for (int it = gw; it < 2 * 4 * 32; it += NGW) { const int kv = it >> 7, j = ((it >> 5) & 3) * 64 + lane, ksl = it & 31;
        const float* pos = a.in[kv ? 8 : 4]; const float* w1 = a.in[kv ? 9 : 5]; const float* b1 = a.in[kv ? 10 : 6];
        float acc = ksl == 0 ? b1[j] : 0.f;
#pragma unroll 16
        for (int k = ksl * 64; k < ksl * 64 + 64; ++k) acc += pos[k] * w1[(size_t)k * CHID + j];
        atomicAdd((float*)(ws + WS_CBIAS) + kv * CHID + j, acc); }
    bf16* XB = (bf16*)((unsigned char*)a.out + DO_XB);
    for (int m0 = gw * 4; m0 < M; m0 += NGW * 4) {
        f32x4 v[4][4];
#pragma unroll
        for (int r = 0; r < 4; ++r) { const GAS f32x4* xr = (const GAS f32x4*)(a.in[0] + (size_t)(m0 + r) * DM) + lane;
#pragma unroll
            for (int j = 0; j < 4; ++j) v[r][j] = xr[64 * j]; }
#pragma unroll
        for (int r = 0; r < 4; ++r) { float s = 0.f;
#pragma unroll
            for (int j = 0; j < 4; ++j) s += (v[r][j].x * v[r][j].x + v[r][j].y * v[r][j].y) + (v[r][j].z * v[r][j].z + v[r][j].w * v[r][j].w);
            const float rstd = rsqrtf(wave_sum(s) * (1.f / DM) + EPS);
            GAS unsigned long long* o8 = (GAS unsigned long long*)(XB + (size_t)(m0 + r) * DM) + lane;
#pragma unroll
            for (int j = 0; j < 4; ++j) o8[64 * j] = (unsigned long long)pk2(v[r][j].x * rstd, v[r][j].y * rstd) | ((unsigned long long)pk2(v[r][j].z * rstd, v[r][j].w * rstd) << 32); }
    }
}

__device__ __forceinline__ float ldp(const bf16* P, size_t row, int col) { return bf2f(P[row * PP + col]); }

__device__ __forceinline__ void n_compress(const Args& a, const bf16* P, LAS unsigned char* lds, int G) {
    const int tid = tid_opaque(), sub = tid >> 8, lt = tid & 255;
    LAS float* bv = (LAS float*)(lds + sub * 16384); LAS float* hid = bv + CBLK * NDK;
    for (int it = blockIdx.x; it < NBATCH * NC * 2; it += G) {
        const int u = it * 2 + sub, kv = u & 1, g = (u >> 1) & 1, c = (u >> 2) % NC, b = (u >> 2) / NC;
        const float* pos = a.in[kv ? 8 : 4]; const float* w1 = a.in[kv ? 9 : 5]; const float* b1 = a.in[kv ? 10 : 6]; const float* w2 = a.in[kv ? 11 : 7];
        bf16* out = (bf16*)(a.ws + (kv ? WS_VCMP : WS_KCMP));
        const int colbase = (kv ? PC_VCR : PC_KCR) + g * NDK;
        __syncthreads();
        for (int i = lt; i < CBLK * NDK; i += 256) { const int ii = i >> 6, d = i & 63; bv[i] = ldp(P, (size_t)b * SEQ + c * CSTR + ii, colbase + d) + pos[i]; }
        __syncthreads();
        float acc = b1[lt];
        for (int k = 0; k < CBLK * NDK; ++k) acc += bv[k] * w1[(size_t)k * CHID + lt];
        hid[lt] = gelu_tanh(acc);
        __syncthreads();
        if (lt < NDK) { float o = 0.f; for (int j = 0; j < CHID; ++j) o += hid[j] * w2[j * NDK + lt]; out[(((size_t)b * NG + g) * 128 + c) * NDK + lt] = (bf16)f2bf(o); }
    }
}

template <int MODE>
__device__ __forceinline__ void n_attn(const Args& a, const bf16* P, bf16* NSA, LAS unsigned char* lds, int G) {
    const int tid = tid_opaque(), sub = tid >> 8, r = (tid >> 6) & 3, lane = tid & 63;
    LAS float* qs = (LAS float*)(lds + sub * 16384) + r * 64;
    LAS float* scs = (LAS float*)(lds + sub * 16384 + 1024) + r * 576;
    LAS int* blks = (LAS int*)(lds + sub * 16384 + 1024 + 9216) + r * 12;
    const unsigned* selmask = (const unsigned*)(a.ws + WS_SEL);
    const int kcol = MODE ? PC_KW : PC_KS, vcol = MODE ? PC_VW : PC_VS;
    for (int it = blockIdx.x; it < M; it += G) {
        const int u = it * 2 + sub, g = u & 1, t = u >> 1, tl = t & (SEQ - 1), h = g * NR + r, cur = tl >> 6;
        const size_t rb = (size_t)(t - tl);
        const float slope = exp2f(-(float)(h + 1));
        __syncthreads();
        qs[lane] = ldp(P, t, PC_NQ + h * NDK + lane);
        unsigned mask;
        if (MODE) { const int lo = (tl - (WIN - 1)) > 0 ? ((tl - (WIN - 1)) >> 6) : 0; mask = 0u; for (int j = lo; j <= cur; ++j) mask |= 1u << j; }
        else mask = selmask[t * NG + g];
        int nb = 0;
        for (int j = 0; j < NS; ++j) if ((mask >> j) & 1u) { if (lane == 0) blks[nb] = j; ++nb; }
        __syncthreads();
        float m = -1e30f;
        for (int b = 0; b < nb; ++b) {
            const int s = blks[b] * 64 + lane; const int d = tl - s;
            const bool valid = d >= 0 && (!MODE || d < WIN);
            float sc = -1e30f;
            if (valid) { float dot = 0.f; const bf16* kr = P + (rb + s) * PP + kcol + g * NDK; for (int x = 0; x < NDK; ++x) dot += qs[x] * bf2f(kr[x]); sc = dot * 0.125f - slope * (float)d; }
            scs[b * 64 + lane] = sc; m = fmaxf(m, sc);
        }
        m = wave_max(m);
        float sum = 0.f;
        for (int b = 0; b < nb; ++b) { const float sc = scs[b * 64 + lane]; const float p = sc > -1e29f ? expf(sc - m) : 0.f; scs[b * 64 + lane] = p; sum += p; }
        sum = wave_sum(sum);
        __syncthreads();
        float o = 0.f;
        for (int b = 0; b < nb; ++b) {
            const int s0 = blks[b] * 64;
            for (int i = 0; i < 64; ++i) { const float p = scs[b * 64 + i]; if (p != 0.f) o += p * ldp(P, rb + s0 + i, vcol + g * NDK + lane); }
        }
        const float gate = sigmoidf_(ldp(P, t, PC_GATE + (MODE ? 16 : 8) + h));
        const size_t oi = (size_t)t * 512 + h * NDK + lane;
        float res = gate * o / sum;
        if (!MODE) res += bf2f(NSA[oi]);
        NSA[oi] = (bf16)f2bf(res);
    }
}

__device__ __forceinline__ void n_cmp(const Args& a, const bf16* P, bf16* NSA, LAS unsigned char* lds, int G) {
    const int tid = tid_opaque(), w = tid >> 6, lane = tid & 63;
    LAS float* qs = (LAS float*)(lds + w * 4096);
    LAS float* ps = qs + 256;
    const float* kcmp = (const float*)(a.ws + WS_KCMP); const float* vcmp = (const float*)(a.ws + WS_VCMP);
    unsigned* selmask = (unsigned*)(a.ws + WS_SEL);
    for (int it = blockIdx.x; it < M * NG / 8; it += G) {
        const int u = it * 8 + w, g = u & 1, t = u >> 1, tl = t & (SEQ - 1), b = t >> 11;
        const float* kc = kcmp + ((size_t)b * NG + g) * NC * NDK; const float* vc = vcmp + ((size_t)b * NG + g) * NC * NDK;
        __syncthreads();
        for (int r = 0; r < NR; ++r) qs[r * 64 + lane] = ldp(P, t, PC_NQ + (g * NR + r) * NDK + lane);
        __syncthreads();
        for (int r = 0; r < NR; ++r) {
            const int h = g * NR + r; const float slope = exp2f(-(float)(h + 1));
            float sc[2]; bool val[2];
#pragma unroll
            for (int q = 0; q < 2; ++q) {
                const int c = lane + 64 * q; sc[q] = -1e30f; val[q] = false;
                if (c < NC) {
                    float d = 0.f; const float* kr = kc + (size_t)c * NDK;
                    for (int x = 0; x < NDK; ++x) d += qs[r * 64 + x] * kr[x];
                    const int dc = tl - (c * CSTR + CBLK - 1);
                    if (dc >= 0) { val[q] = true; sc[q] = d * 0.125f - slope * (float)dc; }
                }
            }
            const float mx = wave_max(fmaxf(sc[0], sc[1]));
            float p0 = val[0] ? expf(sc[0] - mx) : 0.f, p1 = val[1] ? expf(sc[1] - mx) : 0.f;
            const float sum = wave_sum(p0 + p1);
            const float inv = sum > 0.f ? 1.f / sum : 0.f;
            ps[r * 128 + lane] = p0 * inv; ps[r * 128 + 64 + lane] = p1 * inv;
        }
        __syncthreads();
        for (int r = 0; r < NR; ++r) {
            const int h = g * NR + r;
            float o = 0.f;
            for (int c = 0; c < NC; ++c) o += ps[r * 128 + c] * vc[(size_t)c * NDK + lane];
            const float gate = sigmoidf_(ldp(P, t, PC_GATE + h));
            const size_t oi = (size_t)t * 512 + h * NDK + lane;
            NSA[oi] = (bf16)f2bf(bf2f(NSA[oi]) + gate * o);
        }
        float imp = 0.f; const int j = lane & 31;
        for (int r = 0; r < NR; ++r)
            for (int c = 4 * j - 1; c <= 4 * j + 3; ++c) if (c >= 0 && c < NC) imp += ps[r * 128 + c];
        const int cur = tl >> 6;
        if (j == 0 || j == cur || j == cur - 1) imp = 1e9f;
        if (j > cur) imp = -1e9f;
        int rank = 0;
        for (int i = 0; i < NS; ++i) { const float o = __shfl(imp, i); rank += (o > imp || (o == imp && i < j)) ? 1 : 0; }
        const unsigned long long bal = __ballot(rank < TOPK && lane < 32 && j <= cur);
        if (lane == 0) selmask[t * NG + g] = (unsigned)bal;
    }
}

__device__ __forceinline__ void n_retention(const Args& a, bf16* P, LAS unsigned char* lds, int G) {
    const int tid = tid_opaque(), sub = tid >> 8, lt = tid & 255;
    LAS float* Qs = (LAS float*)(lds + sub * 49152);
    LAS float* Ks = Qs + 32 * 129;
    LAS float* Vs = Ks + 16 * 129;
    LAS float* Ps = Vs + 16 * 256;
    const float* gn_g = a.in[3];
    for (int p = blockIdx.x; p < NBATCH * 2 * 64; p += G) {
        const int k_ = p >> 8, qt0 = p & 63, qt = (k_ & 1) ? 63 - qt0 : qt0, idx = p >> 6, hp = idx & 1, b = idx >> 1, h = hp * 2 + sub;
        const size_t rb = (size_t)b * SEQ;
        const float lg = log1pf(-exp2f(-5.0f - (float)h));
        const float scale = 0.08838834764831845f;
        __syncthreads();
        for (int i = lt; i < 32 * 128; i += 256) { const int r = i >> 7, c = i & 127; Qs[r * 129 + c] = ldp(P, rb + qt * 32 + r, PC_RQ + h * RDK + c); }
        float acc[32];
#pragma unroll
        for (int e = 0; e < 32; ++e) acc[e] = 0.f;
        const int pi = lt >> 3, pj0 = (lt & 7) * 2;
        for (int kt = 0; kt <= 2 * qt + 1; ++kt) {
            __syncthreads();
            for (int i = lt; i < 16 * 128; i += 256) { const int r = i >> 7, c = i & 127; Ks[r * 129 + c] = ldp(P, rb + kt * 16 + r, PC_RK + h * RDK + c); }
            for (int i = lt; i < 16 * 256; i += 256) { const int r = i >> 8, c = i & 255; Vs[r * 256 + c] = ldp(P, rb + kt * 16 + r, PC_RV + h * RDV + c); }
            __syncthreads();
#pragma unroll
            for (int jj = 0; jj < 2; ++jj) {
                const int j = pj0 + jj; float d = 0.f;
                for (int c = 0; c < 128; ++c) d += Qs[pi * 129 + c] * Ks[j * 129 + c];
                const int diff = (qt * 32 + pi) - (kt * 16 + j);
                Ps[pi * 17 + j] = diff >= 0 ? d * scale * expf(lg * (float)diff) : 0.f;
            }
            __syncthreads();
            for (int j = 0; j < 16; ++j) {
                const float pv = Ps[pi * 17 + j];
#pragma unroll
                for (int e = 0; e < 32; ++e) acc[e] += pv * Vs[j * 256 + (lt & 7) + 8 * e];
            }
        }
        float s = 0.f;
#pragma unroll
        for (int e = 0; e < 32; ++e) s += acc[e];
        s += __shfl_xor(s, 1); s += __shfl_xor(s, 2); s += __shfl_xor(s, 4);
        const float mu = s / 256.f;
        float q = 0.f;
#pragma unroll
        for (int e = 0; e < 32; ++e) { const float d = acc[e] - mu; q += d * d; }
        q += __shfl_xor(q, 1); q += __shfl_xor(q, 2); q += __shfl_xor(q, 4);
        const float rstd = rsqrtf(q / 256.f + EPS);
        const size_t t = rb + qt * 32 + pi;
#pragma unroll
        for (int e = 0; e < 32; ++e) {
            const int col = h * RDV + (lt & 7) + 8 * e;
            const float on = (acc[e] - mu) * rstd * gn_g[col];
            const float gg = ldp(P, t, PC_RG + col);
            P[t * PP + PC_RG + col] = (bf16)f2bf(gg * sigmoidf_(gg) * on);
        }
    }
}

__device__ __forceinline__ void n_conv(const Args& a, bf16* P, int G) {
    const float* cw = a.in[17]; const float* cb = a.in[18];
    constexpr int NF8 = DFF / 8, NITEM = (M / 16) * NF8;
    for (int it = blockIdx.x * 512 + tid_opaque(); it < NITEM; it += G * 512) {
        const int rblk = it / NF8, f8 = (it - rblk * NF8) * 8, pn = f8 >> 7, j = f8 & 127, t0 = rblk * 16, tl0 = t0 & (SEQ - 1);
        bf16* pa = P + (size_t)t0 * PP + PC_UP + 256 * pn + j;
        float w0[8], w1[8], w2[8], bb[8];
#pragma unroll
        for (int q = 0; q < 2; ++q) { const f32x4 c0 = *(const f32x4*)(cw + f8 + 4 * q), c1 = *(const f32x4*)(cw + DFF + f8 + 4 * q), c2 = *(const f32x4*)(cw + 2 * DFF + f8 + 4 * q), cc = *(const f32x4*)(cb + f8 + 4 * q);
#pragma unroll
            for (int e = 0; e < 4; ++e) { w0[4 * q + e] = c0[e]; w1[4 * q + e] = c1[e]; w2[4 * q + e] = c2[e]; bb[4 * q + e] = cc[e]; } }
        v4u p1 = (v4u){0u, 0u, 0u, 0u}, p2 = p1;
        if (tl0 != 0) { p1 = *(const v4u*)(pa - PP); p2 = *(const v4u*)(pa - 2 * PP); }
#pragma unroll 1
        for (int r0 = 0; r0 < 16; r0 += 4) {
            v4u av[4], bv[4];
#pragma unroll
            for (int r = 0; r < 4; ++r) { av[r] = *(const v4u*)(pa + (size_t)(r0 + r) * PP); bv[r] = *(const v4u*)(pa + (size_t)(r0 + r) * PP + 128); }
#pragma unroll
            for (int r = 0; r < 4; ++r) {
                unsigned o[4];
#pragma unroll
                for (int q = 0; q < 4; ++q) {
                    const float ac0 = bb[2 * q] + w2[2 * q] * pg8::bf_lo(av[r][q]) + w1[2 * q] * pg8::bf_lo(p1[q]) + w0[2 * q] * pg8::bf_lo(p2[q]);
                    const float ac1 = bb[2 * q + 1] + w2[2 * q + 1] * pg8::bf_hi(av[r][q]) + w1[2 * q + 1] * pg8::bf_hi(p1[q]) + w0[2 * q + 1] * pg8::bf_hi(p2[q]);
                    o[q] = cvtpk(pg8::gelu_fast(ac0) * pg8::bf_lo(bv[r][q]), pg8::gelu_fast(ac1) * pg8::bf_hi(bv[r][q]));
                }
                *(v4u*)(pa + (size_t)(r0 + r) * PP + 128) = (v4u){o[0], o[1], o[2], o[3]};
                p2 = p1; p1 = av[r];
            }
        }
    }
}

__device__ __forceinline__ void n_final(const Args& a, int G) {
    const int tid_ = tid_opaque(), lane = tid_ & 63, gw = blockIdx.x * 8 + (tid_ >> 6), NGW = G * 8;
    const float* rs3 = (const float*)(a.ws + WS_RS3); const float* gf = a.in[20];
    f32x4 gv[4];
#pragma unroll
    for (int j = 0; j < 4; ++j) gv[j] = *((const f32x4*)gf + lane + 64 * j);
    for (int m0 = gw * 4; m0 < M; m0 += NGW * 4) {
        f32x4 v[4][4]; float rstd[4];
#pragma unroll
        for (int r = 0; r < 4; ++r) { const f32x4* xr = (const f32x4*)(a.out + (size_t)(m0 + r) * DM) + lane;
#pragma unroll
            for (int j = 0; j < 4; ++j) v[r][j] = xr[64 * j];
            rstd[r] = rsqrtf(rs3[m0 + r] * (1.f / DM) + EPS); }
#pragma unroll
        for (int r = 0; r < 4; ++r) { f32x4* xr = (f32x4*)(a.out + (size_t)(m0 + r) * DM) + lane;
#pragma unroll
            for (int j = 0; j < 4; ++j) xr[64 * j] = v[r][j] * rstd[r] * gv[j]; }
    }
}

typedef short bf16x8 __attribute__((ext_vector_type(8)));
typedef float f32x16 __attribute__((ext_vector_type(16)));
typedef float f32x2_t __attribute__((ext_vector_type(2))); typedef __bf16 bf16x2_t __attribute__((ext_vector_type(2)));
typedef unsigned v2u __attribute__((ext_vector_type(2)));
#define MFMA32(a, b, c) __builtin_amdgcn_mfma_f32_32x32x16_bf16((a), (b), (c), 0, 0, 0)
__device__ __forceinline__ unsigned cvtpk(float lo, float hi) { f32x2_t v = {lo, hi}; bf16x2_t b = __builtin_convertvector(v, bf16x2_t); return __builtin_bit_cast(unsigned, b); }
__device__ __forceinline__ float xhalf_max(float m) { auto rr = __builtin_amdgcn_permlane32_swap(__float_as_uint(m), __float_as_uint(m), false, false); return fmaxf(__uint_as_float(rr[0]), __uint_as_float(rr[1])); }
__device__ __forceinline__ float xhalf_sum(float m) { auto rr = __builtin_amdgcn_permlane32_swap(__float_as_uint(m), __float_as_uint(m), false, false); return __uint_as_float(rr[0]) + __uint_as_float(rr[1]); }
__device__ __forceinline__ bf16x8 pack8(const f32x16& x, int s) {
    v4u p; p.x = cvtpk(x[8 * s], x[8 * s + 1]); p.y = cvtpk(x[8 * s + 2], x[8 * s + 3]); p.z = cvtpk(x[8 * s + 4], x[8 * s + 5]); p.w = cvtpk(x[8 * s + 6], x[8 * s + 7]);
    return __builtin_bit_cast(bf16x8, p);
}
constexpr float LOG2E = 1.4426950408889634f;
constexpr int AT_KSTR = 144, AT_VSTR = 192, AT_VOFF = 64 * AT_KSTR, AT_BUF = AT_VOFF + 64 * AT_VSTR;
constexpr float AT_THR = 8.0f;

__device__ __forceinline__ v4i16_t ds_tr_(const LAS unsigned char* p) { return __builtin_amdgcn_ds_read_tr16_b64_v4i16((LAS v4i16_t*)p); }

template <int MODE>
__device__ __forceinline__ void attn_unit(const bf16* P, bf16* NSA, const unsigned* selmask, LAS unsigned char* lds, int b, int g, int n) {
    const int tid = tid_opaque(), lane = tid & 63, wid = tid >> 6, q = lane & 31, h = lane >> 5;
    const int r = wid >> 1, th = wid & 1, head = g * NR + r;
    const int tl = 64 * n + 32 * th + q;
    const size_t rb = (size_t)b * SEQ, trow = rb + tl;
    bf16x8 qf[4];
    { const bf16* qp = P + trow * PP + PC_NQ + head * NDK + 8 * h;
#pragma unroll
      for (int ks = 0; ks < 4; ++ks) qf[ks] = __builtin_bit_cast(bf16x8, scale8(*(const v4u*)(qp + 16 * ks), 0.125f * LOG2E)); }
    const float slope2 = exp2f(-(float)(head + 1)) * LOG2E;
    const unsigned smask = MODE == 0 ? selmask[trow * NG + g] : 0u;
    const int j0 = MODE == 1 ? (n > 8 ? n - 8 : 0) : 0, j1 = n;
    f32x16 o0, o1;
#pragma unroll
    for (int i = 0; i < 16; ++i) { o0[i] = 0.f; o1[i] = 0.f; }
    float m = 0.f, l = 0.f; bool started = false;
    const int skey = tid >> 3, sch = tid & 7;
    const bf16* kg = P + (rb + skey) * PP + (MODE ? PC_KW : PC_KS) + g * NDK + 8 * sch;
    const bf16* vg = P + (rb + skey) * PP + (MODE ? PC_VW : PC_VS) + g * NDK + 8 * sch;
    v4u kreg = *(const v4u*)(kg + (size_t)(64 * j0) * PP), vreg = *(const v4u*)(vg + (size_t)(64 * j0) * PP);
#define AT_WRITE(bufi) do { LAS unsigned char* kb_ = lds + (bufi) * AT_BUF; *(LAS v4u*)(kb_ + skey * AT_KSTR + sch * 16) = kreg; *(LAS v4u*)(kb_ + AT_VOFF + skey * AT_VSTR + sch * 16) = vreg; } while (0)
    AT_WRITE(0);
    __syncthreads();
    const int vlane = (4 * h + ((lane & 15) >> 2)) * AT_VSTR + (16 * ((lane >> 4) & 1) + 4 * (lane & 3)) * 2;
    for (int j = j0; j <= j1; ++j) {
        const int cur = (j - j0) & 1;
        if (j < j1) { kreg = *(const v4u*)(kg + (size_t)(64 * (j + 1)) * PP); vreg = *(const v4u*)(vg + (size_t)(64 * (j + 1)) * PP); }
        LAS unsigned char* kb = lds + cur * AT_BUF;
        const bool lane_ok = MODE == 0 ? ((smask >> j) & 1u) != 0u : true;
        const float L = lane_ok ? slope2 * (float)(64 * j + 4 * h - tl) - m : -INFINITY;
        f32x16 s0, s1;
#pragma unroll
        for (int i = 0; i < 16; ++i) { const int kk = (i & 3) + 8 * (i >> 2); s0[i] = fmaf(slope2, (float)kk, L); s1[i] = fmaf(slope2, (float)(kk + 32), L); }
#pragma unroll
        for (int ks = 0; ks < 4; ++ks) {
            const bf16x8 a0 = *(const LAS bf16x8*)(kb + q * AT_KSTR + ks * 32 + h * 16);
            const bf16x8 a1 = *(const LAS bf16x8*)(kb + (q + 32) * AT_KSTR + ks * 32 + h * 16);
            s0 = MFMA32(a0, qf[ks], s0); s1 = MFMA32(a1, qf[ks], s1);
        }
        if ((j == n) || (MODE == 1 && j == n - 8)) {
            const int dbase = tl - 64 * j - 4 * h;
#pragma unroll
            for (int i = 0; i < 16; ++i) { const int kk = (i & 3) + 8 * (i >> 2), d0 = dbase - kk, d1 = d0 - 32;
                if (!(d0 >= 0 && (MODE == 0 || d0 < WIN))) s0[i] = -INFINITY;
                if (!(d1 >= 0 && (MODE == 0 || d1 < WIN))) s1[i] = -INFINITY; }
        }
        float mx = fmaxf(s0[0], s1[0]);
#pragma unroll
        for (int i = 1; i < 16; ++i) mx = fmaxf(mx, fmaxf(s0[i], s1[i]));
        mx = xhalf_max(mx);
        const bool fin = mx > -INFINITY;
        const bool resc = fin && (mx > AT_THR || !started);
        if (__any(resc)) {
            const float delta = resc ? mx : 0.f, alpha = started ? __builtin_amdgcn_exp2f(-delta) : 1.0f;
            m += delta; l *= alpha;
#pragma unroll
            for (int i = 0; i < 16; ++i) { s0[i] -= delta; s1[i] -= delta; o0[i] *= alpha; o1[i] *= alpha; }
        }
        started = started || fin;
        float ps = 0.f;
#pragma unroll
        for (int i = 0; i < 16; ++i) { s0[i] = __builtin_amdgcn_exp2f(s0[i]); s1[i] = __builtin_amdgcn_exp2f(s1[i]); ps += s0[i] + s1[i]; }
        l += ps;
        bf16x8 pf[4];
        pf[0] = pack8(s0, 0); pf[1] = pack8(s0, 1); pf[2] = pack8(s1, 0); pf[3] = pack8(s1, 1);
        const LAS unsigned char* vb = kb + AT_VOFF + vlane;
#pragma unroll
        for (int ks = 0; ks < 4; ++ks) {
            const LAS unsigned char* va = vb + 16 * ks * AT_VSTR;
            { const v4i16_t lo = ds_tr_(va), hi = ds_tr_(va + 8 * AT_VSTR);
              o0 = MFMA32(((bf16x8){lo[0], lo[1], lo[2], lo[3], hi[0], hi[1], hi[2], hi[3]}), pf[ks], o0); }
            { const v4i16_t lo = ds_tr_(va + 64), hi = ds_tr_(va + 64 + 8 * AT_VSTR);
              o1 = MFMA32(((bf16x8){lo[0], lo[1], lo[2], lo[3], hi[0], hi[1], hi[2], hi[3]}), pf[ks], o1); }
        }
        if (j < j1) AT_WRITE(cur ^ 1);
        __syncthreads();
    }
#undef AT_WRITE
    l = xhalf_sum(l);
    const float gate = pg8::fsig(bf2f(P[trow * PP + PC_GATE + (MODE ? 16 : 8) + head]));
    const float f = gate / l;
    bf16* op = NSA + trow * 512 + head * NDK + 4 * h;
#pragma unroll
    for (int dt = 0; dt < 2; ++dt)
#pragma unroll
        for (int rg = 0; rg < 4; ++rg) {
            const f32x16& o = dt ? o1 : o0;
            float v0 = o[4 * rg] * f, v1 = o[4 * rg + 1] * f, v2 = o[4 * rg + 2] * f, v3 = o[4 * rg + 3] * f;
            v2u* dst = (v2u*)(op + 32 * dt + 8 * rg);
            if (MODE == 0) { const v2u pv = *dst; v0 += pg8::bf_lo(pv.x); v1 += pg8::bf_hi(pv.x); v2 += pg8::bf_lo(pv.y); v3 += pg8::bf_hi(pv.y); }
            *dst = (v2u){cvtpk(v0, v1), cvtpk(v2, v3)};
        }
}
template <int MODE>
__device__ __forceinline__ void attn_phase(const Args& a, const bf16* P, bf16* NSA, LAS unsigned char* lds, int G, int id) {
    const unsigned* selmask = (const unsigned*)(a.ws + WS_SEL);
    __syncthreads();
    if (MODE == 0 && G == 256) {
        for (int k = 0; k < 4; ++k) { const int aa = id & 15, hi = id >> 4, nn = (k & 2) ? ((aa + 8) & 15) : aa;
            const int n = (k & 1) ? nn : 31 - nn, bg = hi + 16 * (k >> 1);
            attn_unit<MODE>(P, NSA, selmask, lds, bg >> 1, bg & 1, n); }
        return;
    }
    for (int u = id; u < NBATCH * NG * NS; u += G) {
        const int n = 31 - (u >> 5), bg = u & 31;
        attn_unit<MODE>(P, NSA, selmask, lds, bg >> 1, bg & 1, n);
    }
}


__device__ __forceinline__ v4i16_t ds_tr(const LAS unsigned char* p) { return __builtin_amdgcn_ds_read_tr16_b64_v4i16((LAS v4i16_t*)p); }
__device__ __forceinline__ bf16x8 tr_frag(const LAS unsigned char* base, int R, int k0, int n0, int lane) {
    const int grp = lane >> 4, li = lane & 15, qq = li >> 2, pp = li & 3, ngrp = grp & 1, hh = grp >> 1;
    const LAS unsigned char* a = base + (k0 + 8 * hh + qq) * R + (n0 + 16 * ngrp + 4 * pp) * 2;
    const v4i16_t lo = ds_tr(a), hi = ds_tr(a + 4 * R);
    return (bf16x8){lo[0], lo[1], lo[2], lo[3], hi[0], hi[1], hi[2], hi[3]};
}
__device__ __forceinline__ bf16x8 tr_frag_perm(const LAS unsigned char* base, int R, int k0, int n0, int lane) {
    const int grp = lane >> 4, li = lane & 15, qq = li >> 2, pp = li & 3, ngrp = grp & 1, hh = grp >> 1;
    const LAS unsigned char* a = base + (k0 + 4 * hh + qq) * R + (n0 + 16 * ngrp + 4 * pp) * 2;
    const v4i16_t lo = ds_tr(a), hi = ds_tr(a + 8 * R);
    return (bf16x8){lo[0], lo[1], lo[2], lo[3], hi[0], hi[1], hi[2], hi[3]};
}
__device__ __forceinline__ v4u scale8(v4u v, float sc) {
    v4u o;
#pragma unroll
    for (int i = 0; i < 4; ++i) o[i] = cvtpk(pg8::bf_lo(v[i]) * sc, pg8::bf_hi(v[i]) * sc);
    return o;
}
__device__ __forceinline__ float ret_lg2(int hd) { return log2f(1.0f - exp2f(-5.0f - (float)hd)); }

constexpr int RT_VSTR = 576, RT_KSTR = 320, RO_STR = 272;
constexpr size_t KV_UNIT = 256 * 128;
__device__ __forceinline__ void ret_kv_unit(const bf16* P, bf16* KVS, LAS unsigned char* lds, int b, int hd, int n) {
    const int tid = tid_opaque(), lane = tid & 63, wid = tid >> 6, h = lane >> 5;
    const float lg2 = ret_lg2(hd);
    LAS unsigned char* Vs = lds; LAS unsigned char* Ks = lds + 128 * RT_VSTR;
    const size_t rowbase = (size_t)b * SEQ + 128 * n;
    __syncthreads();
#pragma unroll
    for (int i = 0; i < 8; ++i) { const int idx = tid + 512 * i, row = idx >> 5, ch = idx & 31;
        *(LAS v4u*)(Vs + row * RT_VSTR + ch * 16) = *(const v4u*)(P + (rowbase + row) * PP + PC_RV + hd * RDV + 8 * ch); }
#pragma unroll
    for (int i = 0; i < 4; ++i) { const int idx = tid + 512 * i, row = idx >> 4, ch = idx & 15;
        const float sc = 0.08838834764831845f * exp2f(lg2 * (float)(127 - row));
        *(LAS v4u*)(Ks + row * RT_KSTR + ch * 16) = scale8(*(const v4u*)(P + (rowbase + row) * PP + PC_RK + hd * RDK + 8 * ch), sc); }
    __syncthreads();
    f32x16 acc[4];
#pragma unroll
    for (int d = 0; d < 4; ++d)
#pragma unroll
        for (int i = 0; i < 16; ++i) acc[d][i] = 0.f;
#pragma unroll 2
    for (int ks = 0; ks < 8; ++ks) {
        const bf16x8 A = tr_frag(Vs, RT_VSTR, 16 * ks, 32 * wid, lane);
#pragma unroll
        for (int dt = 0; dt < 4; ++dt) { const bf16x8 B = tr_frag(Ks, RT_KSTR, 16 * ks, 32 * dt, lane); acc[dt] = MFMA32(A, B, acc[dt]); }
    }
    bf16* ob = KVS + (size_t)(((b * RH + hd) * 16 + n)) * KV_UNIT;
#pragma unroll
    for (int dt = 0; dt < 4; ++dt)
#pragma unroll
        for (int i = 0; i < 16; ++i) { const int e = 32 * wid + (i & 3) + 8 * (i >> 2) + 4 * h, d = 32 * dt + (lane & 31); ob[e * 128 + d] = (bf16)f2bf(acc[dt][i]); }
}
__device__ __forceinline__ void ret_kv_phase(const bf16* P, bf16* KVS, LAS unsigned char* lds, int G, int id) {
    for (int u = id; u < NBATCH * RH * 16; u += G) ret_kv_unit(P, KVS, lds, u >> 6, (u >> 4) & 3, u & 15);
}
__device__ __forceinline__ void ret_scan_phase(bf16* KVS, int G) {
    for (int it = blockIdx.x * 512 + tid_opaque(); it < NBATCH * RH * 4096; it += G * 512) {
        const int bh = it >> 12, off = (it & 4095) * 8, hd = bh & 3;
        const float decay = exp2f(128.0f * ret_lg2(hd));
        bf16* p = KVS + (size_t)bh * 16 * KV_UNIT + off;
        v4u v[16];
#pragma unroll
        for (int n = 0; n < 16; ++n) v[n] = *(const v4u*)(p + (size_t)n * KV_UNIT);
        float st[8];
#pragma unroll
        for (int i = 0; i < 8; ++i) st[i] = 0.f;
#pragma unroll
        for (int n = 0; n < 16; ++n) {
            *(v4u*)(p + (size_t)n * KV_UNIT) = (v4u){cvtpk(st[0], st[1]), cvtpk(st[2], st[3]), cvtpk(st[4], st[5]), cvtpk(st[6], st[7])};
#pragma unroll
            for (int i = 0; i < 4; ++i) { st[2 * i] = st[2 * i] * decay + pg8::bf_lo(v[n][i]); st[2 * i + 1] = st[2 * i + 1] * decay + pg8::bf_hi(v[n][i]); }
        }
    }
}
constexpr int RO_QS = 0, RO_SB = 128 * RO_STR, RO_X = 2 * 128 * RO_STR, RO_STATS = RO_X + 128 * RT_VSTR;
static_assert(RO_STATS + 2048 <= 147456 && 256 * RO_STR <= 128 * RT_VSTR, "retention LDS map");
__device__ __forceinline__ void ret_out_unit(bf16* P, const bf16* KVS, const float* gn_g, LAS unsigned char* lds, int b, int hd, int n) {
    const int tid = tid_opaque(), lane = tid & 63, wid = tid >> 6, q = lane & 31, h = lane >> 5;
    const float lg2 = ret_lg2(hd);
    LAS unsigned char* Qs = lds + RO_QS; LAS unsigned char* Sb = lds + RO_SB; LAS unsigned char* X = lds + RO_X;
    const size_t rowbase = (size_t)b * SEQ + 128 * n;
    __syncthreads();
#pragma unroll
    for (int i = 0; i < 4; ++i) { const int idx = tid + 512 * i, row = idx >> 4, ch = idx & 15;
        const float e1 = exp2f(lg2 * (float)(row + 1));
        *(LAS v4u*)(Qs + row * RO_STR + ch * 16) = scale8(*(const v4u*)(P + (rowbase + row) * PP + PC_RQ + hd * RDK + 8 * ch), e1);
        *(LAS v4u*)(X + row * RO_STR + ch * 16) = scale8(*(const v4u*)(P + (rowbase + row) * PP + PC_RK + hd * RDK + 8 * ch), 0.08838834764831845f / e1); }
    __syncthreads();
    const int tt = wid & 3, sh = wid >> 2, trl = 32 * tt + q;
#pragma unroll
    for (int si = 0; si < 2; ++si) {
        const int st = 2 * sh + si;
        if (st > tt) {
#pragma unroll
            for (int rg = 0; rg < 4; ++rg) *(LAS v2u*)(Sb + trl * RO_STR + (32 * st + 8 * rg + 4 * h) * 2) = (v2u){0u, 0u};
        } else {
            f32x16 s;
#pragma unroll
            for (int i = 0; i < 16; ++i) s[i] = 0.f;
#pragma unroll
            for (int ks = 0; ks < 8; ++ks) {
                const bf16x8 a = *(const LAS bf16x8*)(X + (32 * st + q) * RO_STR + ks * 32 + h * 16);
                const bf16x8 bq = *(const LAS bf16x8*)(Qs + trl * RO_STR + ks * 32 + h * 16);
                s = MFMA32(a, bq, s);
            }
#pragma unroll
            for (int rg = 0; rg < 4; ++rg) { const int s0 = 32 * st + 8 * rg + 4 * h;
                const float v0 = (s0 <= trl) ? s[4 * rg] : 0.f, v1 = (s0 + 1 <= trl) ? s[4 * rg + 1] : 0.f, v2 = (s0 + 2 <= trl) ? s[4 * rg + 2] : 0.f, v3 = (s0 + 3 <= trl) ? s[4 * rg + 3] : 0.f;
                *(LAS v2u*)(Sb + trl * RO_STR + s0 * 2) = (v2u){cvtpk(v0, v1), cvtpk(v2, v3)}; }
        }
    }
    __syncthreads();
#pragma unroll
    for (int i = 0; i < 8; ++i) { const int idx = tid + 512 * i, row = idx >> 5, ch = idx & 31;
        *(LAS v4u*)(X + row * RT_VSTR + ch * 16) = *(const v4u*)(P + (rowbase + row) * PP + PC_RV + hd * RDV + 8 * ch); }
    __syncthreads();
    const int eh = wid >> 2;
    f32x16 acc[4];
#pragma unroll
    for (int d = 0; d < 4; ++d)
#pragma unroll
        for (int i = 0; i < 16; ++i) acc[d][i] = 0.f;
    for (int ks = 0; ks < 2 * (tt + 1); ++ks) {
        const bf16x8 bS = *(const LAS bf16x8*)(Sb + trl * RO_STR + ks * 32 + h * 16);
#pragma unroll
        for (int et = 0; et < 4; ++et) { const bf16x8 A = tr_frag(X, RT_VSTR, 16 * ks, 32 * (4 * eh + et), lane); acc[et] = MFMA32(A, bS, acc[et]); }
    }
    __syncthreads();
    { const bf16* rt = KVS + (size_t)(((b * RH + hd) * 16 + n)) * KV_UNIT;
#pragma unroll
      for (int i = 0; i < 8; ++i) { const int idx = tid + 512 * i, row = idx >> 4, ch = idx & 15;
          *(LAS v4u*)(X + row * RO_STR + ch * 16) = *(const v4u*)(rt + row * 128 + 8 * ch); } }
    __syncthreads();
#pragma unroll 2
    for (int ks = 0; ks < 8; ++ks) {
        const bf16x8 bQ = *(const LAS bf16x8*)(Qs + trl * RO_STR + ks * 32 + h * 16);
#pragma unroll
        for (int et = 0; et < 4; ++et) { const bf16x8 A = *(const LAS bf16x8*)(X + (32 * (4 * eh + et) + q) * RO_STR + ks * 32 + h * 16); acc[et] = MFMA32(A, bQ, acc[et]); }
    }
    float s1 = 0.f, s2 = 0.f;
#pragma unroll
    for (int et = 0; et < 4; ++et)
#pragma unroll
        for (int i = 0; i < 16; ++i) { s1 += acc[et][i]; s2 += acc[et][i] * acc[et][i]; }
    s1 = xhalf_sum(s1); s2 = xhalf_sum(s2);
    LAS float* stats = (LAS float*)(lds + RO_STATS);
    if (h == 0) { stats[(eh * 128 + trl) * 2] = s1; stats[(eh * 128 + trl) * 2 + 1] = s2; }
    __syncthreads();
    s1 = stats[trl * 2] + stats[(128 + trl) * 2]; s2 = stats[trl * 2 + 1] + stats[(128 + trl) * 2 + 1];
    const float mu = s1 * (1.f / 256.f), rstd = rsqrtf(fmaxf(s2 * (1.f / 256.f) - mu * mu, 0.f) + EPS);
    bf16* gp = P + (rowbase + trl) * PP + PC_RG + hd * RDV;
    const float* gg = gn_g + hd * RDV;
#pragma unroll
    for (int et = 0; et < 4; ++et)
#pragma unroll
        for (int rg = 0; rg < 4; ++rg) {
            const int e0 = 32 * (4 * eh + et) + 8 * rg + 4 * h;
            const v2u gv = *(const v2u*)(gp + e0); const f32x4 gn = *(const f32x4*)(gg + e0);
            const float g0 = pg8::bf_lo(gv.x), g1 = pg8::bf_hi(gv.x), g2 = pg8::bf_lo(gv.y), g3 = pg8::bf_hi(gv.y);
            const float o0 = (acc[et][4 * rg] - mu) * rstd * gn[0] * g0 * pg8::fsig(g0), o1 = (acc[et][4 * rg + 1] - mu) * rstd * gn[1] * g1 * pg8::fsig(g1);
            const float o2 = (acc[et][4 * rg + 2] - mu) * rstd * gn[2] * g2 * pg8::fsig(g2), o3 = (acc[et][4 * rg + 3] - mu) * rstd * gn[3] * g3 * pg8::fsig(g3);
            *(v2u*)(gp + e0) = (v2u){cvtpk(o0, o1), cvtpk(o2, o3)};
        }
}
__device__ __forceinline__ void ret_out_phase(bf16* P, const bf16* KVS, const float* gn_g, LAS unsigned char* lds, int G) {
    for (int u = blockIdx.x; u < NBATCH * RH * 16; u += G) ret_out_unit(P, KVS, gn_g, lds, u >> 6, (u >> 4) & 3, u & 15);
}

constexpr int CM_KSTR = 144, CM_VSTR = 192;
constexpr int CM_K = 0, CM_V = 128 * CM_KSTR, CM_GW = CM_V + 128 * CM_VSTR, CM_TW = CM_GW + 32768, CM_IMP = CM_TW + 32768;
__device__ __forceinline__ void cmp_unit(const bf16* P, bf16* NSA, const bf16* KC, const bf16* VC, unsigned* selmask, LAS unsigned char* lds, int b, int g, int n) {
    const int tid = tid_opaque(), lane = tid & 63, wid = tid >> 6, q = lane & 31, h = lane >> 5;
    const int r = wid >> 1, th = wid & 1, head = g * NR + r;
    const int tok = 32 * th + q, tl = 64 * n + tok;
    const size_t rb = (size_t)b * SEQ, trow = rb + tl;
    bf16x8 qf[4];
    { const bf16* qp = P + trow * PP + PC_NQ + head * NDK + 8 * h;
#pragma unroll
      for (int ks = 0; ks < 4; ++ks) qf[ks] = *(const bf16x8*)(qp + 16 * ks); }
    const float slope2 = exp2f(-(float)(head + 1)) * LOG2E, c1 = 0.125f * LOG2E;
    __syncthreads();
#pragma unroll
    for (int i = 0; i < 2; ++i) { const int idx = tid + 512 * i, row = idx >> 3, ch = idx & 7;
        v4u kv = (v4u){0u, 0u, 0u, 0u}, vv = kv;
        if (row < NC) { kv = *(const v4u*)(KC + ((size_t)(b * NG + g) * 128 + row) * NDK + 8 * ch); vv = *(const v4u*)(VC + ((size_t)(b * NG + g) * 128 + row) * NDK + 8 * ch); }
        *(LAS v4u*)(lds + CM_K + row * CM_KSTR + ch * 16) = kv; *(LAS v4u*)(lds + CM_V + row * CM_VSTR + ch * 16) = vv; }
    __syncthreads();
    const int ktmax = (4 * n + 2) >> 5;
    f32x16 s[4];
#pragma unroll
    for (int kt = 0; kt < 4; ++kt) {
#pragma unroll
        for (int i = 0; i < 16; ++i) s[kt][i] = 0.f;
        if (kt <= ktmax) {
#pragma unroll
            for (int ks = 0; ks < 4; ++ks) { const bf16x8 a = *(const LAS bf16x8*)(lds + CM_K + (32 * kt + q) * CM_KSTR + ks * 32 + h * 16); s[kt] = MFMA32(a, qf[ks], s[kt]); }
        }
    }
    float mx = -INFINITY;
#pragma unroll
    for (int kt = 0; kt < 4; ++kt)
#pragma unroll
        for (int i = 0; i < 16; ++i) { const int c = 32 * kt + (i & 3) + 8 * (i >> 2) + 4 * h, dc = tl - (c * CSTR + CBLK - 1);
            const float z = (dc >= 0 && kt <= ktmax) ? fmaf(s[kt][i], c1, -slope2 * (float)dc) : -INFINITY;
            s[kt][i] = z; mx = fmaxf(mx, z); }
    mx = xhalf_max(mx);
    const float mref = (mx == -INFINITY) ? 0.f : mx;
    float sum = 0.f;
#pragma unroll
    for (int kt = 0; kt < 4; ++kt)
#pragma unroll
        for (int i = 0; i < 16; ++i) { s[kt][i] = __builtin_amdgcn_exp2f(s[kt][i] - mref); sum += s[kt][i]; }
    sum = xhalf_sum(sum);
    const float inv = sum > 0.f ? 1.f / sum : 0.f;
    LAS float* GW = (LAS float*)(lds + CM_GW); LAS float* TW = (LAS float*)(lds + CM_TW);
#pragma unroll
    for (int kt = 0; kt < 4; ++kt) {
#pragma unroll
        for (int i = 0; i < 16; ++i) s[kt][i] *= inv;
#pragma unroll
        for (int rg = 0; rg < 4; ++rg) { const int j = 8 * kt + 2 * rg + h;
            GW[(r * 64 + tok) * 32 + j] = (s[kt][4 * rg] + s[kt][4 * rg + 1]) + (s[kt][4 * rg + 2] + s[kt][4 * rg + 3]);
            TW[(r * 64 + tok) * 32 + j] = s[kt][4 * rg + 3]; }
    }
    f32x16 o0, o1;
#pragma unroll
    for (int i = 0; i < 16; ++i) { o0[i] = 0.f; o1[i] = 0.f; }
#pragma unroll
    for (int kt = 0; kt < 4; ++kt) {
        if (kt <= ktmax) {
#pragma unroll
            for (int sp = 0; sp < 2; ++sp) { const bf16x8 pf = pack8(s[kt], sp);
                const bf16x8 A0 = tr_frag_perm(lds + CM_V, CM_VSTR, 32 * kt + 16 * sp, 0, lane), A1 = tr_frag_perm(lds + CM_V, CM_VSTR, 32 * kt + 16 * sp, 32, lane);
                o0 = MFMA32(A0, pf, o0); o1 = MFMA32(A1, pf, o1); }
        }
    }
    { const float gate = pg8::fsig(bf2f(P[trow * PP + PC_GATE + head]));
      bf16* op = NSA + trow * 512 + head * NDK + 4 * h;
#pragma unroll
      for (int dt = 0; dt < 2; ++dt)
#pragma unroll
          for (int rg = 0; rg < 4; ++rg) {
              const f32x16& o = dt ? o1 : o0;
              v2u* dst = (v2u*)(op + 32 * dt + 8 * rg); const v2u pv = *dst;
              const float v0 = o[4 * rg] * gate + pg8::bf_lo(pv.x), v1 = o[4 * rg + 1] * gate + pg8::bf_hi(pv.x), v2 = o[4 * rg + 2] * gate + pg8::bf_lo(pv.y), v3 = o[4 * rg + 3] * gate + pg8::bf_hi(pv.y);
              *dst = (v2u){cvtpk(v0, v1), cvtpk(v2, v3)};
          } }
    __syncthreads();
    LAS float* IMP = (LAS float*)(lds + CM_IMP);
    const int j = tid & 31;
#pragma unroll
    for (int pass = 0; pass < 4; ++pass) { const int tk = (tid >> 5) + 16 * pass;
        float imp = 0.f;
#pragma unroll
        for (int rr = 0; rr < 4; ++rr) { imp += GW[(rr * 64 + tk) * 32 + j]; if (j > 0) imp += TW[(rr * 64 + tk) * 32 + j - 1]; }
        if (j == 0 || j == n || j == n - 1) imp = 1e9f;
        if (j > n) imp = -1e9f;
        IMP[tk * 32 + j] = imp; }
    __syncthreads();
#pragma unroll
    for (int pass = 0; pass < 4; ++pass) { const int tk = (tid >> 5) + 16 * pass;
        const float mine = IMP[tk * 32 + j]; int rank = 0;
        for (int i = 0; i < 32; ++i) { const float o = IMP[tk * 32 + i]; rank += (o > mine || (o == mine && i < j)) ? 1 : 0; }
        const unsigned long long bal = __ballot(rank < TOPK && j <= n);
        if ((lane & 31) == 0) selmask[(rb + 64 * n + tk) * NG + g] = (unsigned)(bal >> (lane & 32)); }
}
__device__ __forceinline__ void cmp_phase(const Args& a, const bf16* P, bf16* NSA, LAS unsigned char* lds, int G) {
    const bf16* KC = (const bf16*)(a.ws + WS_KCMP); const bf16* VC = (const bf16*)(a.ws + WS_VCMP);
    unsigned* selmask = (unsigned*)(a.ws + WS_SEL);
    for (int u = blockIdx.x; u < NBATCH * NG * NS; u += G) {
        const int i = u & 255, k = u >> 8, aa = i & 15, hi = i >> 4;
        const int nn = (k & 2) ? ((aa + 8) & 15) : aa, n = (k & 1) ? 31 - nn : nn, bg = hi + 16 * (k >> 1);
        cmp_unit(P, NSA, KC, VC, selmask, lds, bg >> 1, bg & 1, n);
    }
}

__device__ __forceinline__ const Args* args_opaque() { auto p = __builtin_amdgcn_kernarg_segment_ptr(); asm volatile("" : "+s"(p)); return (const Args*)p; }
__device__ __forceinline__ void conv_fixup(const Args& a, bf16* P, int pm) {
    if ((pm & 7) == 0) return;
    const float* cw = a.in[17]; const float* tail = (const float*)(a.ws + WS_TAIL); const float* head = (const float*)(a.ws + WS_HEAD);
    for (int i = tid_opaque(); i < 2 * DFF; i += 512) {
        const int r = i / DFF, f = i - r * DFF;
        const float am1 = tail[((size_t)(pm - 1) * 2 + 1) * DFF + f], am2 = tail[((size_t)(pm - 1) * 2 + 0) * DFF + f];
        const float* hp = head + (((size_t)pm * 2 + r) * DFF + f) * 2;
        const float ac = hp[0] + (r == 0 ? cw[DFF + f] * am1 + cw[f] * am2 : cw[f] * am1);
        P[(size_t)(pm * 256 + r) * PP + PC_UP + f] = (bf16)f2bf(pg8::gelu_fast(ac) * hp[1]);
    }
}
__global__ void __launch_bounds__(512, 2) mega_fwd(Args kernel_args) {
    extern __shared__ __attribute__((aligned(16))) unsigned char lds_raw[];
    LAS unsigned char* lds = (LAS unsigned char*)lds_raw;
    volatile LAS unsigned* MISC = (volatile LAS unsigned*)(lds + MISC_OFF);
    const int tid = tid_opaque(), G = gridDim.x;
    for (int u = tid; u < (LDS_BYTES - 131072) / 4; u += 512) ((LAS unsigned*)(lds + 131072))[u] = 0u;
    __syncthreads();
    XcdBarrier bar;
    { const Args& a = *args_opaque(); bar = xcd_barrier_post((unsigned*)(a.ws + WS_CTL) + CW_BAR, MISC + 8); }
#define PH_PRELUDE const Args& a = *args_opaque(); bf16* P = (bf16*)(a.ws + WS_PROJ); bf16* XB = (bf16*)((unsigned char*)a.out + DO_XB); bf16* NSA = (bf16*)((unsigned char*)a.out + DO_NSA); \
    bf16* KVS = (bf16*)((unsigned char*)a.out + DO_XB); float* rs2 = (float*)(a.ws + WS_RS2); float* rs3 = (float*)(a.ws + WS_RS3); float* rsdummy = (float*)(a.ws + 44 * MiB); \
    bf16* NSAdummy = (bf16*)((unsigned char*)a.out + 96 * MiB); (void)P; (void)XB; (void)NSA; (void)KVS; (void)rs2; (void)rs3; (void)rsdummy; (void)NSAdummy
#ifndef PROBE_REP
#define PROBE_REP 0
#endif
#define REPS(k) ((PROBE_REP == (k)) ? 2 : 1)
    for (int rep_ = 0; rep_ < REPS(1); ++rep_) { PH_PRELUDE;
    p0_prologue(a, lds, G);
    xcd_barrier(bar);
    }
    for (int rep_ = 0; rep_ < REPS(2); ++rep_) { PH_PRELUDE;
    { pg8::Gemm g{XB, (const bf16*)(a.ws + WS_WIN), DM, DM, 128, 256, (long)128 * DM * 2, (long)256 * DM * 2}; pg8::StaticOrder S; S.init(M, NPAD_IN, G, (int)blockIdx.x);
      pg8::EpiRowScale<0> E{P, PP, nullptr};
      pg8::gemm_phase<pg8::EpiRowScale<0>, pg8::StaticOrder, true, true>(lds, g, S, E); }
    xcd_barrier(bar);
    }
    for (int rep3_ = 0; rep3_ < REPS(3); ++rep3_) {
    for (int rep_ = 0; rep_ < REPS(4); ++rep_) { PH_PRELUDE;
    if (G >= 64 && blockIdx.x < 32) {
        for (int kv = 0; kv < 2; ++kv) {
            pg8::Gemm g{P + (kv ? PC_VCR : PC_KCR), (const bf16*)(a.ws + (kv ? WS_WC1V : WS_WC1K)), 16 * PP, CBLK * NDK, PP * 2, 2 * PP * 2, (long)NDK * 2, (long)SEQ * PP * 2};
            pg8::FewUnits S{NBATCH, (int)blockIdx.x - 16 * kv};
            pg8::EpiCompress E{(const float*)(a.ws + WS_CBIAS) + kv * CHID, (const bf16*)(a.ws + WS_W2T) + kv * (NDK * CHID), (bf16*)(a.ws + (kv ? WS_VCMP : WS_KCMP))};
            pg8::gemm_phase<pg8::EpiCompress, pg8::FewUnits, false, true>(lds, g, S, E);
        }
    } else if (G >= 64) {
        attn_phase<1>(a, P, NSA, lds, G - 32, (int)blockIdx.x - 32);
        ret_kv_phase(P, KVS, lds, G - 32, (int)blockIdx.x - 32);
    } else {
        n_compress(a, P, lds, G);
        attn_phase<1>(a, P, NSA, lds, G, (int)blockIdx.x);
        ret_kv_phase(P, KVS, lds, G, (int)blockIdx.x);
    }
    xcd_barrier(bar);
    }
    { PH_PRELUDE;
    cmp_phase(a, P, NSA, lds, G);
    ret_scan_phase(KVS, G);
    xcd_barrier(bar); }
    }
    { PH_PRELUDE;
    if (PROBE_REP == 9) attn_phase<0>(a, P, NSAdummy, lds, G, (int)blockIdx.x);
    attn_phase<0>(a, P, NSA, lds, G, (int)blockIdx.x);
    ret_out_phase(P, KVS, a.in[3], lds, G);
    xcd_barrier(bar); }
    for (int rep_ = 0; rep_ < REPS(5); ++rep_) { PH_PRELUDE;
    { pg8::Gemm g{P + PC_RG, (const bf16*)(a.ws + WS_WRO), PP, 1024, 128, 256, (long)128 * PP * 2, (long)256 * PP * 2}; pg8::StaticOrder S; S.init(M, DM, G, (int)blockIdx.x);
      pg8::EpiMerge<true> E{P + PC_MERGED, P + PC_GA, PP};
      pg8::gemm_phase<pg8::EpiMerge<true>, pg8::StaticOrder, true, true>(lds, g, S, E); }
    { pg8::Gemm g{NSA, (const bf16*)(a.ws + WS_WNO), 512, 512, 128, 256, (long)128 * 512 * 2, (long)256 * 512 * 2}; pg8::StaticOrder S; S.init(M, DM, G, (int)blockIdx.x);
      pg8::EpiMerge<false> E{P + PC_MERGED, P + PC_GB, PP};
      pg8::gemm_phase<pg8::EpiMerge<false>, pg8::StaticOrder, true, true>(lds, g, S, E); }
    xcd_barrier(bar);
    }
    for (int rep_ = 0; rep_ < REPS(6); ++rep_) { PH_PRELUDE;
    { pg8::Gemm g{P + PC_MERGED, (const bf16*)(a.ws + WS_WOUT), PP, DM, 128, 256, (long)128 * PP * 2, (long)256 * PP * 2}; pg8::StaticOrder S; S.init(M, DM, G, (int)blockIdx.x);
      pg8::EpiResid<0> E{a.in[0], nullptr, P + PC_X1B, PP, (rep_ + 1 < REPS(6)) ? rsdummy : rs2};
      pg8::gemm_phase<pg8::EpiResid<0>, pg8::StaticOrder, true, true>(lds, g, S, E); }
    xcd_barrier(bar);
    }
    for (int rep_ = 0; rep_ < REPS(7); ++rep_) { PH_PRELUDE;
    { pg8::Gemm g{P + PC_X1B, (const bf16*)(a.ws + WS_WUP), PP, DM, 128, 256, (long)128 * PP * 2, (long)256 * PP * 2}; pg8::StaticOrder S; S.init(M, NUP, G, (int)blockIdx.x);
      pg8::EpiUpConv E{P + PC_UP, PP, rs2, a.in[17], a.in[18], (float*)(a.ws + WS_TAIL), (float*)(a.ws + WS_HEAD), (LAS float*)(lds + 131072), DFF};
      pg8::gemm_phase<pg8::EpiUpConv, pg8::StaticOrder, true, true>(lds, g, S, E); }
    xcd_barrier(bar);
    }
    { PH_PRELUDE;
    { pg8::StaticOrder S; S.init(M, DM, G, (int)blockIdx.x); pg8::Unit u;
      for (int i = 0; S.next(i, u); ++i) conv_fixup(a, P, u.pm);
      asm volatile("s_waitcnt vmcnt(0)" ::: "memory"); __syncthreads();
      pg8::Gemm g{P + PC_UP, (const bf16*)(a.ws + WS_WDN), PP, DFF, 128, 256, (long)128 * PP * 2, (long)256 * PP * 2};
      pg8::EpiResid<1> E{nullptr, a.out, P + PC_X1B, PP, rs3};
      pg8::gemm_phase<pg8::EpiResid<1>, pg8::StaticOrder, true, true>(lds, g, S, E); }
    xcd_barrier(bar); }
    { const Args& a = *args_opaque(); n_final(a, G); }
}

extern "C" void kernel_launch(void* const* d_in, const int* in_sizes, int n_in, void* d_out, int out_size, void* d_ws, size_t ws_size, hipStream_t stream) {
    static int grid = 0;
    if (grid == 0) {
        if (n_in != 21 || out_size != M * DM || ws_size < WS_END) { fprintf(stderr, "kernel_launch: unexpected sizes n_in %d out %d ws %zu (need %zu)\n", n_in, out_size, ws_size, (size_t)WS_END); grid = -1; return; }
        int dev = 0, cus = 0;
        if (hipGetDevice(&dev) != hipSuccess || hipDeviceGetAttribute(&cus, hipDeviceAttributeMultiprocessorCount, dev) != hipSuccess) { grid = -1; return; }
        if (hipFuncSetAttribute((const void*)mega_fwd, hipFuncAttributeMaxDynamicSharedMemorySize, LDS_BYTES) != hipSuccess) { fprintf(stderr, "kernel_launch: hipFuncSetAttribute failed\n"); grid = -1; return; }
        grid = cus;
    }
    if (grid < 0) return;
    (void)hipMemsetAsync((char*)d_ws + WS_CTL, 0, CTL_ZERO_BYTES, stream);
    Args a{};
    for (int i = 0; i < 21; ++i) a.in[i] = (const float*)d_in[i];
    a.out = (float*)d_out; a.ws = (unsigned char*)d_ws;
    hipLaunchKernelGGL(mega_fwd, dim3(grid), dim3(512), LDS_BYTES, stream, a);
}
```
